# Optimizing an MI355X kernel written in HIP

```python
import math
import jax, jax.numpy as jnp
from jax import lax
import numpy as np

D_MODEL = 2048
BATCH = 4
SEQ = 4096
DEPTH = 2

GRID_W = 64
CTX_LEN = 256
MIX_WIDTH = D_MODEL
HEAD_DIM = 128
S5_WIDTH = MIX_WIDTH // 4
S5_GROUP = 16
S5_GROUPS = S5_WIDTH // S5_GROUP
S5_STATE = 64
DT_MIN = 1e-3
DT_MAX = 1e-1
DIFF_WIDTH = MIX_WIDTH // 4
DIFF_V_DIM = HEAD_DIM
DIFF_HEADS = DIFF_WIDTH // DIFF_V_DIM
DIFF_QK_DIM = DIFF_V_DIM // 2
DIFF_QK_WIDTH = DIFF_HEADS * 2 * DIFF_QK_DIM
GQA_WIDTH = MIX_WIDTH - S5_WIDTH - DIFF_WIDTH
GQA_HEADS = GQA_WIDTH // HEAD_DIM
GQA_KV_HEADS = 2
GQA_REP = GQA_HEADS // GQA_KV_HEADS
GQA_KV_WIDTH = GQA_KV_HEADS * HEAD_DIM
IN_SIZES = (S5_WIDTH, DIFF_QK_WIDTH, DIFF_QK_WIDTH, DIFF_WIDTH, GQA_WIDTH, GQA_KV_WIDTH, GQA_KV_WIDTH)
IN_COLS = S5_WIDTH + 2 * DIFF_QK_WIDTH + DIFF_WIDTH + GQA_WIDTH + 2 * GQA_KV_WIDTH
FFN_DIM = ((8 * D_MODEL // 3 + 255) // 256) * 256
N_MOD = 9
Q_BLOCK = 128
ROPE_THETA = 10000.0
EPS = 1e-6

kernel_name = "hybrid_s5_diffattn_gqa_macaron_dit"

f32 = jnp.float32


def rms_norm(x, g):
    xf = x.astype(f32)
    y = xf * lax.rsqrt(jnp.mean(xf * xf, axis=-1, keepdims=True) + EPS)
    return (y * g.astype(f32)).astype(x.dtype)


def modulate(h, m, k):
    return h * (1 + m[:, 3 * k + 1]) + m[:, 3 * k]


def macaron_ffn(x, m, k, g, w_gate, w_up, w_down):
    h = modulate(rms_norm(x, g), m, k)
    y = (jax.nn.silu(h @ w_gate) * (h @ w_up)) @ w_down
    return x + 0.5 * m[:, 3 * k + 2] * y


def split_in(p):
    outs, start = [], 0
    for size in IN_SIZES:
        outs.append(p[..., start:start + size])
        start += size
    return outs


def rope_1d(x, pos):
    half = x.shape[-1] // 2
    freqs = ROPE_THETA ** (-jnp.arange(half, dtype=f32) / half)
    ang = pos.astype(f32)[:, None] * freqs
    shape = (1, x.shape[1]) + (1,) * (x.ndim - 3) + (half,)
    cos = jnp.cos(ang).reshape(shape).astype(x.dtype)
    sin = jnp.sin(ang).reshape(shape).astype(x.dtype)
    x1, x2 = x[..., :half], x[..., half:]
    return jnp.concatenate([x1 * cos - x2 * sin, x1 * sin + x2 * cos], axis=-1)


def rope_axial(x, pos_row, pos_col):
    a = x.shape[-1] // 2
    return jnp.concatenate([rope_1d(x[..., :a], pos_row), rope_1d(x[..., a:], pos_col)], axis=-1)


def block_attention(q, k, v):
    b, l, g, r, dk = q.shape
    nb = l // Q_BLOCK
    qb = jnp.moveaxis(q.reshape(b, nb, Q_BLOCK, g, r, dk), 1, 0)
    scale = dk ** -0.5

    def one_block(qblk):
        s = jnp.einsum('bqgrd,bkgd->bgrqk', qblk, k).astype(f32) * scale
        p = jax.nn.softmax(s, axis=-1).astype(v.dtype)
        return jnp.einsum('bgrqk,bkgd->bqgrd', p, v)

    out = lax.map(one_block, qb)
    return jnp.moveaxis(out, 0, 1).reshape(b, l, g, r, v.shape[-1])


def s5_discretize(lam_re, lam_im, log_dt, b_re, b_im):
    lam = lax.complex(lam_re.astype(f32), lam_im.astype(f32))
    dt = jnp.exp(log_dt.astype(f32))[:, None]
    a_bar = jnp.exp(lam * dt)
    b_bar = ((a_bar - 1) / lam)[..., None] * lax.complex(b_re.astype(f32), b_im.astype(f32))
    return a_bar, b_bar


def ssm_combine(left, right):
    a_l, b_l = left
    a_r, b_r = right
    return a_r * a_l, a_r * b_l + b_r


def s5_scan(u, a_bar, b_bar, h0, reverse):
    bu = lax.complex(jnp.einsum('blgh,gph->blgp', u, b_bar.real),
                     jnp.einsum('blgh,gph->blgp', u, b_bar.imag))
    if reverse:
        bu = jnp.flip(bu, axis=1)
    if h0 is not None:
        bu = bu.at[:, 0].add(a_bar * h0)
    a = jnp.broadcast_to(a_bar, bu.shape)
    _, h = lax.associative_scan(ssm_combine, (a, bu), axis=1)
    if reverse:
        h = jnp.flip(h, axis=1)
    return h


def s5_readout(h, c_re, c_im):
    return (jnp.einsum('blgp,ghp->blgh', h.real, c_re.astype(f32))
            - jnp.einsum('blgp,ghp->blgh', h.imag, c_im.astype(f32)))


def s5_glu(y, u, d_skip, glu_w, glu_b):
    uf = u.astype(f32)
    y = y.reshape(uf.shape) + d_skip.astype(f32) * uf
    y = jax.nn.gelu(y)
    y = y * jax.nn.sigmoid(y @ glu_w.astype(f32) + glu_b.astype(f32))
    return y.astype(u.dtype)


def s5_mixer(u_x, u_c, need_ctx, lam_re, lam_im, log_dt, b_re, b_im, c_re, c_im, d_skip, glu_w, glu_b):
    ux = u_x.astype(f32).reshape(u_x.shape[:2] + (S5_GROUPS, S5_GROUP))
    uc = u_c.astype(f32).reshape(u_c.shape[:2] + (S5_GROUPS, S5_GROUP))
    y_x = 0.0
    y_c = 0.0
    for direction in range(2):
        rev = direction == 1
        a_bar, b_bar = s5_discretize(lam_re[direction], lam_im[direction], log_dt[direction],
                                     b_re[direction], b_im[direction])
        h_c = s5_scan(uc, a_bar, b_bar, None, rev)
        h_end = h_c[:, 0] if rev else h_c[:, -1]
        h_x = s5_scan(ux, a_bar, b_bar, h_end, rev)
        y_x = y_x + s5_readout(h_x, c_re[direction], c_im[direction])
        if need_ctx:
            y_c = y_c + s5_readout(h_c, c_re[direction], c_im[direction])
    out_x = s5_glu(y_x, u_x, d_skip, glu_w, glu_b)
    out_c = s5_glu(y_c, u_c, d_skip, glu_w, glu_b) if need_ctx else None
    return out_x, out_c


def diff_attention(qkv_x, qkv_c, need_ctx, pos_row, pos_col, lam_vecs, subln_g, lam_init):
    def heads(q, k, v):
        bb, ll = q.shape[:2]
        return (q.reshape(bb, ll, DIFF_HEADS, 2, DIFF_QK_DIM),
                k.reshape(bb, ll, DIFF_HEADS, 2, DIFF_QK_DIM),
                v.reshape(bb, ll, DIFF_HEADS, DIFF_V_DIM))

    qx, kx, vx = heads(*qkv_x)
    qc, kc, vc = heads(*qkv_c)
    qx = rope_axial(qx, pos_row, pos_col)
    kx = rope_axial(kx, pos_row, pos_col)
    lv = lam_vecs.astype(f32)
    lam = jnp.exp(jnp.sum(lv[0] * lv[1])) - jnp.exp(jnp.sum(lv[2] * lv[3])) + lam_init

    def diff_attend(q, k, v):
        o1 = block_attention(q[:, :, :, 0:1], k[:, :, :, 0], v)
        o2 = block_attention(q[:, :, :, 1:2], k[:, :, :, 1], v)
        o = (o1 - lam.astype(o1.dtype) * o2)[:, :, :, 0]
        o = rms_norm(o, subln_g) * (1.0 - lam_init)
        return o.reshape(o.shape[0], o.shape[1], DIFF_WIDTH)

    out_x = diff_attend(qx, jnp.concatenate([kc, kx], axis=1), jnp.concatenate([vc, vx], axis=1))
    out_c = diff_attend(qc, kc, vc) if need_ctx else None
    return out_x, out_c


def gqa_attention(qkv_x, qkv_c, need_ctx, pos_row, pos_col, q_g, k_g):
    def heads(q, k, v):
        bb, ll = q.shape[:2]
        q = rms_norm(q.reshape(bb, ll, GQA_KV_HEADS, GQA_REP, HEAD_DIM), q_g)
        k = rms_norm(k.reshape(bb, ll, GQA_KV_HEADS, HEAD_DIM), k_g)
        v = v.reshape(bb, ll, GQA_KV_HEADS, HEAD_DIM)
        return q, k, v

    qx, kx, vx = heads(*qkv_x)
    qc, kc, vc = heads(*qkv_c)
    qx = rope_axial(qx, pos_row, pos_col)
    kx = rope_axial(kx, pos_row, pos_col)
    ox = block_attention(qx, jnp.concatenate([kc, kx], axis=1), jnp.concatenate([vc, vx], axis=1))
    out_x = ox.reshape(ox.shape[0], ox.shape[1], GQA_WIDTH)
    out_c = None
    if need_ctx:
        oc = block_attention(qc, kc, vc)
        out_c = oc.reshape(oc.shape[0], oc.shape[1], GQA_WIDTH)
    return out_x, out_c


def setup_inputs(seed: int = 0) -> dict:
    key = jax.random.key(seed)
    ks = jax.random.split(key, 32)

    def nrm(k, shape, scale):
        return jax.random.normal(k, shape, f32) * scale

    G, P, H = S5_GROUPS, S5_STATE, S5_GROUP
    x = nrm(ks[0], (BATCH, SEQ, D_MODEL), 1.0)
    c = nrm(ks[1], (BATCH, D_MODEL), 1.0)
    ctx = nrm(ks[2], (BATCH, CTX_LEN, D_MODEL), 1.0)
    c_ctx = nrm(ks[3], (D_MODEL,), 1.0)
    ada_w = nrm(ks[4], (DEPTH, D_MODEL, N_MOD * D_MODEL), 0.5 * D_MODEL ** -0.5)
    ada_b = nrm(ks[5], (DEPTH, N_MOD * D_MODEL), 0.02)
    norm_g = 1.0 + nrm(ks[6], (DEPTH, 3, D_MODEL), 0.05)
    ffn_w_gate = nrm(ks[7], (DEPTH, 2, D_MODEL, FFN_DIM), D_MODEL ** -0.5)
    ffn_w_up = nrm(ks[8], (DEPTH, 2, D_MODEL, FFN_DIM), D_MODEL ** -0.5)
    ffn_w_down = nrm(ks[9], (DEPTH, 2, FFN_DIM, D_MODEL), FFN_DIM ** -0.5)
    w_in = nrm(ks[10], (DEPTH, D_MODEL, IN_COLS), D_MODEL ** -0.5)
    w_out = nrm(ks[11], (DEPTH, MIX_WIDTH, D_MODEL), MIX_WIDTH ** -0.5)
    s5_lam_re = -0.5 + nrm(ks[12], (DEPTH, 2, G, P), 0.01)
    s5_lam_im = math.pi * jnp.arange(P, dtype=f32) + nrm(ks[13], (DEPTH, 2, G, P), 0.01)
    s5_log_dt = jax.random.uniform(ks[14], (DEPTH, 2, G), f32, math.log(DT_MIN), math.log(DT_MAX))
    s5_b_re = nrm(ks[15], (DEPTH, 2, G, P, H), (2 * H) ** -0.5)
    s5_b_im = nrm(ks[16], (DEPTH, 2, G, P, H), (2 * H) ** -0.5)
    s5_c_re = nrm(ks[17], (DEPTH, 2, G, H, P), P ** -0.5)
    s5_c_im = nrm(ks[18], (DEPTH, 2, G, H, P), P ** -0.5)
    s5_d = nrm(ks[19], (DEPTH, S5_WIDTH), 0.5)
    s5_glu_w = nrm(ks[20], (DEPTH, S5_WIDTH, S5_WIDTH), S5_WIDTH ** -0.5)
    s5_glu_b = nrm(ks[21], (DEPTH, S5_WIDTH), 0.02)
    diff_lam = nrm(ks[22], (DEPTH, 4, DIFF_QK_DIM), 0.1)
    diff_subln_g = 1.0 + nrm(ks[23], (DEPTH, DIFF_V_DIM), 0.05)
    gqa_q_g = 1.0 + nrm(ks[24], (DEPTH, HEAD_DIM), 0.05)
    gqa_k_g = 1.0 + nrm(ks[25], (DEPTH, HEAD_DIM), 0.05)
    final_g = 1.0 + nrm(ks[26], (D_MODEL,), 0.05)
    return {"x": x, "c": c, "ctx": ctx, "c_ctx": c_ctx, "ada_w": ada_w, "ada_b": ada_b,
            "norm_g": norm_g, "ffn_w_gate": ffn_w_gate, "ffn_w_up": ffn_w_up, "ffn_w_down": ffn_w_down,
            "w_in": w_in, "w_out": w_out, "s5_lam_re": s5_lam_re, "s5_lam_im": s5_lam_im,
            "s5_log_dt": s5_log_dt, "s5_b_re": s5_b_re, "s5_b_im": s5_b_im, "s5_c_re": s5_c_re,
            "s5_c_im": s5_c_im, "s5_d": s5_d, "s5_glu_w": s5_glu_w, "s5_glu_b": s5_glu_b,
            "diff_lam": diff_lam, "diff_subln_g": diff_subln_g, "gqa_q_g": gqa_q_g, "gqa_k_g": gqa_k_g,
            "final_g": final_g}


def reference(x, c, ctx, c_ctx, ada_w, ada_b, norm_g, ffn_w_gate, ffn_w_up, ffn_w_down, w_in, w_out,
              s5_lam_re, s5_lam_im, s5_log_dt, s5_b_re, s5_b_im, s5_c_re, s5_c_im, s5_d, s5_glu_w, s5_glu_b,
              diff_lam, diff_subln_g, gqa_q_g, gqa_k_g, final_g):
    b, seq = x.shape[0], x.shape[1]
    rows = seq // GRID_W
    pos_row = jnp.repeat(jnp.arange(rows, dtype=jnp.int32), GRID_W)
    pos_col = jnp.tile(jnp.arange(GRID_W, dtype=jnp.int32), rows)
    xc = ctx
    for i in range(DEPTH):
        need_ctx = i < DEPTH - 1
        lam_init = 0.8 - 0.6 * math.exp(-0.3 * i)
        m_x = (jax.nn.silu(c) @ ada_w[i] + ada_b[i]).reshape(b, N_MOD, 1, D_MODEL)
        m_c = (jax.nn.silu(c_ctx) @ ada_w[i] + ada_b[i]).reshape(1, N_MOD, 1, D_MODEL)

        xc = macaron_ffn(xc, m_c, 0, norm_g[i, 0], ffn_w_gate[i, 0], ffn_w_up[i, 0], ffn_w_down[i, 0])
        x = macaron_ffn(x, m_x, 0, norm_g[i, 0], ffn_w_gate[i, 0], ffn_w_up[i, 0], ffn_w_down[i, 0])

        hc = modulate(rms_norm(xc, norm_g[i, 1]), m_c, 1)
        hx = modulate(rms_norm(x, norm_g[i, 1]), m_x, 1)
        pc = split_in(hc @ w_in[i])
        px = split_in(hx @ w_in[i])

        s5_x, s5_c = s5_mixer(px[0], pc[0], need_ctx, s5_lam_re[i], s5_lam_im[i], s5_log_dt[i],
                              s5_b_re[i], s5_b_im[i], s5_c_re[i], s5_c_im[i], s5_d[i], s5_glu_w[i], s5_glu_b[i])
        dif_x, dif_c = diff_attention(px[1:4], pc[1:4], need_ctx, pos_row, pos_col,
                                      diff_lam[i], diff_subln_g[i], lam_init)
        gqa_x, gqa_c = gqa_attention(px[4:7], pc[4:7], need_ctx, pos_row, pos_col, gqa_q_g[i], gqa_k_g[i])

        x = x + m_x[:, 5] * (jnp.concatenate([s5_x, dif_x, gqa_x], axis=-1) @ w_out[i])
        if need_ctx:
            xc = xc + m_c[:, 5] * (jnp.concatenate([s5_c, dif_c, gqa_c], axis=-1) @ w_out[i])
            xc = macaron_ffn(xc, m_c, 2, norm_g[i, 2], ffn_w_gate[i, 1], ffn_w_up[i, 1], ffn_w_down[i, 1])

        x = macaron_ffn(x, m_x, 2, norm_g[i, 2], ffn_w_gate[i, 1], ffn_w_up[i, 1], ffn_w_down[i, 1])
    return rms_norm(x, final_g)
```

```cpp
#include <hip/hip_runtime.h>
#include <hip/hip_bf16.h>
#include <cstdio>
#include <cstdint>
#include <cmath>
namespace pg8 {
#define PG8_LAS __attribute__((address_space(3)))
typedef unsigned short bf16_t;
typedef short bf16x8 __attribute__((ext_vector_type(8)));
typedef float f32x4 __attribute__((ext_vector_type(4)));
typedef unsigned u32x4 __attribute__((ext_vector_type(4)));
constexpr int BM = 256, BK = 64, HALF = 128, HTB = HALF * BK * 2  , STAGE_BYTES = 8 * HTB, NXCD = 8, WGM = 8;

__host__ __device__ __forceinline__ int lds_byte(int r, int c) { const int st = (r >> 4) * 2 + (c >> 5), rr = r & 15, cc = c & 31, ob = rr * 64 + cc * 2; return st * 1024 + (ob ^ (((ob >> 9) & 1) << 5)); }
__host__ __device__ __forceinline__ void stage_rc(int b, int& R, int& C) { const int st = b / 1024, sb = b % 1024, swz = sb ^ (((sb >> 9) & 1) << 5); R = (st >> 1) * 16 + swz / 64; C = (st & 1) * 32 + (swz % 64) / 2; }
__host__ __device__ __forceinline__ int perm32(int rho) { const int n = rho >> 4, i = rho & 15; return 8 * (i >> 2) + 4 * n + (i & 3); }

struct Unit { int pm, pn; };
struct Gemm { const bf16_t* A; const bf16_t* Bt; int M, N, K, lda, ldb; };

struct StaticOrder {
    int nM, nN, nwg, G, c;
    __host__ __device__ void init(int M, int N, int G_, int c_) { nM = M / BM; nN = N / BM; nwg = nM * nN; G = G_; c = c_; }
    __host__ __device__ bool next(int i, Unit& u) const {
        const long L = (long)i * G + c; if (L >= nwg) return false;
        int wgid = (int)L; { const int q = nwg / NXCD, r = nwg % NXCD, xcd = wgid % NXCD, off = wgid / NXCD; wgid = (xcd < r ? xcd * (q + 1) : r * (q + 1) + (xcd - r) * q) + off; }
        const int nig = WGM * nN, gid = wgid / nig, fm = gid * WGM, gsz = (nM - fm) < WGM ? (nM - fm) : WGM;
        u.pm = fm + ((wgid % nig) % gsz); u.pn = (wgid % nig) / gsz; return true;
    }
    __device__ __forceinline__ void a_ready(const Unit&) const {}
    __device__ __forceinline__ void done(const Unit&) const {}
};

__device__ __forceinline__ unsigned cvt_pk_bf16(float lo, float hi) { unsigned r; asm volatile("v_cvt_pk_bf16_f32 %0, %1, %2" : "=v"(r) : "v"(lo), "v"(hi)); return r; }
typedef float f32x2 __attribute__((ext_vector_type(2)));
__device__ __forceinline__ f32x2 gelu_pk(f32x2 v) {
    const f32x2 av = __builtin_elementwise_abs(v), d = av * 0.2316418882f + 1.0f;
    f32x2 t; t.x = __builtin_amdgcn_rcpf(d.x); t.y = __builtin_amdgcn_rcpf(d.y);
    f32x2 q = t * 0.5307027145f + (-0.7265760135f); q = q * t + 0.7107068705f; q = q * t + (-0.142248368f); q = q * t + 0.127414796f; q = q * t;
    const f32x2 s = (v * v) * (-0.72134752044f);
    f32x2 e; e.x = __builtin_amdgcn_exp2f(s.x); e.y = __builtin_amdgcn_exp2f(s.y);
    const f32x2 m = v * (q * e), r = v - m;
    f32x2 o; o.x = v.x < 0.f ? m.x : r.x; o.y = v.y < 0.f ? m.y : r.y; return o;
}

template <int ACT  > struct EpiBf16 {
    static constexpr bool PERM = true, AFTER_DRAIN = false; static_assert(ACT == 0 || ACT == 1, "EpiBf16: ACT is 0 (none) or 1 (gelu_pk)");
    bf16_t* O; int ldc; const float* bias; int split_cols; size_t split_stride; float scale0;
    __device__ __forceinline__ void operator()(const f32x4 (&acc)[2][2][4][2], const Unit& u, int wr, int wc, int fr, int fq) const {
        const int row0 = u.pm * BM + wr * 64 + fr; int colt = u.pn * BM; bf16_t* base = O;
        float sc = 1.f; if (split_cols) { const int t = colt / split_cols; base += (size_t)t * split_stride; colt -= t * split_cols; if (t == 0) sc = scale0; }
        const int col0 = colt + wc * 32 + 8 * fq, bcol0 = u.pn * BM + wc * 32 + 8 * fq;
        f32x4 bv[2][2];
#pragma unroll
        for (int bj = 0; bj < 2; ++bj)
#pragma unroll
            for (int n = 0; n < 2; ++n) bv[bj][n] = bias ? *(const f32x4*)(bias + bcol0 + bj * HALF + 4 * n) : (f32x4){0.f, 0.f, 0.f, 0.f};
#pragma unroll
        for (int ai = 0; ai < 2; ++ai)
#pragma unroll
            for (int m = 0; m < 4; ++m) { bf16_t* rowp = base + (size_t)(row0 + ai * HALF + m * 16) * ldc + col0;
#pragma unroll
                for (int bj = 0; bj < 2; ++bj) { f32x4 v0 = acc[ai][bj][m][0] + bv[bj][0], v1 = acc[ai][bj][m][1] + bv[bj][1];
                    if (ACT == 1) { f32x2 a = gelu_pk((f32x2){v0[0], v0[1]}), b = gelu_pk((f32x2){v0[2], v0[3]}), c = gelu_pk((f32x2){v1[0], v1[1]}), d = gelu_pk((f32x2){v1[2], v1[3]});
                        v0 = (f32x4){a.x, a.y, b.x, b.y}; v1 = (f32x4){c.x, c.y, d.x, d.y}; }
                    v0 = v0 * sc; v1 = v1 * sc; u32x4 w; w.x = cvt_pk_bf16(v0[0], v0[1]); w.y = cvt_pk_bf16(v0[2], v0[3]); w.z = cvt_pk_bf16(v1[0], v1[1]); w.w = cvt_pk_bf16(v1[2], v1[3]);
                    *(u32x4*)(rowp + bj * HALF) = w; } }
    }
};


template <class Epi, class Sched, bool ALIGN_EPI = false, bool SP2 = false>
__device__ __forceinline__ void gemm_phase(PG8_LAS unsigned char* lds, const Gemm g, const Sched& S, const Epi& E) {
    int tid_l = threadIdx.x; asm volatile("" : "+v"(tid_l));
    const int tid = tid_l, wid = __builtin_amdgcn_readfirstlane(tid >> 6), lane = tid & 63, wr = wid >> 2, wc = wid & 3, fr = lane & 15, fq = lane >> 4;
    const int K = g.K, nt = K / BK;
    unsigned voffA[2], voffB[2];
#pragma unroll
    for (int i = 0; i < 2; ++i) { int R, C; stage_rc(tid * 16 + i * 8192, R, C); const int Rb = Epi::PERM ? ((R & ~31) + perm32(R & 31)) : R;
        voffA[i] = (unsigned)(R * g.lda + C) * 2u; voffB[i] = (unsigned)(Rb * g.ldb + C) * 2u; }
    const size_t kstep = (size_t)(BK * 2);
    const size_t hstepA = (size_t)HALF * g.lda * 2, hstepB = (size_t)HALF * g.ldb * 2;
    const size_t tstepA = 2 * hstepA, tstepB = 2 * hstepB;
    const unsigned ldsw = (unsigned)wid * 1024u;
    const int aoff = lds_byte(wr * 64 + fr, fq * 8), boff = lds_byte(wc * 32 + fr, fq * 8);
#define PG8_SA(b, h) (((b) * 2 + (h)) * HTB)
#define PG8_SB(b, h) ((4 + (b) * 2 + (h)) * HTB)
#define PG8_STAGE(bufoff, gbase, voff) do { _Pragma("unroll") for (int _i = 0; _i < 2; ++_i) \
        __builtin_amdgcn_global_load_lds((const unsigned*)((const char*)(gbase) + (voff)[_i]), (PG8_LAS unsigned*)(lds + (bufoff) + ldsw + _i * 8192), 16, 0, 0); } while (0)
#define PG8_LDA(dst, b, h) do { _Pragma("unroll") for (int m = 0; m < 4; ++m) _Pragma("unroll") for (int k = 0; k < 2; ++k) dst[m][k] = *(const PG8_LAS bf16x8*)(lds + PG8_SA(b, h) + aoff + m * 2048 + k * 1024); } while (0)
#define PG8_LDB(dst, b, h) do { _Pragma("unroll") for (int n = 0; n < 2; ++n) _Pragma("unroll") for (int k = 0; k < 2; ++k) dst[n][k] = *(const PG8_LAS bf16x8*)(lds + PG8_SB(b, h) + boff + n * 2048 + k * 1024); } while (0)
#define PG8_MMA(ai, bj, At, Bt) do { __builtin_amdgcn_s_setprio(1); _Pragma("unroll") for (int m = 0; m < 4; ++m) _Pragma("unroll") for (int n = 0; n < 2; ++n) _Pragma("unroll") for (int k = 0; k < 2; ++k) \
        acc[ai][bj][m][n] = __builtin_amdgcn_mfma_f32_16x16x32_bf16(Bt[n][k], At[m][k], acc[ai][bj][m][n], 0, 0, 0); __builtin_amdgcn_s_setprio(0); } while (0)
#define PG8_WAIT_V(n) asm volatile("s_waitcnt vmcnt(" #n ")" ::: "memory")
#define PG8_WAIT_L(n) asm volatile("s_waitcnt lgkmcnt(" #n ")" ::: "memory")
#define PG8_BAR __builtin_amdgcn_s_barrier()
#define PG8_SCHED __builtin_amdgcn_sched_barrier(0)
    Unit cur, nxt; int ui = 0;
    if (!S.next(0, cur)) return;
    f32x4 acc[2][2][4][2];
#pragma unroll
    for (int a = 0; a < 2; ++a)
#pragma unroll
        for (int b = 0; b < 2; ++b)
#pragma unroll
            for (int m = 0; m < 4; ++m)
#pragma unroll
                for (int n = 0; n < 2; ++n) acc[a][b][m][n] = (f32x4){0.f, 0.f, 0.f, 0.f};
    bf16x8 At[4][2], B0[2][2], B1[2][2];
    const char* cA = (const char*)g.A + (size_t)cur.pm * tstepA; const char* cB = (const char*)g.Bt + (size_t)cur.pn * tstepB;
    S.a_ready(cur);
    if constexpr (SP2) {
        PG8_STAGE(PG8_SB(0, 0), cB, voffB); PG8_STAGE(PG8_SB(0, 1), cB + hstepB, voffB); PG8_STAGE(PG8_SA(0, 0), cA, voffA); PG8_STAGE(PG8_SA(0, 1), cA + hstepA, voffA);
        if (wr == 1) PG8_BAR;
        PG8_WAIT_V(2); PG8_BAR;
        PG8_STAGE(PG8_SB(1, 0), cB + kstep, voffB); PG8_STAGE(PG8_SA(1, 0), cA + kstep, voffA); PG8_STAGE(PG8_SB(1, 1), cB + hstepB + kstep, voffB);
        PG8_WAIT_V(6); PG8_BAR;
    } else {
        PG8_STAGE(PG8_SB(0, 0), cB, voffB); PG8_STAGE(PG8_SA(0, 0), cA, voffA); PG8_STAGE(PG8_SB(0, 1), cB + hstepB, voffB); PG8_STAGE(PG8_SA(0, 1), cA + hstepA, voffA);
        if (wr == 1) PG8_BAR;
        PG8_WAIT_V(4); PG8_BAR;
        PG8_STAGE(PG8_SB(1, 0), cB + kstep, voffB); PG8_STAGE(PG8_SA(1, 0), cA + kstep, voffA); PG8_STAGE(PG8_SB(1, 1), cB + hstepB + kstep, voffB);
        PG8_WAIT_V(6); PG8_BAR;
    }
    for (;;) {
        const bool has_next = S.next(ui + 1, nxt);
        const char* nA = has_next ? (const char*)g.A + (size_t)nxt.pm * tstepA : cA; const char* nB = has_next ? (const char*)g.Bt + (size_t)nxt.pn * tstepB : cB;
        for (int t = 0; t < nt; t += 2) {
            const bool last = (t == nt - 2);
            const char* a1 = cA + (size_t)(t + 1) * kstep;
            const char* a2 = last ? nA : cA + (size_t)(t + 2) * kstep; const char* b2 = last ? nB : cB + (size_t)(t + 2) * kstep;
            const char* a3 = a2 + kstep; const char* b3 = b2 + kstep;
            if (last && has_next) S.a_ready(nxt);
            if constexpr (SP2) {
            PG8_LDB(B0, 0, 0); PG8_LDB(B1, 0, 1); PG8_SCHED; PG8_LDA(At, 0, 0); PG8_STAGE(PG8_SA(1, 1), a1 + hstepA, voffA);
            PG8_WAIT_V(8); PG8_WAIT_L(0); PG8_BAR; PG8_MMA(0, 0, At, B0); PG8_MMA(0, 1, At, B1); PG8_BAR; PG8_SCHED;
            PG8_LDA(At, 0, 1); PG8_STAGE(PG8_SB(0, 0), b2, voffB); PG8_STAGE(PG8_SB(0, 1), b2 + hstepB, voffB); PG8_STAGE(PG8_SA(0, 0), a2, voffA);
            PG8_WAIT_V(8); PG8_WAIT_L(0); PG8_BAR; PG8_MMA(1, 0, At, B0); PG8_MMA(1, 1, At, B1); PG8_BAR; PG8_SCHED;
            PG8_LDB(B0, 1, 0); PG8_LDB(B1, 1, 1); PG8_SCHED; PG8_LDA(At, 1, 0); PG8_STAGE(PG8_SA(0, 1), a2 + hstepA, voffA);
            PG8_WAIT_V(8); PG8_WAIT_L(0); PG8_BAR; PG8_MMA(0, 0, At, B0); PG8_MMA(0, 1, At, B1); PG8_BAR; PG8_SCHED;
            PG8_LDA(At, 1, 1); PG8_STAGE(PG8_SB(1, 0), b3, voffB); PG8_STAGE(PG8_SB(1, 1), b3 + hstepB, voffB); PG8_STAGE(PG8_SA(1, 0), a3, voffA);
            PG8_WAIT_V(8); PG8_WAIT_L(0); PG8_BAR; PG8_MMA(1, 0, At, B0); PG8_MMA(1, 1, At, B1); PG8_BAR; PG8_SCHED;
            } else {
            PG8_LDB(B0, 0, 0); PG8_SCHED; PG8_LDA(At, 0, 0); PG8_STAGE(PG8_SA(1, 1), a1 + hstepA, voffA);
            PG8_WAIT_L(8); PG8_BAR; PG8_WAIT_L(0); PG8_MMA(0, 0, At, B0); PG8_BAR; PG8_SCHED;
            PG8_LDB(B1, 0, 1); PG8_STAGE(PG8_SB(0, 0), b2, voffB);
            PG8_BAR; PG8_WAIT_L(0); PG8_MMA(0, 1, At, B1); PG8_BAR;
            PG8_LDA(At, 0, 1); PG8_STAGE(PG8_SA(0, 0), a2, voffA);
            PG8_BAR; PG8_WAIT_L(0); PG8_MMA(1, 0, At, B0); PG8_BAR; PG8_SCHED;
            PG8_STAGE(PG8_SB(0, 1), b2 + hstepB, voffB);
            PG8_WAIT_V(6); PG8_BAR; PG8_MMA(1, 1, At, B1); PG8_BAR;
            PG8_LDB(B0, 1, 0); PG8_SCHED; PG8_LDA(At, 1, 0); PG8_STAGE(PG8_SA(0, 1), a2 + hstepA, voffA);
            PG8_WAIT_L(8); PG8_BAR; PG8_WAIT_L(0); PG8_MMA(0, 0, At, B0); PG8_BAR; PG8_SCHED;
            PG8_LDB(B1, 1, 1); PG8_STAGE(PG8_SB(1, 0), b3, voffB);
            PG8_BAR; PG8_WAIT_L(0); PG8_MMA(0, 1, At, B1); PG8_BAR;
            PG8_LDA(At, 1, 1); PG8_STAGE(PG8_SA(1, 0), a3, voffA);
            PG8_BAR; PG8_WAIT_L(0); PG8_MMA(1, 0, At, B0); PG8_BAR; PG8_SCHED;
            PG8_STAGE(PG8_SB(1, 1), b3 + hstepB, voffB);
            PG8_WAIT_V(6); PG8_BAR; PG8_MMA(1, 1, At, B1); PG8_BAR;
            }
        }
        if constexpr (ALIGN_EPI) { if (wr == 0) PG8_BAR; }
        if constexpr (!Epi::AFTER_DRAIN) { E(acc, cur, wr, wc, fr, fq); S.done(cur); }
        if (!has_next) break;
#pragma unroll
        for (int a = 0; a < 2; ++a)
#pragma unroll
            for (int b = 0; b < 2; ++b)
#pragma unroll
                for (int m = 0; m < 4; ++m)
#pragma unroll
                    for (int n = 0; n < 2; ++n) acc[a][b][m][n] = (f32x4){0.f, 0.f, 0.f, 0.f};
        cur = nxt; cA = nA; cB = nB; ++ui;
        if constexpr (ALIGN_EPI) { if (wr == 1) PG8_BAR; }
    }
    PG8_WAIT_V(0);
    if constexpr (!ALIGN_EPI) { if (wr == 0) PG8_BAR; }
    PG8_BAR;
    if constexpr (Epi::AFTER_DRAIN) { E.fused(acc, cur, wr, wc, fr, fq, lds, wid, lane); S.done(cur); }
#undef PG8_SA
#undef PG8_SB
#undef PG8_STAGE
#undef PG8_LDA
#undef PG8_LDB
#undef PG8_MMA
#undef PG8_WAIT_V
#undef PG8_WAIT_L
#undef PG8_BAR
#undef PG8_SCHED
}
}

namespace at128 {
using bf16 = __hip_bfloat16;
constexpr int D = 128, NW = 8, QBLK = 32, KVBLK = 64, SDEPTH = 2;
constexpr float SCALE = 0.088388347648318440f, THR = 8.f;
constexpr size_t SHM_V = KVBLK * D * 2, SHM_K = KVBLK * D * 2, SHM_ATTN = 2 * SHM_V + 2 * SHM_K + NW * 64 * 4;
using bf16x8 = __attribute__((ext_vector_type(8))) short;
using s16x4  = __attribute__((ext_vector_type(4))) short;
using f32x16 = __attribute__((ext_vector_type(16))) float;
using f32x8  = __attribute__((ext_vector_type(8))) float;
using u32x4  = __attribute__((ext_vector_type(4))) unsigned;
#define KSWZ(row, colB) ((row) * 256 + ((colB) ^ (((row) & 7) << 4)))
#define SBAR() __builtin_amdgcn_sched_barrier(0)
__device__ __forceinline__ int crow(int r, int hi) { return (r & 3) + 8 * (r >> 2) + 4 * hi; }
__device__ __forceinline__ unsigned cvtpk(float lo, float hi) {
  unsigned r; asm volatile("v_cvt_pk_bf16_f32 %0, %1, %2" : "=v"(r) : "v"(lo), "v"(hi)); return r;
}
template <typename TIn> struct Stage;
template <> struct Stage<bf16>  { using T = bf16x8;
  __device__ static __forceinline__ T ld8(const bf16* p) { return *reinterpret_cast<const bf16x8*>(p); }
  __device__ static __forceinline__ bf16x8 tobf(T x) { return x; } };
template <> struct Stage<float> { using T = f32x8;
  __device__ static __forceinline__ T ld8(const float* p) { return *reinterpret_cast<const f32x8*>(p); }
  __device__ static __forceinline__ bf16x8 tobf(T x) {
    u32x4 w = {cvtpk(x[0], x[1]), cvtpk(x[2], x[3]), cvtpk(x[4], x[5]), cvtpk(x[6], x[7])}; return *reinterpret_cast<bf16x8*>(&w); } };

__device__ __forceinline__ void partialSM(f32x16& p0, f32x16& p1, float& m_reg, float& mn, float& alpha) {
  constexpr float C = SCALE * 1.4426950408889634f;
  float pmax = p0[0]; for (int r = 1; r < 16; ++r) pmax = fmaxf(pmax, p0[r]); for (int r = 0; r < 16; ++r) pmax = fmaxf(pmax, p1[r]);
  { auto rr = __builtin_amdgcn_permlane32_swap(__float_as_uint(pmax), __float_as_uint(pmax), false, false);
    pmax = fmaxf(__uint_as_float(rr[0]), __uint_as_float(rr[1])); }
  if (__builtin_expect(__all(pmax - m_reg <= THR / SCALE), 1)) { mn = m_reg; alpha = 1.f; }
  else { mn = fmaxf(m_reg, pmax); alpha = __builtin_amdgcn_exp2f((m_reg - mn) * C); m_reg = mn; }
  float mnC = -mn * C;
  for (int r = 0; r < 16; ++r) p0[r] = fmaf(p0[r], C, mnC); for (int r = 0; r < 16; ++r) p1[r] = fmaf(p1[r], C, mnC);
  for (int r = 0; r < 16; ++r) p0[r] = __builtin_amdgcn_exp2f(p0[r]);
}
__device__ __forceinline__ void finishSM(f32x16& p0, f32x16& p1, float alpha, float& l_reg, bf16x8& pa0, bf16x8& pa1, bf16x8& pa2, bf16x8& pa3) {
  for (int r = 0; r < 16; ++r) p1[r] = __builtin_amdgcn_exp2f(p1[r]);
  float ps = 0; for (int r = 0; r < 16; ++r) ps += p0[r]; for (int r = 0; r < 16; ++r) ps += p1[r];
  { auto rr = __builtin_amdgcn_permlane32_swap(__float_as_uint(ps), __float_as_uint(ps), false, false);
    ps = __uint_as_float(rr[0]) + __uint_as_float(rr[1]); }
  l_reg = l_reg * alpha + ps;
#define PK4(P, BASE, OUT) do { unsigned a0 = cvtpk(P[BASE + 0], P[BASE + 1]), a1 = cvtpk(P[BASE + 2], P[BASE + 3]);   \
    unsigned b0 = cvtpk(P[BASE + 4], P[BASE + 5]), b1 = cvtpk(P[BASE + 6], P[BASE + 7]);                              \
    auto r0 = __builtin_amdgcn_permlane32_swap(a0, b0, false, false); auto r1 = __builtin_amdgcn_permlane32_swap(a1, b1, false, false); \
    u32x4 w = {r0[0], r1[0], r0[1], r1[1]}; OUT = *reinterpret_cast<bf16x8*>(&w); } while (0)
  PK4(p0, 0, pa0); PK4(p0, 8, pa1); PK4(p1, 0, pa2); PK4(p1, 8, pa3);
#undef PK4
}
__device__ __forceinline__ void qkt(f32x16& p0, f32x16& p1, const bf16* Ks, const bf16x8* qr, int r32, int hi) {
  p0 = f32x16{}; p1 = f32x16{};
  for (int d0 = 0; d0 < 8; ++d0) { int cb = (d0 * 16 + hi * 8) * 2;
    bf16x8 b0 = *reinterpret_cast<const bf16x8*>((const char*)Ks + KSWZ(r32, cb));
    bf16x8 b1 = *reinterpret_cast<const bf16x8*>((const char*)Ks + KSWZ(32 + r32, cb));
    p0 = __builtin_amdgcn_mfma_f32_32x32x16_bf16(b0, qr[d0], p0, 0, 0, 0);
    p1 = __builtin_amdgcn_mfma_f32_32x32x16_bf16(b1, qr[d0], p1, 0, 0, 0); }
}
__device__ __forceinline__ int v_st(int k, int c) { const int kk = (k & ~0xC) | ((k & 4) << 1) | ((k & 8) >> 1); return ((kk >> 3) * 4 + (c >> 5)) * 512 + ((kk & 7) * 32 + (c & 31)) * 2; }
__device__ __forceinline__ int v_rd_base(int lane) { return ((lane & 3) << 3) | (((lane >> 2) & 3) << 6) | (((lane >> 4) & 1) << 5) | (((lane >> 5) & 1) << 8); }
constexpr int v_rd_off(int d0, int ks, int half) { return d0 * 512 + ks * 4096 + half * 2048; }
template <int OFF> __device__ __forceinline__ s16x4 tr_read(int vb) {
  s16x4 r; asm volatile("ds_read_b64_tr_b16 %0, %1 offset:%2" : "=&v"(r) : "v"(vb), "i"(OFF) : "memory"); return r;
}
template <int D0> __device__ __forceinline__ void pv_one(f32x16& od, int vb, bf16x8 pa0, bf16x8 pa1, bf16x8 pa2, bf16x8 pa3) {
  const s16x4 l0 = tr_read<v_rd_off(D0, 0, 0)>(vb), h0 = tr_read<v_rd_off(D0, 0, 1)>(vb), l1 = tr_read<v_rd_off(D0, 1, 0)>(vb), h1 = tr_read<v_rd_off(D0, 1, 1)>(vb);
  const s16x4 l2 = tr_read<v_rd_off(D0, 2, 0)>(vb), h2 = tr_read<v_rd_off(D0, 2, 1)>(vb), l3 = tr_read<v_rd_off(D0, 3, 0)>(vb), h3 = tr_read<v_rd_off(D0, 3, 1)>(vb);
  asm volatile("s_waitcnt lgkmcnt(0)" ::: "memory"); SBAR();
#define PK(L, H) (bf16x8){L[0], L[1], L[2], L[3], H[0], H[1], H[2], H[3]}
  od = __builtin_amdgcn_mfma_f32_32x32x16_bf16(pa0, PK(l0, h0), od, 0, 0, 0);
  od = __builtin_amdgcn_mfma_f32_32x32x16_bf16(pa1, PK(l1, h1), od, 0, 0, 0);
  od = __builtin_amdgcn_mfma_f32_32x32x16_bf16(pa2, PK(l2, h2), od, 0, 0, 0);
  od = __builtin_amdgcn_mfma_f32_32x32x16_bf16(pa3, PK(l3, h3), od, 0, 0, 0);
#undef PK
}
__device__ __forceinline__ void pv_d0(f32x16* o, int vb, bf16x8 pa0, bf16x8 pa1, bf16x8 pa2, bf16x8 pa3) {
  pv_one<0>(o[0], vb, pa0, pa1, pa2, pa3); pv_one<1>(o[1], vb, pa0, pa1, pa2, pa3); pv_one<2>(o[2], vb, pa0, pa1, pa2, pa3); pv_one<3>(o[3], vb, pa0, pa1, pa2, pa3);
}

template <int LDQ, int LDK, int LDV, int LDOF, int LDOB>
__device__ __forceinline__ void attn_dense_body(const bf16* __restrict__ Qb, const bf16* __restrict__ Kh, const bf16* __restrict__ Vh,
                                                float* __restrict__ Of, bf16* __restrict__ Ob16, int seq, char* lds) {
  using TQ = bf16; using St = Stage<bf16>; using SQ = Stage<TQ>;
  int tid_l = threadIdx.x; asm volatile("" : "+v"(tid_l));
  const int tid = tid_l, wid = tid >> 6, lane = tid & 63, r32 = lane & 31, hi = lane >> 5;
  bf16* V_lds = (bf16*)lds; bf16* K_lds = (bf16*)(lds + 2 * SHM_V);
  float* ws = (float*)(lds + 2 * SHM_V + 2 * SHM_K) + wid * 64; float* li_l = ws; float* al_l = ws + 32;
  float m_reg = -1e30f, l_reg = 0; f32x16 o[4] = {}; bf16x8 qr[8];
  const TQ* Qw = Qb + (long)(wid * QBLK + r32) * LDQ + hi * 8;
#pragma unroll
  for (int d0 = 0; d0 < 8; ++d0) qr[d0] = SQ::tobf(SQ::ld8(Qw + d0 * 16));
  const int sr = tid >> 4, sc = (tid & 15) * 8, vst0 = v_st(sr, sc), vst1 = v_st(32 + sr, sc);
  const int vb0 = (int)(uintptr_t)V_lds + v_rd_base(lane);
  struct { typename St::T vs0, vs1, ks0, ks1; } sr_[SDEPTH];
#define SLOAD(i, k0) do { sr_[i].vs0 = St::ld8(&Vh[(long)((k0) + sr) * LDV + sc]); sr_[i].vs1 = St::ld8(&Vh[(long)((k0) + 32 + sr) * LDV + sc]); \
    sr_[i].ks0 = St::ld8(&Kh[(long)((k0) + sr) * LDK + sc]); sr_[i].ks1 = St::ld8(&Kh[(long)((k0) + 32 + sr) * LDK + sc]); } while (0)
#define SWRITE(b, i) do { *(bf16x8*)((char*)V_lds + (b) * SHM_V + vst0) = St::tobf(sr_[i].vs0);          \
    *(bf16x8*)((char*)V_lds + (b) * SHM_V + vst1) = St::tobf(sr_[i].vs1); int kc = sc * 2;               \
    *(bf16x8*)((char*)K_lds + (b) * SHM_K + KSWZ(sr, kc)) = St::tobf(sr_[i].ks0);                       \
    *(bf16x8*)((char*)K_lds + (b) * SHM_K + KSWZ(32 + sr, kc)) = St::tobf(sr_[i].ks1); } while (0)
#define SWAIT() do { if constexpr (SDEPTH == 2) asm volatile("s_waitcnt vmcnt(4)" ::: "memory"); else asm volatile("s_waitcnt vmcnt(0)" ::: "memory"); } while (0)
#define RESC(a) do { if (__any((a) < 1.f)) { if (hi == 0) al_l[r32] = (a); asm volatile("s_waitcnt lgkmcnt(0)" ::: "memory"); \
    for (int d = 0; d < 4; ++d) for (int r = 0; r < 16; ++r) o[d][r] *= al_l[crow(r, hi)]; } } while (0)
  f32x16 pA0, pA1, pB0, pB1; float mnA, mnB, alA, alB; bf16x8 pa0, pa1, pa2, pa3; const int NT = seq / KVBLK;
  constexpr int SE = 0, SO = SDEPTH - 1;
  SLOAD(SE, 0); asm volatile("s_waitcnt vmcnt(0)" ::: "memory"); SWRITE(0, SE); __syncthreads();
  qkt(pA0, pA1, K_lds, qr, r32, hi); partialSM(pA0, pA1, m_reg, mnA, alA);
  SLOAD(SO, KVBLK); if constexpr (SDEPTH == 2) { if (2 < NT) SLOAD(SE, 2 * KVBLK); }
  SWAIT(); SWRITE(1, SO); __syncthreads();
  for (int j = 1; j + 1 < NT; j += 2) {
    SBAR(); qkt(pB0, pB1, (bf16*)((char*)K_lds + SHM_K), qr, r32, hi);
    finishSM(pA0, pA1, alA, l_reg, pa0, pa1, pa2, pa3); SBAR();
    SLOAD(SO, (j + SDEPTH) * KVBLK); SBAR();
    pv_d0(o, vb0, pa0, pa1, pa2, pa3); partialSM(pB0, pB1, m_reg, mnB, alB);
    __syncthreads(); SWAIT(); SWRITE(0, SE);
    RESC(alB); __syncthreads();
    SBAR(); qkt(pA0, pA1, K_lds, qr, r32, hi);
    finishSM(pB0, pB1, alB, l_reg, pa0, pa1, pa2, pa3); SBAR();
    if (SDEPTH == 1 || j + 3 < NT) SLOAD(SE, (j + 1 + SDEPTH) * KVBLK); SBAR();
    pv_d0(o, vb0 + (int)SHM_V, pa0, pa1, pa2, pa3); partialSM(pA0, pA1, m_reg, mnA, alA);
    __syncthreads(); SWAIT(); SWRITE(1, SO);
    RESC(alA); __syncthreads();
  }
  SBAR(); qkt(pB0, pB1, (bf16*)((char*)K_lds + SHM_K), qr, r32, hi);
  finishSM(pA0, pA1, alA, l_reg, pa0, pa1, pa2, pa3); SBAR();
  pv_d0(o, vb0, pa0, pa1, pa2, pa3); partialSM(pB0, pB1, m_reg, mnB, alB);
  __syncthreads(); RESC(alB);
  finishSM(pB0, pB1, alB, l_reg, pa0, pa1, pa2, pa3); SBAR();
  pv_d0(o, vb0 + (int)SHM_V, pa0, pa1, pa2, pa3);
  if (hi == 0) li_l[r32] = l_reg; asm volatile("s_waitcnt lgkmcnt(0)" ::: "memory");
  float rli[16];
#pragma unroll
  for (int r = 0; r < 16; ++r) rli[r] = __builtin_amdgcn_rcpf(li_l[crow(r, hi)]);
  if (Of) { float* Ow = Of + (long)(wid * QBLK) * LDOF;
#pragma unroll
    for (int r = 0; r < 16; ++r) { int orow = crow(r, hi);
#pragma unroll
      for (int d0 = 0; d0 < 4; ++d0) Ow[(long)orow * LDOF + d0 * 32 + r32] = o[d0][r] * rli[r]; }
  } else { unsigned short* Ow = (unsigned short*)Ob16 + (long)(wid * QBLK) * LDOB;
#pragma unroll
    for (int r = 0; r < 16; ++r) { int orow = crow(r, hi);
#pragma unroll
      for (int d0 = 0; d0 < 4; ++d0) Ow[(long)orow * LDOB + d0 * 32 + r32] = (unsigned short)(cvtpk(o[d0][r] * rli[r], 0.f) & 0xffffu); }
  }
#undef SLOAD
#undef SWRITE
#undef SWAIT
#undef RESC
}

}
#define GAS __attribute__((address_space(1)))
#define LAS __attribute__((address_space(3)))
typedef unsigned short bf16_t;
typedef unsigned u32x4v __attribute__((ext_vector_type(4)));
typedef unsigned v4u __attribute__((ext_vector_type(4)));
typedef float f32x4 __attribute__((ext_vector_type(4)));
typedef short bf16x8 __attribute__((ext_vector_type(8)));
typedef GAS unsigned gu32;
typedef GAS unsigned long long gu64;
#define RLX_AGENT __ATOMIC_RELAXED, __HIP_MEMORY_SCOPE_AGENT
#define LDS_WAIT() asm volatile("s_waitcnt lgkmcnt(0)" ::: "memory")
#define VM_WAIT() asm volatile("s_waitcnt vmcnt(0)" ::: "memory")
__device__ __forceinline__ unsigned long long rt() { return __builtin_amdgcn_s_memrealtime(); }
__device__ __forceinline__ unsigned f2bf(float f) { unsigned u = __builtin_bit_cast(unsigned, f); return (u + 0x7fffu + ((u >> 16) & 1u)) >> 16; }
__device__ __forceinline__ unsigned pk2(float lo, float hi) { return f2bf(lo) | (f2bf(hi) << 16); }
#define XB_TMO      128
#define XB_XCNT(j)  (256  + 64 * (j))
#define XB_XSUB(j)  (1280 + 64 * (j))
#define XB_XGEN(j)  (2304 + 64 * (j))
#define XB_TOP      3328
#define XB_TOPGEN   3392
#define XCD_BAR_WORDS 3456
#define XB_SPIN_CAP (1u << 18)

__device__ __forceinline__ unsigned xb_ld(unsigned* p)              { return __hip_atomic_load(p, __ATOMIC_RELAXED, __HIP_MEMORY_SCOPE_AGENT); }
__device__ __forceinline__ unsigned xb_add(unsigned* p, unsigned v) { return __hip_atomic_fetch_add(p, v, __ATOMIC_RELAXED, __HIP_MEMORY_SCOPE_AGENT); }
__device__ __forceinline__ unsigned xb_xcc_id() { return (unsigned)__builtin_amdgcn_s_getreg((3 << 11) | 20) & 0xFu; }
#define XB_SPIN(cond, bar) do { unsigned _sp = 0; while (cond) { __builtin_amdgcn_s_sleep(1); \
    if ((++_sp & 255u) == 0u) { if (xb_ld(&(bar)[XB_TMO])) break; if (_sp > XB_SPIN_CAP) { atomicAdd(&(bar)[XB_TMO], 1u); break; } } } } while (0)

struct XcdBarrier {
    unsigned* bar; unsigned x;
    volatile LAS unsigned* st;
};

__device__ __forceinline__ XcdBarrier xcd_barrier_post(unsigned* bar, volatile LAS unsigned* st) {
    XcdBarrier b; b.bar = bar; b.x = xb_xcc_id(); b.st = st;
    if (threadIdx.x == 0) (void)xb_add(&bar[XB_XCNT(b.x)], 1u);
    return b;
}
__device__ __forceinline__ void xcd_barrier_complete(unsigned* bar, unsigned x, unsigned& nloc, unsigned& nx) {
    const unsigned G = gridDim.x * gridDim.y * gridDim.z;
    unsigned sum, cnt, mine, sp = 0u;
    for (;;) {
        sum = 0u; cnt = 0u; mine = 0u;
#pragma unroll
        for (unsigned j = 0; j < 16; ++j) { const unsigned c = xb_ld(&bar[XB_XCNT(j)]); sum += c; cnt += (c > 0u) ? 1u : 0u; mine = (j == x) ? c : mine; }
        if (sum == G) break;
        __builtin_amdgcn_s_sleep(1);
        if ((++sp & 255u) == 0u) { if (xb_ld(&bar[XB_TMO])) break; if (sp > XB_SPIN_CAP) { atomicAdd(&bar[XB_TMO], 1u); break; } }
    }
    nloc = mine > 0u ? mine : 1u; nx = cnt > 0u ? cnt : 1u;
}

__device__ __forceinline__ void xcd_barrier(const XcdBarrier& b) {
    asm volatile("s_waitcnt vmcnt(0)" ::: "memory");
    __syncthreads();
    if (threadIdx.x == 0) {
        unsigned* bar = b.bar;
        __builtin_amdgcn_s_waitcnt(0);
        unsigned nloc = b.st[0], nx = b.st[1];
        if (nloc == 0u) { xcd_barrier_complete(bar, b.x, nloc, nx); b.st[0] = nloc; b.st[1] = nx; }
        const unsigned old = xb_add(&bar[XB_XSUB(b.x)], 1u);
        const unsigned gen = old / nloc;
        if (old + 1u == (gen + 1u) * nloc) {
            __builtin_amdgcn_fence(__ATOMIC_RELEASE, "agent");
            asm volatile("s_waitcnt vmcnt(0)" ::: "memory");
            const unsigned og = xb_add(&bar[XB_TOP], 1u);
            const unsigned tg = og / nx;
            if (og + 1u == (tg + 1u) * nx) xb_add(&bar[XB_TOPGEN], 1u);
            else XB_SPIN(xb_ld(&bar[XB_TOPGEN]) == tg, bar);
            __builtin_amdgcn_fence(__ATOMIC_ACQUIRE, "agent");
            xb_add(&bar[XB_XGEN(b.x)], 1u);
            asm volatile("s_waitcnt vmcnt(0)" ::: "memory");
        } else {
            XB_SPIN(xb_ld(&bar[XB_XGEN(b.x)]) == gen, bar);
            __builtin_amdgcn_fence(__ATOMIC_ACQUIRE, "agent");
            asm volatile("s_waitcnt vmcnt(0)" ::: "memory");
        }
    }
    __syncthreads();
}


constexpr int DM = 2048, NB = 4, SEQL = 4096, CTXL = 256, SPB = 4352, R = NB * SPB, FF = 5632, INC = 3584, NMOD = 9, MODW = NMOD * DM;
constexpr int S5G = 32, S5P = 64, S5H = 16, TCH = 64, NCH = 68, RCP = 512, RCV = 272, KS5 = 1280;
constexpr float EPS = 1e-6f;
constexpr int NWAVES = 8;
constexpr size_t MiB = 1u << 20;
constexpr size_t WS_CTL = 0, CTL_ZERO_BYTES = 1 * MiB;
constexpr size_t WS_MODV = 1 * MiB;
constexpr size_t WS_APOW = 2 * MiB;
constexpr size_t WS_BBAR = 7 * MiB;
constexpr size_t WS_ROPE = 6 * MiB + 512 * 1024;
constexpr size_t WS_KTAB = 8 * MiB;
constexpr size_t WS_WGU = 16 * MiB;
constexpr size_t WS_WD = 192 * MiB;
constexpr size_t WS_WIN = 280 * MiB;
constexpr size_t WS_WOUT = 308 * MiB;
constexpr size_t WS_GLU = 324 * MiB;
constexpr size_t WS_TZE = 326 * MiB;
constexpr size_t WS_SM = 486 * MiB;
constexpr size_t WS_XS = 518 * MiB;
constexpr size_t WS_H = 654 * MiB;
constexpr size_t WS_HACT = 722 * MiB;
constexpr size_t WS_P = 722 * MiB;
constexpr size_t WS_KA = 841 * MiB;
constexpr size_t WS_OD = 867 * MiB;
constexpr size_t WS_MIX = 935 * MiB;
constexpr size_t WS_UG = 1003 * MiB;
constexpr size_t WS_SST = 1043 * MiB;
constexpr size_t WS_YG = 1059 * MiB;
constexpr size_t WS_END = 1076 * MiB;
constexpr int CW_BAR = 4096;
constexpr int RING_BYTES = 131072, LDSCTL_OFF = RING_BYTES, MISC_OFF = LDSCTL_OFF + 320, PTR_OFF = MISC_OFF + 128, LDS_BYTES = 147456;
constexpr int NPH = 28;
#ifndef MK_N_LAUNCHES
#define MK_N_LAUNCHES 1
#endif

typedef float f32x2v __attribute__((ext_vector_type(2)));
__device__ __forceinline__ float wave_sum(float v) {
#pragma unroll
    for (int o = 1; o < 64; o <<= 1) v += __shfl_xor(v, o);
    return v;
}
__device__ __forceinline__ float bflo(unsigned w) { return __uint_as_float(w << 16); }
__device__ __forceinline__ float bfhi(unsigned w) { return __uint_as_float(w & 0xffff0000u); }
__device__ __forceinline__ unsigned cvtpk2(float lo, float hi) { unsigned r; asm volatile("v_cvt_pk_bf16_f32 %0, %1, %2" : "=v"(r) : "v"(lo), "v"(hi)); return r; }
__device__ __forceinline__ float sigmoidf_fast(float z) { return __builtin_amdgcn_rcpf(1.f + __builtin_amdgcn_exp2f(-1.4426950408889634f * z)); }

namespace pg8 {
struct EpiGU { static constexpr bool PERM = true, AFTER_DRAIN = false; bf16_t* O;
    __device__ __forceinline__ void operator()(const f32x4 (&acc)[2][2][4][2], const Unit& u, int wr, int wc, int fr, int fq) const {
        const int row0 = u.pm * BM + wr * 64 + fr, col0 = u.pn * HALF + wc * 32 + 8 * fq;
#pragma unroll
        for (int ai = 0; ai < 2; ++ai)
#pragma unroll
            for (int m = 0; m < 4; ++m) { bf16_t* rowp = O + (size_t)(row0 + ai * HALF + m * 16) * FF + col0;
                float o[8];
#pragma unroll
                for (int n = 0; n < 2; ++n)
#pragma unroll
                    for (int i = 0; i < 4; ++i) { const float g = acc[ai][0][m][n][i], up = acc[ai][1][m][n][i]; o[4 * n + i] = g * up * sigmoidf_fast(g); }
                u32x4 w; w.x = cvt_pk_bf16(o[0], o[1]); w.y = cvt_pk_bf16(o[2], o[3]); w.z = cvt_pk_bf16(o[4], o[5]); w.w = cvt_pk_bf16(o[6], o[7]);
                *(u32x4*)rowp = w; }
    }
};
struct EpiResid { static constexpr bool PERM = false, AFTER_DRAIN = false; float* X; const float* gate; float coef;
    __device__ __forceinline__ void operator()(const f32x4 (&acc)[2][2][4][2], const Unit& u, int wr, int wc, int fr, int fq) const {
        const int bb = u.pm / 17, jj = u.pm % 17, midx = jj == 0 ? 4 : bb;
        const int col0 = u.pn * BM + wc * 32 + 4 * fq; const float* gv = gate + (size_t)midx * MODW + col0;
        f32x4 gt[2][2];
#pragma unroll
        for (int bj = 0; bj < 2; ++bj)
#pragma unroll
            for (int n = 0; n < 2; ++n) gt[bj][n] = *(const f32x4*)(gv + bj * HALF + n * 16) * coef;
#pragma unroll
        for (int ai = 0; ai < 2; ++ai)
#pragma unroll
            for (int m = 0; m < 4; ++m) { float* rowp = X + (size_t)(u.pm * BM + ai * HALF + wr * 64 + m * 16 + fr) * DM + col0;
#pragma unroll
                for (int bj = 0; bj < 2; ++bj)
#pragma unroll
                    for (int n = 0; n < 2; ++n) { f32x4* p = (f32x4*)(rowp + bj * HALF + n * 16); *p = *p + gt[bj][n] * acc[ai][bj][m][n]; } }
    }
};
struct EpiWin { static constexpr bool PERM = true, AFTER_DRAIN = false; bf16_t* P; bf16_t* UG;
    __device__ __forceinline__ void operator()(const f32x4 (&acc)[2][2][4][2], const Unit& u, int wr, int wc, int fr, int fq) const {
        const int row0 = u.pm * BM + wr * 64 + fr, col0 = u.pn * BM + wc * 32 + 8 * fq;
#pragma unroll
        for (int ai = 0; ai < 2; ++ai)
#pragma unroll
            for (int m = 0; m < 4; ++m) { const int row = row0 + ai * HALF + m * 16;
                const int b = row / SPB, s = row % SPB, rc = b * NCH + (s >> 6), j = s & 63;
#pragma unroll
                for (int bj = 0; bj < 2; ++bj) { const f32x4 v0 = acc[ai][bj][m][0], v1 = acc[ai][bj][m][1];
                    u32x4 w; w.x = cvt_pk_bf16(v0[0], v0[1]); w.y = cvt_pk_bf16(v0[2], v0[3]); w.z = cvt_pk_bf16(v1[0], v1[1]); w.w = cvt_pk_bf16(v1[2], v1[3]);
                    const int col = col0 + bj * HALF;
                    if (u.pn < 2) { const int g = col >> 4, ho0 = col & 15; *(u32x4*)(UG + (size_t)(g * RCP + rc) * KS5 + j * 16 + ho0) = w; }
                    else *(u32x4*)(P + (size_t)row * INC + col) = w; } }
    }
};
struct EpiS5State { static constexpr bool PERM = false, AFTER_DRAIN = false; float* SST;
    __device__ __forceinline__ void operator()(const f32x4 (&acc)[2][2][4][2], const Unit& u, int wr, int wc, int fr, int fq) const {
        const int col0 = wc * 32 + 4 * fq;
#pragma unroll
        for (int ai = 0; ai < 2; ++ai)
#pragma unroll
            for (int m = 0; m < 4; ++m) { float* rowp = SST + (size_t)(u.pm * BM + ai * HALF + wr * 64 + m * 16 + fr) * 256 + col0;
#pragma unroll
                for (int bj = 0; bj < 2; ++bj)
#pragma unroll
                    for (int n = 0; n < 2; ++n) *(f32x4*)(rowp + bj * HALF + n * 16) = acc[ai][bj][m][n]; }
    }
};
struct EpiS5Out { static constexpr bool PERM = true, AFTER_DRAIN = false; const bf16_t* UG; const float* dskip; bf16_t* YG;
    __device__ __forceinline__ void operator()(const f32x4 (&acc)[2][2][4][2], const Unit& u, int wr, int wc, int fr, int fq) const {
        const int g = u.pm >> 1, pmr = u.pm & 1, pnr = u.pn & 3;
#pragma unroll
        for (int bj = 0; bj < 2; ++bj) { const int cn8 = 256 * pnr + 128 * bj + 32 * wc + 8 * fq, l = cn8 >> 4, ho0 = cn8 & 15;
            const f32x4 d0 = *(const f32x4*)(dskip + g * 16 + ho0), d1 = *(const f32x4*)(dskip + g * 16 + ho0 + 4);
#pragma unroll
            for (int ai = 0; ai < 2; ++ai)
#pragma unroll
                for (int m = 0; m < 4; ++m) { const int rc = 256 * pmr + 128 * ai + 64 * wr + 16 * m + fr;
                    if (rc < RCV) { const int b = rc / NCH, c = rc % NCH; const size_t row = (size_t)b * SPB + c * 64 + l;
                        const u32x4 uu = *(const u32x4*)(UG + (size_t)(g * RCP + rc) * KS5 + cn8);
                        float y[8];
                        y[0] = acc[ai][bj][m][0][0] + d0[0] * bflo(uu.x); y[1] = acc[ai][bj][m][0][1] + d0[1] * bfhi(uu.x);
                        y[2] = acc[ai][bj][m][0][2] + d0[2] * bflo(uu.y); y[3] = acc[ai][bj][m][0][3] + d0[3] * bfhi(uu.y);
                        y[4] = acc[ai][bj][m][1][0] + d1[0] * bflo(uu.z); y[5] = acc[ai][bj][m][1][1] + d1[1] * bfhi(uu.z);
                        y[6] = acc[ai][bj][m][1][2] + d1[2] * bflo(uu.w); y[7] = acc[ai][bj][m][1][3] + d1[3] * bfhi(uu.w);
#pragma unroll
                        for (int i = 0; i < 8; ++i) { const float v = y[i]; y[i] = v * sigmoidf_fast(1.5957691216057308f * (v + 0.044715f * v * v * v)); }
                        u32x4 w; w.x = cvt_pk_bf16(y[0], y[1]); w.y = cvt_pk_bf16(y[2], y[3]); w.z = cvt_pk_bf16(y[4], y[5]); w.w = cvt_pk_bf16(y[6], y[7]);
                        *(u32x4*)(YG + row * 512 + g * 16 + ho0) = w; } } }
    }
};
struct EpiGLU { static constexpr bool PERM = true, AFTER_DRAIN = false; const bf16_t* YG; const float* gb; bf16_t* MIX;
    __device__ __forceinline__ void operator()(const f32x4 (&acc)[2][2][4][2], const Unit& u, int wr, int wc, int fr, int fq) const {
        const int row0 = u.pm * BM + wr * 64 + fr, col0 = u.pn * BM + wc * 32 + 8 * fq;
#pragma unroll
        for (int bj = 0; bj < 2; ++bj) { const int col = col0 + bj * HALF; const f32x4 b0 = *(const f32x4*)(gb + col), b1 = *(const f32x4*)(gb + col + 4);
#pragma unroll
            for (int ai = 0; ai < 2; ++ai)
#pragma unroll
                for (int m = 0; m < 4; ++m) { const size_t row = (size_t)(row0 + ai * HALF + m * 16);
                    const u32x4 yy = *(const u32x4*)(YG + row * 512 + col);
                    const f32x4 z0 = acc[ai][bj][m][0] + b0, z1 = acc[ai][bj][m][1] + b1;
                    float o[8];
                    o[0] = bflo(yy.x) * sigmoidf_fast(z0[0]); o[1] = bfhi(yy.x) * sigmoidf_fast(z0[1]); o[2] = bflo(yy.y) * sigmoidf_fast(z0[2]); o[3] = bfhi(yy.y) * sigmoidf_fast(z0[3]);
                    o[4] = bflo(yy.z) * sigmoidf_fast(z1[0]); o[5] = bfhi(yy.z) * sigmoidf_fast(z1[1]); o[6] = bflo(yy.w) * sigmoidf_fast(z1[2]); o[7] = bfhi(yy.w) * sigmoidf_fast(z1[3]);
                    u32x4 w; w.x = cvt_pk_bf16(o[0], o[1]); w.y = cvt_pk_bf16(o[2], o[3]); w.z = cvt_pk_bf16(o[4], o[5]); w.w = cvt_pk_bf16(o[6], o[7]);
                    *(u32x4*)(MIX + row * DM + col) = w; } }
    }
};
struct S5StateOrder { int G, c;
    __device__ bool next(int i, Unit& u) const { const int L = i * G + c; if (L >= 64) return false; u.pm = L; u.pn = L >> 1; return true; }
    __device__ __forceinline__ void a_ready(const Unit&) const {}
    __device__ __forceinline__ void done(const Unit&) const {}
};
struct S5OutOrder { int G, c;
    __device__ bool next(int i, Unit& u) const { const int L = i * G + c; if (L >= 256) return false; const int g = L >> 3, rem = L & 7; u.pm = 2 * g + (rem & 1); u.pn = 4 * g + (rem >> 1); return true; }
    __device__ __forceinline__ void a_ready(const Unit&) const {}
    __device__ __forceinline__ void done(const Unit&) const {}
};
}

__device__ __forceinline__ void transpose_item(const float* W, int K, int N, bf16_t* WT, int k0, int n0, int rowbase, LAS float* scr, int lane) {
#pragma unroll 8
    for (int i = 0; i < 32; ++i) { const int kk = 2 * i + (lane >> 5); scr[kk * 33 + (lane & 31)] = W[(size_t)(k0 + kk) * N + n0 + (lane & 31)]; }
    LDS_WAIT(); asm volatile("" ::: "memory");
    const int c = lane & 7;
#pragma unroll
    for (int j = 0; j < 4; ++j) { const int n = (lane >> 3) + 8 * j; const LAS float* s = scr + (8 * c) * 33 + n;
        v4u o; o.x = pk2(s[0 * 33], s[1 * 33]); o.y = pk2(s[2 * 33], s[3 * 33]); o.z = pk2(s[4 * 33], s[5 * 33]); o.w = pk2(s[6 * 33], s[7 * 33]);
        *(GAS v4u*)(WT + (size_t)(rowbase + n) * K + k0 + 8 * c) = o; }
    LDS_WAIT(); asm volatile("" ::: "memory");
}
__device__ __forceinline__ void norm_mod_rows(const float* XS, bf16_t* H, const float* g, const float* modl, int modk, int gw, int NGW, int lane) {
    for (int r = gw; r < R; r += NGW) {
        const int b = r / SPB, s = r % SPB, midx = s < CTXL ? 4 : b;
        const float* sh = modl + (size_t)midx * MODW + (3 * modk) * DM; const float* sc = sh + DM;
        const f32x4* xr = (const f32x4*)(XS + (size_t)r * DM) + lane;
        f32x4 v[8]; float ss = 0.f;
#pragma unroll
        for (int j = 0; j < 8; ++j) { v[j] = xr[64 * j]; ss += (v[j].x * v[j].x + v[j].y * v[j].y) + (v[j].z * v[j].z + v[j].w * v[j].w); }
        const float rstd = 1.f / sqrtf(wave_sum(ss) * (1.f / DM) + EPS);
        unsigned long long* o8 = (unsigned long long*)(H + (size_t)r * DM) + lane;
#pragma unroll
        for (int j = 0; j < 8; ++j) { const int col = 4 * (lane + 64 * j);
            const f32x4 gg = *(const f32x4*)(g + col), s1 = *(const f32x4*)(sc + col), s0 = *(const f32x4*)(sh + col);
            const f32x4 o = (v[j] * rstd * gg) * (s1 + 1.f) + s0;
            o8[64 * j] = (unsigned long long)cvtpk2(o.x, o.y) | ((unsigned long long)cvtpk2(o.z, o.w) << 32); }
    }
}
__device__ __forceinline__ void unpack8(const u32x4v w, float (&f)[8]) {
    f[0] = bflo(w.x); f[1] = bfhi(w.x); f[2] = bflo(w.y); f[3] = bfhi(w.y); f[4] = bflo(w.z); f[5] = bfhi(w.z); f[6] = bflo(w.w); f[7] = bfhi(w.w);
}
__device__ __forceinline__ u32x4v pack8(const float (&f)[8]) { u32x4v w; w.x = cvtpk2(f[0], f[1]); w.y = cvtpk2(f[2], f[3]); w.z = cvtpk2(f[4], f[5]); w.w = cvtpk2(f[6], f[7]); return w; }
template <int XORL> __device__ __forceinline__ void rope8(float (&f)[8], bool first, const f32x2v* tab) {
#pragma unroll
    for (int e = 0; e < 8; ++e) {
        const f32x2v cs = tab[e];
        const float other = __shfl_xor(f[e], XORL);
        f[e] = first ? (f[e] * cs.x - other * cs.y) : (other * cs.y + f[e] * cs.x);
    }
}
__device__ __forceinline__ const void* ldptr(LAS unsigned char* ldsl, int i) {
    const unsigned long long v = *(volatile LAS unsigned long long*)(ldsl + PTR_OFF + 8 * i);
    const unsigned lo = __builtin_amdgcn_readfirstlane((unsigned)v), hi = __builtin_amdgcn_readfirstlane((unsigned)(v >> 32));
    return (const void*)(const GAS void*)(((unsigned long long)hi << 32) | lo);
}
struct Args { const float* in[27]; float* out; unsigned char* ws; int ph_lo, ph_hi; };
__global__ void __launch_bounds__(NWAVES * 64, 2) mega_fwd(Args args) {
    extern __shared__ __attribute__((aligned(16))) unsigned char lds[];
    LAS unsigned char* const ldsl = (LAS unsigned char*)lds;
    const int tid = threadIdx.x;
#define PH_IDS int tid_l = threadIdx.x; asm volatile("" : "+v"(tid_l)); const int tid = tid_l, lane = tid & 63, wave = __builtin_amdgcn_readfirstlane(tid >> 6); \
    int G_l = gridDim.x, bx_l = blockIdx.x; asm volatile("" : "+s"(G_l), "+s"(bx_l)); const int G = G_l, bx = bx_l, vcu = (G % 8 == 0) ? (bx % 8) * (G / 8) + bx / 8 : bx; \
    const int gw = vcu * NWAVES + wave, NGW = G * NWAVES; (void)lane; (void)gw; (void)NGW; (void)vcu; (void)bx; (void)tid;
    for (int u = tid; u < (LDS_BYTES - LDSCTL_OFF) / 4; u += NWAVES * 64) ((LAS unsigned*)(ldsl + LDSCTL_OFF))[u] = 0u;
    __syncthreads();
    if (tid < 27) ((LAS unsigned long long*)(ldsl + PTR_OFF))[tid] = (unsigned long long)args.in[tid];
    if (tid == 27) ((LAS unsigned long long*)(ldsl + PTR_OFF))[27] = (unsigned long long)args.out;
    if (tid == 28) ((LAS unsigned long long*)(ldsl + PTR_OFF))[28] = (unsigned long long)args.ws;
    __syncthreads();
#define INP(i) ((const float*)ldptr(ldsl, (i)))
#define WSP() ((unsigned char*)ldptr(ldsl, 28))
#define WS_F32(off) ((float*)(ws + (off)))
#define WS_BF(off) ((bf16_t*)(ws + (off)))
    XcdBarrier bar; bar.bar = (unsigned*)(args.ws + WS_CTL) + CW_BAR; bar.x = 0; bar.st = nullptr;
    if (MK_N_LAUNCHES == 1) bar = xcd_barrier_post((unsigned*)(args.ws + WS_CTL) + CW_BAR, (volatile LAS unsigned*)(ldsl + MISC_OFF) + 8);
    const int lo = args.ph_lo, hi = args.ph_hi; int ph = 0;
#define PH_ON (ph >= lo && ph < hi)
#define PH_END do { if (ph >= lo && ph + 1 < hi) xcd_barrier(bar); asm volatile("" ::: "memory"); ++ph; } while (0)
    if (PH_ON) { PH_IDS
        unsigned char* const ws = WSP();
        {   const float* const c_in = INP(1); const float* const cctx_in = INP(3); const float* const ada_w = INP(4); const float* const ada_b = INP(5); float* const MODV = WS_F32(WS_MODV);
            LAS float* sl = (LAS float*)ldsl;
            LAS float* part = (LAS float*)(ldsl + 40960);
            for (int i = tid; i < 5 * DM; i += NWAVES * 64) { const int m = i / DM, k = i % DM; const float v = m < 4 ? c_in[m * DM + k] : cctx_in[k]; sl[i] = v / (1.f + expf(-v)); }
            __syncthreads();
            for (int it = vcu; it < 2 * 288; it += G) {
                const int layer = it / 288, n0 = (it % 288) * 64, kb = wave * 256;
                const float* W = ada_w + (size_t)layer * DM * MODW + (size_t)kb * MODW + n0 + lane;
                float a0 = 0.f, a1 = 0.f, a2 = 0.f, a3 = 0.f, a4 = 0.f;
#pragma unroll 4
                for (int kk = 0; kk < 256; kk += 4) {
                    const float w0 = W[(size_t)(kk + 0) * MODW], w1 = W[(size_t)(kk + 1) * MODW], w2 = W[(size_t)(kk + 2) * MODW], w3 = W[(size_t)(kk + 3) * MODW];
                    const f32x4 s0 = *(const LAS f32x4*)(sl + 0 * DM + kb + kk), s1 = *(const LAS f32x4*)(sl + 1 * DM + kb + kk), s2 = *(const LAS f32x4*)(sl + 2 * DM + kb + kk),
                                s3 = *(const LAS f32x4*)(sl + 3 * DM + kb + kk), s4 = *(const LAS f32x4*)(sl + 4 * DM + kb + kk);
                    a0 += s0.x * w0 + s0.y * w1 + s0.z * w2 + s0.w * w3; a1 += s1.x * w0 + s1.y * w1 + s1.z * w2 + s1.w * w3; a2 += s2.x * w0 + s2.y * w1 + s2.z * w2 + s2.w * w3;
                    a3 += s3.x * w0 + s3.y * w1 + s3.z * w2 + s3.w * w3; a4 += s4.x * w0 + s4.y * w1 + s4.z * w2 + s4.w * w3;
                }
                part[(wave * 5 + 0) * 64 + lane] = a0; part[(wave * 5 + 1) * 64 + lane] = a1; part[(wave * 5 + 2) * 64 + lane] = a2; part[(wave * 5 + 3) * 64 + lane] = a3; part[(wave * 5 + 4) * 64 + lane] = a4;
                __syncthreads();
                if (tid < 320) { const int m = tid >> 6, l = tid & 63; float s = 0.f;
#pragma unroll
                    for (int w = 0; w < 8; ++w) s += part[(w * 5 + m) * 64 + l];
                    MODV[(size_t)(layer * 5 + m) * MODW + n0 + l] = s + ada_b[layer * MODW + n0 + l]; }
                __syncthreads();
            }
        }
        __syncthreads();
        {   LAS float* scr = (LAS float*)(ldsl + wave * 16384);
            bf16_t* const WGU = WS_BF(WS_WGU); bf16_t* const WD = WS_BF(WS_WD); bf16_t* const WIN = WS_BF(WS_WIN); bf16_t* const WOUT = WS_BF(WS_WOUT); bf16_t* const GLUW = WS_BF(WS_GLU);
            constexpr int I_F = 5632, I_FFN = 3 * I_F * 4, I_IN = 3584, I_OUT = 2048, I_GLU = 128, I_L = I_IN + I_OUT + I_GLU, NITEMS = I_FFN + 2 * I_L;
            for (int it = gw; it < NITEMS; it += NGW) {
                if (it < I_FFN) { const int fi = it / (3 * I_F), rem = it % (3 * I_F), kind = rem / I_F, item = rem % I_F;
                    if (kind < 2) { const int nblk = FF / 32, kbk = item / nblk, nb = item % nblk, n0 = 32 * nb;
                        transpose_item(INP(7 + kind) + (size_t)fi * DM * FF, DM, FF, WGU + (size_t)fi * 2 * FF * DM, 64 * kbk, n0, (n0 / 128) * 256 + (n0 % 128) + kind * 128, scr, lane); }
                    else { const int nblk = DM / 32, kbk = item / nblk, nb = item % nblk;
                        transpose_item(INP(9) + (size_t)fi * FF * DM, FF, DM, WD + (size_t)fi * DM * FF, 64 * kbk, 32 * nb, 32 * nb, scr, lane); } }
                else { const int it2 = it - I_FFN, l = it2 / I_L, rem = it2 % I_L;
                    if (rem < I_IN) { const int nblk = INC / 32, kbk = rem / nblk, nb = rem % nblk;
                        transpose_item(INP(10) + (size_t)l * DM * INC, DM, INC, WIN + (size_t)l * INC * DM, 64 * kbk, 32 * nb, 32 * nb, scr, lane); }
                    else if (rem < I_IN + I_OUT) { const int r2 = rem - I_IN, nblk = DM / 32, kbk = r2 / nblk, nb = r2 % nblk;
                        transpose_item(INP(11) + (size_t)l * DM * DM, DM, DM, WOUT + (size_t)l * DM * DM, 64 * kbk, 32 * nb, 32 * nb, scr, lane); }
                    else { const int r2 = rem - I_IN - I_OUT, nblk = 512 / 32, kbk = r2 / nblk, nb = r2 % nblk;
                        transpose_item(INP(20) + (size_t)l * 512 * 512, 512, 512, GLUW + (size_t)l * 512 * 512, 64 * kbk, 32 * nb, 32 * nb, scr, lane); } }
            }
        }
        {   const float* const x_in = INP(0); const float* const ctx_in = INP(2); float* const XS = WS_F32(WS_XS);
            const size_t n4 = (size_t)R * (DM / 4);
            for (size_t i = (size_t)bx * (NWAVES * 64) + tid; i < n4; i += (size_t)G * (NWAVES * 64)) {
                const int r = (int)(i / (DM / 4)), c4 = (int)(i % (DM / 4)), b = r / SPB, s = r % SPB;
                const float* src = s < CTXL ? ctx_in + (size_t)(b * CTXL + s) * DM : x_in + (size_t)(b * SEQL + s - CTXL) * DM;
                ((f32x4*)XS)[i] = ((const f32x4*)src)[c4]; }
        }
        {   f32x2v* const ROPE = (f32x2v*)(ws + WS_ROPE);
            for (int e = bx * (NWAVES * 64) + tid; e < 64 * 48; e += G * (NWAVES * 64)) { const int pos = e / 48, i = e % 48;
                const float freq = i < 16 ? exp2f(-(float)i * (13.287712379549449f / 16.f)) : exp2f(-(float)(i - 16) * (13.287712379549449f / 32.f));
                const float ang = (float)pos * freq; ROPE[e] = (f32x2v){cosf(ang), sinf(ang)}; } }
        {   const float* const p_lre = INP(12); const float* const p_lim = INP(13); const float* const p_ldt = INP(14); const float* const p_bre = INP(15); const float* const p_bim = INP(16);
            f32x2v* const APOW = (f32x2v*)(ws + WS_APOW); f32x2v* const BBAR = (f32x2v*)(ws + WS_BBAR);
        for (int e = bx * (NWAVES * 64) + tid; e < 2 * 2 * S5G * S5P; e += G * (NWAVES * 64)) {
            const float lre = p_lre[e], lim = p_lim[e], dt = expf(p_ldt[e / S5P]);
            const float xr = lre * dt; const double trev = (double)lim * (double)dt * 0.15915494309189535;
            for (int k = 0; k <= 64; ++k) { const double tk = trev * (double)k; const float ang = (float)((tk - floor(tk)) * 6.283185307179586); const float mg = expf(xr * (float)k);
                APOW[(size_t)e * 65 + k] = (f32x2v){mg * cosf(ang), mg * sinf(ang)}; }
            const float y = (float)((trev - floor(trev)) * 6.283185307179586);
            const float er = expm1f(xr), cy = cosf(y), sy = sinf(y), shf = sinf(0.5f * y);
            const float nr = er * cy - 2.f * shf * shf, ni = (er + 1.f) * sy, den = 1.f / (lre * lre + lim * lim);
            const float qr = (nr * lre + ni * lim) * den, qi = (ni * lre - nr * lim) * den;
            for (int h = 0; h < S5H; ++h) { const float br = p_bre[(size_t)e * S5H + h], bi = p_bim[(size_t)e * S5H + h];
                BBAR[(size_t)e * S5H + h] = (f32x2v){qr * br - qi * bi, qr * bi + qi * br}; }
        } }
    }
    PH_END;

    for (int fi = 0; fi < 4; ++fi) {
        const int layer = fi >> 1, which = fi & 1;
        if (PH_ON) { PH_IDS
            unsigned char* const ws = WSP(); const float* const modl = WS_F32(WS_MODV) + (size_t)layer * 5 * MODW;
            norm_mod_rows(WS_F32(WS_XS), WS_BF(WS_H), INP(6) + (size_t)(layer * 3 + which * 2) * DM, modl, which * 2, gw, NGW, lane);
            if (fi == 0) {
                const float* const p_cre = INP(17); const float* const p_cim = INP(18); const f32x2v* const APOW = (const f32x2v*)(ws + WS_APOW); const f32x2v* const BBAR = (const f32x2v*)(ws + WS_BBAR); float* const KTAB = WS_F32(WS_KTAB);
                for (int e = bx * (NWAVES * 64) + tid; e < 2 * S5G * 127 * 256; e += G * (NWAVES * 64)) {
                    const int hi_ = e & 15, ho = (e >> 4) & 15, lagi = (e >> 8) % 127, lg = (e >> 8) / 127, l = lg / S5G, g = lg % S5G, lag = lagi - 63;
                    float acc = 0.f;
#pragma unroll
                    for (int d = 0; d < 2; ++d) { const bool use = d == 0 ? lag >= 0 : lag <= 0; const int k = lag < 0 ? -lag : lag;
                        if (use) { const int base = ((l * 2 + d) * S5G + g);
                            const float* cre = p_cre + ((size_t)base * S5H + ho) * S5P; const float* cim = p_cim + ((size_t)base * S5H + ho) * S5P;
                            for (int p = 0; p < S5P; ++p) { const f32x2v ap = APOW[((size_t)base * S5P + p) * 65 + k], bb = BBAR[((size_t)base * S5P + p) * S5H + hi_];
                                const float wr_ = ap.x * bb.x - ap.y * bb.y, wi_ = ap.x * bb.y + ap.y * bb.x; acc += cre[p] * wr_ - cim[p] * wi_; } } }
                    KTAB[e] = acc; }
            }
        }
        PH_END;
        if (PH_ON) { PH_IDS
            unsigned char* const ws = WSP();
            pg8::Gemm g{WS_BF(WS_H), WS_BF(WS_WGU) + (size_t)fi * 2 * FF * DM, R, 2 * FF, DM, DM, DM}; pg8::StaticOrder S; S.init(R, 2 * FF, G, bx);
            pg8::EpiGU E{WS_BF(WS_HACT)};
            pg8::gemm_phase<pg8::EpiGU, pg8::StaticOrder, true, true>(ldsl, g, S, E);
        }
        PH_END;
        if (PH_ON) { PH_IDS
            unsigned char* const ws = WSP(); const float* const modl = WS_F32(WS_MODV) + (size_t)layer * 5 * MODW;
            pg8::Gemm g{WS_BF(WS_HACT), WS_BF(WS_WD) + (size_t)fi * DM * FF, R, DM, FF, FF, FF}; pg8::StaticOrder S; S.init(R, DM, G, bx);
            pg8::EpiResid E{WS_F32(WS_XS), modl + (size_t)(which * 6 + 2) * DM, 0.5f};
            pg8::gemm_phase<pg8::EpiResid, pg8::StaticOrder, true, true>(ldsl, g, S, E);
        }
        PH_END;
        if (which == 0) {
            if (PH_ON) { PH_IDS
                unsigned char* const ws = WSP(); const float* const modl = WS_F32(WS_MODV) + (size_t)layer * 5 * MODW;
                norm_mod_rows(WS_F32(WS_XS), WS_BF(WS_H), INP(6) + (size_t)(layer * 3 + 1) * DM, modl, 1, gw, NGW, lane);
                if (layer == 0) {
                    const float* const p_cre = INP(17); const float* const p_cim = INP(18); const f32x2v* const APOW = (const f32x2v*)(ws + WS_APOW); const f32x2v* const BBAR = (const f32x2v*)(ws + WS_BBAR);
                    const float* const KTAB = WS_F32(WS_KTAB); bf16_t* const TZE = WS_BF(WS_TZE); bf16_t* const SM = WS_BF(WS_SM);
                    for (int e = bx * (NWAVES * 64) + tid; e < 2 * S5G * 1024 * 160; e += G * (NWAVES * 64)) {
                        const int k8 = e % 160, n = (e / 160) & 1023, lg = e / (160 * 1024), t = n >> 4, ho = n & 15;
                        float o[8];
                        if (k8 < 128) { const int j = k8 >> 1, hi0 = (k8 & 1) * 8; const float* src = KTAB + ((size_t)lg * 127 + (t - j + 63)) * 256 + ho * 16 + hi0;
                            const f32x4 s0 = *(const f32x4*)src, s1 = *(const f32x4*)(src + 4); o[0] = s0.x; o[1] = s0.y; o[2] = s0.z; o[3] = s0.w; o[4] = s1.x; o[5] = s1.y; o[6] = s1.z; o[7] = s1.w; }
                        else { const int q = k8 - 128, d = q >> 4, p0 = (q & 15) * 4, l = lg / S5G, g = lg % S5G, base = (l * 2 + d) * S5G + g, pw = d == 0 ? t + 1 : 64 - t;
                            const float* cre = p_cre + ((size_t)base * S5H + ho) * S5P + p0; const float* cim = p_cim + ((size_t)base * S5H + ho) * S5P + p0;
#pragma unroll
                            for (int pp = 0; pp < 4; ++pp) { const f32x2v ap = APOW[((size_t)base * S5P + p0 + pp) * 65 + pw]; const float cr = cre[pp], ci = cim[pp];
                                o[2 * pp] = cr * ap.x - ci * ap.y; o[2 * pp + 1] = -(cr * ap.y + ci * ap.x); } }
                        *(u32x4v*)(TZE + ((size_t)lg * 1024 + n) * KS5 + k8 * 8) = pack8(o);
                    }
                    for (int e = bx * (NWAVES * 64) + tid; e < 2 * S5G * 256 * 128; e += G * (NWAVES * 64)) {
                        const int k8 = e & 127, n = (e >> 7) & 255, lg = e >> 15, l = lg / S5G, g = lg % S5G, d = n >> 7, p = (n & 127) >> 1, ri = n & 1, j = k8 >> 1, hi0 = (k8 & 1) * 8;
                        const int base = (l * 2 + d) * S5G + g, pw = d == 0 ? 63 - j : j;
                        const f32x2v ap = APOW[((size_t)base * S5P + p) * 65 + pw]; float o[8];
#pragma unroll
                        for (int q = 0; q < 8; ++q) { const f32x2v bb = BBAR[((size_t)base * S5P + p) * S5H + hi0 + q]; o[q] = ri ? (ap.x * bb.y + ap.y * bb.x) : (ap.x * bb.x - ap.y * bb.y); }
                        *(u32x4v*)(SM + ((size_t)lg * 256 + n) * 1024 + k8 * 8) = pack8(o);
                    }
                }
            }
            PH_END;
            if (PH_ON) { PH_IDS
                unsigned char* const ws = WSP();
                pg8::Gemm g{WS_BF(WS_H), WS_BF(WS_WIN) + (size_t)layer * INC * DM, R, INC, DM, DM, DM}; pg8::StaticOrder S; S.init(R, INC, G, bx);
                pg8::EpiWin E{WS_BF(WS_P), WS_BF(WS_UG)};
                pg8::gemm_phase<pg8::EpiWin, pg8::StaticOrder, true, true>(ldsl, g, S, E);
            }
            PH_END;
            if (PH_ON) { PH_IDS
                unsigned char* const ws = WSP();
                {   pg8::Gemm g{WS_BF(WS_UG), WS_BF(WS_SM) + (size_t)layer * S5G * 256 * 1024, S5G * RCP, S5G * 256, 1024, KS5, 1024}; pg8::S5StateOrder S{G, bx};
                    pg8::EpiS5State E{WS_F32(WS_SST)};
                    pg8::gemm_phase<pg8::EpiS5State, pg8::S5StateOrder, true, true>(ldsl, g, S, E); }
                const float* qg = INP(24) + layer * 128; const float* kg = INP(25) + layer * 128;
                const bf16_t* const PB = WS_BF(WS_P); bf16_t* const QA = WS_BF(WS_H); bf16_t* const KA = WS_BF(WS_KA); const f32x2v* const ROPE = (const f32x2v*)(ws + WS_ROPE);
                for (int r = gw; r < R; r += NGW) {
                    const int b = r / SPB, s = r % SPB; const bool lat = s >= CTXL; const int t = lat ? s - CTXL : 0; const f32x2v* const trow = ROPE + (t >> 6) * 48; const f32x2v* const tcol = ROPE + (t & 63) * 48;
                    const bf16_t* pr = PB + (size_t)r * INC; bf16_t* qa = QA + (size_t)r * DM; bf16_t* ka = KA + (size_t)r * 768;
                    const int li8 = lane & 7, li16 = lane & 15; float f[8];
                    {
                        unpack8(*(const u32x4v*)(pr + 512 + 8 * lane), f);
                        if (lat) rope8<2>(f, (li8 & 2) == 0, (li8 < 4 ? trow : tcol) + 8 * (li8 & 1));
#pragma unroll
                        for (int e = 0; e < 8; ++e) f[e] *= 1.4142135623730951f;
                        const int slot = lane >> 3, comp = slot & 1;
                        *(u32x4v*)(qa + slot * 128 + comp * 64 + 8 * li8) = pack8(f);
                        { unsigned z = 0u; asm volatile("" : "+v"(z)); *(u32x4v*)(qa + slot * 128 + (1 - comp) * 64 + 8 * li8) = (u32x4v){z, z, z, z}; }
                        unpack8(*(const u32x4v*)(pr + 1024 + 8 * lane), f);
                        if (lat) rope8<2>(f, (li8 & 2) == 0, (li8 < 4 ? trow : tcol) + 8 * (li8 & 1));
                        *(u32x4v*)(ka + 8 * lane) = pack8(f); }
#pragma unroll
                    for (int ch = 0; ch < 2; ++ch) {
                        unpack8(*(const u32x4v*)(pr + 2048 + ch * 512 + 8 * lane), f);
                        float ss = 0.f;
#pragma unroll
                        for (int e = 0; e < 8; ++e) ss += f[e] * f[e];
                        ss += __shfl_xor(ss, 1); ss += __shfl_xor(ss, 2); ss += __shfl_xor(ss, 4); ss += __shfl_xor(ss, 8);
                        const float rstd = 1.f / sqrtf(ss * (1.f / 128.f) + EPS);
#pragma unroll
                        for (int e = 0; e < 8; ++e) f[e] = f[e] * rstd * qg[8 * li16 + e];
                        if (lat) rope8<4>(f, (li16 & 4) == 0, (li16 < 8 ? trow : tcol) + 16 + 8 * (li16 & 3));
                        *(u32x4v*)(qa + (8 + ch * 4 + (lane >> 4)) * 128 + 8 * li16) = pack8(f); }
                    {
                        const int lk = lane & 31;
                        unpack8(*(const u32x4v*)(pr + 3072 + 8 * lk), f);
                        float ss = 0.f;
#pragma unroll
                        for (int e = 0; e < 8; ++e) ss += f[e] * f[e];
                        ss += __shfl_xor(ss, 1); ss += __shfl_xor(ss, 2); ss += __shfl_xor(ss, 4); ss += __shfl_xor(ss, 8);
                        const float rstd = 1.f / sqrtf(ss * (1.f / 128.f) + EPS);
#pragma unroll
                        for (int e = 0; e < 8; ++e) f[e] = f[e] * rstd * kg[8 * li16 + e];
                        if (lat) rope8<4>(f, (li16 & 4) == 0, (li16 < 8 ? trow : tcol) + 16 + 8 * (li16 & 3));
                        if (lane < 32) *(u32x4v*)(ka + 512 + 8 * lk) = pack8(f); }
                }
            }
            PH_END;
            if (PH_ON) { PH_IDS
                unsigned char* const ws = WSP();
                if (bx < 32) {
                    const f32x2v* const APOW = (const f32x2v*)(ws + WS_APOW); const float* const SST = WS_F32(WS_SST); bf16_t* const UG = WS_BF(WS_UG);
                    const int w8 = bx * NWAVES + wave, b = w8 >> 6, g = (w8 >> 1) & 31, d = w8 & 1, p = lane;
                    const f32x2v aT = APOW[((size_t)((layer * 2 + d) * S5G + g) * S5P + p) * 65 + 64];
                    float rr = 0.f, ri_ = 0.f;
                    for (int cc = 0; cc < 4; ++cc) {
                        f32x2v sv[17];
#pragma unroll
                        for (int q = 0; q < 17; ++q) { const int idx = cc * 17 + q, c = d == 0 ? idx : (idx < 4 ? 3 - idx : 71 - idx);
                            sv[q] = *(const f32x2v*)(SST + (size_t)(g * RCP + b * NCH + c) * 256 + d * 128 + p * 2); }
#pragma unroll
                        for (int q = 0; q < 17; ++q) { const int idx = cc * 17 + q, c = d == 0 ? idx : (idx < 4 ? 3 - idx : 71 - idx);
                            *(unsigned*)(UG + (size_t)(g * RCP + b * NCH + c) * KS5 + 1024 + d * 128 + p * 2) = cvtpk2(rr, ri_);
                            const float nr = aT.x * rr - aT.y * ri_ + sv[q].x, ni = aT.x * ri_ + aT.y * rr + sv[q].y; rr = nr; ri_ = ni; }
                    }
                }
                const bf16_t* const QA = WS_BF(WS_H); const bf16_t* const KA = WS_BF(WS_KA); const bf16_t* const PB = WS_BF(WS_P); float* const OD = WS_F32(WS_OD); bf16_t* const MIX = WS_BF(WS_MIX);
                const int nunits = 1024 + (layer == 0 ? 64 : 0);
                for (int i = 0;; ++i) {
                    const int U = i * G + vcu; if (U >= nunits) break;
                    int b, slot, qrow0, seq;
                    if (U < 1024) { b = U >> 8; slot = (U >> 4) & 15; qrow0 = b * SPB + CTXL + (U & 15) * 256; seq = SPB; }
                    else { const int U2 = U - 1024; b = U2 >> 4; slot = U2 & 15; qrow0 = b * SPB; seq = CTXL; }
                    const int kcol = slot < 8 ? (slot >> 1) * 128 : (4 + ((slot - 8) >> 2)) * 128;
                    const int vcol = slot < 8 ? 1536 + (slot >> 1) * 128 : 3328 + ((slot - 8) >> 2) * 128;
                    __syncthreads();
                    at128::attn_dense_body<DM, 768, INC, 1024, DM>((const at128::bf16*)(QA + (size_t)qrow0 * DM + slot * 128), (const at128::bf16*)(KA + (size_t)b * SPB * 768 + kcol),
                        (const at128::bf16*)(PB + (size_t)b * SPB * INC + vcol), slot < 8 ? OD + (size_t)qrow0 * 1024 + slot * 128 : nullptr,
                        (at128::bf16*)(MIX + (size_t)qrow0 * DM + 1024 + (slot < 8 ? 0 : slot - 8) * 128), seq, (char*)lds);
                }
                __syncthreads();
            }
            PH_END;
            if (PH_ON) { PH_IDS
                unsigned char* const ws = WSP();
                {   pg8::Gemm g{WS_BF(WS_UG), WS_BF(WS_TZE) + (size_t)layer * S5G * 1024 * KS5, S5G * RCP, S5G * 1024, KS5, KS5, KS5}; pg8::S5OutOrder S{G, bx};
                    pg8::EpiS5Out E{WS_BF(WS_UG), INP(19) + layer * 512, WS_BF(WS_YG)};
                    pg8::gemm_phase<pg8::EpiS5Out, pg8::S5OutOrder, true, true>(ldsl, g, S, E); }
                const float* lv = INP(22) + layer * 256; const float* const OD = WS_F32(WS_OD); bf16_t* const MIX = WS_BF(WS_MIX); const float lam_init = layer == 0 ? 0.2f : 0.35550906759f;
                const float lam = expf(wave_sum(lv[lane] * lv[64 + lane])) - expf(wave_sum(lv[128 + lane] * lv[192 + lane])) + lam_init;
                const float* sg = INP(23) + layer * 128; const int li16 = lane & 15, hh = lane >> 4;
                for (int r = gw; r < R; r += NGW) {
                    if (layer == 1 && (r % SPB) < CTXL) continue;
                    const float* o1 = OD + (size_t)r * 1024 + (2 * hh) * 128 + 8 * li16; const float* o2 = o1 + 128;
                    const f32x4 a0 = *(const f32x4*)o1, a1 = *(const f32x4*)(o1 + 4), b0 = *(const f32x4*)o2, b1 = *(const f32x4*)(o2 + 4);
                    float f[8] = {a0.x - lam * b0.x, a0.y - lam * b0.y, a0.z - lam * b0.z, a0.w - lam * b0.w, a1.x - lam * b1.x, a1.y - lam * b1.y, a1.z - lam * b1.z, a1.w - lam * b1.w};
                    float ss = 0.f;
#pragma unroll
                    for (int e = 0; e < 8; ++e) ss += f[e] * f[e];
                    ss += __shfl_xor(ss, 1); ss += __shfl_xor(ss, 2); ss += __shfl_xor(ss, 4); ss += __shfl_xor(ss, 8);
                    const float rstd = (1.f - lam_init) / sqrtf(ss * (1.f / 128.f) + EPS);
#pragma unroll
                    for (int e = 0; e < 8; ++e) f[e] = f[e] * rstd * sg[8 * li16 + e];
                    *(u32x4v*)(MIX + (size_t)r * DM + 512 + hh * 128 + 8 * li16) = pack8(f);
                }
            }
            PH_END;
            if (PH_ON) { PH_IDS
                unsigned char* const ws = WSP();
                pg8::Gemm g{WS_BF(WS_YG), WS_BF(WS_GLU) + (size_t)layer * 512 * 512, R, 512, 512, 512, 512}; pg8::StaticOrder S; S.init(R, 512, G, bx);
                pg8::EpiGLU E{WS_BF(WS_YG), INP(21) + layer * 512, WS_BF(WS_MIX)};
                pg8::gemm_phase<pg8::EpiGLU, pg8::StaticOrder, true, true>(ldsl, g, S, E);
            }
            PH_END;
            if (PH_ON) { PH_IDS
                unsigned char* const ws = WSP(); const float* const modl = WS_F32(WS_MODV) + (size_t)layer * 5 * MODW;
                pg8::Gemm g{WS_BF(WS_MIX), WS_BF(WS_WOUT) + (size_t)layer * DM * DM, R, DM, DM, DM, DM}; pg8::StaticOrder S; S.init(R, DM, G, bx);
                pg8::EpiResid E{WS_F32(WS_XS), modl + (size_t)5 * DM, 1.0f};
                pg8::gemm_phase<pg8::EpiResid, pg8::StaticOrder, true, true>(ldsl, g, S, E);
            }
            PH_END;
        }
    }
    if (PH_ON) { PH_IDS
        unsigned char* const ws = WSP(); const float* fg = INP(26); const float* const XS = WS_F32(WS_XS); float* const outp = (float*)ldptr(ldsl, 27);
        for (int q = gw; q < NB * SEQL; q += NGW) {
            const int b = q / SEQL, t = q % SEQL; const f32x4* xr = (const f32x4*)(XS + (size_t)(b * SPB + CTXL + t) * DM) + lane;
            f32x4 v[8]; float ss = 0.f;
#pragma unroll
            for (int j = 0; j < 8; ++j) { v[j] = xr[64 * j]; ss += (v[j].x * v[j].x + v[j].y * v[j].y) + (v[j].z * v[j].z + v[j].w * v[j].w); }
            const float rstd = 1.f / sqrtf(wave_sum(ss) * (1.f / DM) + EPS);
            f32x4* orow = (f32x4*)(outp + (size_t)q * DM) + lane;
#pragma unroll
            for (int j = 0; j < 8; ++j) orow[64 * j] = v[j] * rstd * *(const f32x4*)(fg + 4 * (lane + 64 * j));
        }
    }
#undef PH_ON
#undef PH_END
}

extern "C" void kernel_launch(void* const* d_in, const int* in_sizes, int n_in, void* d_out, int out_size, void* d_ws, size_t ws_size, hipStream_t stream) {
    static int grid = 0;
    if (grid == 0) {
        if (n_in != 27 || in_sizes[0] != NB * SEQL * DM || out_size != NB * SEQL * DM || ws_size < WS_END) {
            fprintf(stderr, "kernel_launch: shape mismatch: n_in %d in0 %d out %d ws %zu (need %zu)\n", n_in, n_in > 0 ? in_sizes[0] : -1, out_size, ws_size, (size_t)WS_END); grid = -1; return; }
        int dev = 0, cus = 0, per_cu = 0;
        if (hipGetDevice(&dev) != hipSuccess || hipDeviceGetAttribute(&cus, hipDeviceAttributeMultiprocessorCount, dev) != hipSuccess) { fprintf(stderr, "kernel_launch: device query failed\n"); grid = -1; return; }
        if (hipFuncSetAttribute((const void*)mega_fwd, hipFuncAttributeMaxDynamicSharedMemorySize, LDS_BYTES) != hipSuccess) { fprintf(stderr, "kernel_launch: hipFuncSetAttribute failed\n"); grid = -1; return; }
        if (hipOccupancyMaxActiveBlocksPerMultiprocessor(&per_cu, (const void*)mega_fwd, NWAVES * 64, LDS_BYTES) != hipSuccess || per_cu < 1)
            fprintf(stderr, "kernel_launch: note: occupancy query reports %d workgroups per CU\n", per_cu);
        (void)hipGetLastError();
        grid = cus;
    }
    if (grid < 0) return;
    if (hipMemsetAsync((char*)d_ws + WS_CTL, 0, CTL_ZERO_BYTES, stream) != hipSuccess) { fprintf(stderr, "kernel_launch: memset failed\n"); return; }
    Args a{};
    for (int i = 0; i < 27; ++i) a.in[i] = (const float*)d_in[i];
    a.out = (float*)d_out; a.ws = (unsigned char*)d_ws;
#if MK_N_LAUNCHES == 1
    a.ph_lo = 0; a.ph_hi = NPH;
    hipLaunchKernelGGL(mega_fwd, dim3(grid), dim3(NWAVES * 64), LDS_BYTES, stream, a);
#else
    for (int k = 0; k < NPH; ++k) { a.ph_lo = k; a.ph_hi = k + 1; hipLaunchKernelGGL(mega_fwd, dim3(grid), dim3(NWAVES * 64), LDS_BYTES, stream, a); }
#endif
    const hipError_t le = hipPeekAtLastError();
    if (le != hipSuccess) fprintf(stderr, "kernel_launch: launch failed: %s\n", hipGetErrorName(le));
}
```

```cpp
#include <hip/hip_runtime.h>
#include <hip/hip_bf16.h>
#include <cstdio>
#include <cstdint>
#include <cmath>
namespace pg8 {
#define PG8_LAS __attribute__((address_space(3)))
typedef unsigned short bf16_t;
typedef short bf16x8 __attribute__((ext_vector_type(8)));
typedef float f32x4 __attribute__((ext_vector_type(4)));
typedef unsigned u32x4 __attribute__((ext_vector_type(4)));
constexpr int BM = 256, BK = 64, HALF = 128, HTB = HALF * BK * 2  , STAGE_BYTES = 8 * HTB, NXCD = 8, WGM = 8;

__host__ __device__ __forceinline__ int lds_byte(int r, int c) { const int st = (r >> 4) * 2 + (c >> 5), rr = r & 15, cc = c & 31, ob = rr * 64 + cc * 2; return st * 1024 + (ob ^ (((ob >> 9) & 1) << 5)); }
__host__ __device__ __forceinline__ void stage_rc(int b, int& R, int& C) { const int st = b / 1024, sb = b % 1024, swz = sb ^ (((sb >> 9) & 1) << 5); R = (st >> 1) * 16 + swz / 64; C = (st & 1) * 32 + (swz % 64) / 2; }
__host__ __device__ __forceinline__ int perm32(int rho) { const int n = rho >> 4, i = rho & 15; return 8 * (i >> 2) + 4 * n + (i & 3); }

struct Unit { int pm, pn, kofs, ks; };
struct Gemm { const bf16_t* A; const bf16_t* Bt; int M, N, K, lda, ldb; };

struct StaticOrder {
    int nM, nN, nwg, G, c;
    __host__ __device__ void init(int M, int N, int G_, int c_) { nM = M / BM; nN = N / BM; nwg = nM * nN; G = G_; c = c_; }
    __host__ __device__ bool next(int i, Unit& u) const {
        const long L = (long)i * G + c; if (L >= nwg) return false;
        int wgid = (int)L; { const int q = nwg / NXCD, r = nwg % NXCD, xcd = wgid % NXCD, off = wgid / NXCD; wgid = (xcd < r ? xcd * (q + 1) : r * (q + 1) + (xcd - r) * q) + off; }
        const int nig = WGM * nN, gid = wgid / nig, fm = gid * WGM, gsz = (nM - fm) < WGM ? (nM - fm) : WGM;
        u.pm = fm + ((wgid % nig) % gsz); u.pn = (wgid % nig) / gsz; u.kofs = 0; u.ks = 0; return true;
    }
    __device__ __forceinline__ void a_ready(const Unit&) const {}
    __device__ __forceinline__ void done(const Unit&) const {}
};

__device__ __forceinline__ unsigned cvt_pk_bf16(float lo, float hi) { unsigned r; asm volatile("v_cvt_pk_bf16_f32 %0, %1, %2" : "=v"(r) : "v"(lo), "v"(hi)); return r; }
typedef float f32x2 __attribute__((ext_vector_type(2)));
__device__ __forceinline__ f32x2 gelu_pk(f32x2 v) {
    const f32x2 av = __builtin_elementwise_abs(v), d = av * 0.2316418882f + 1.0f;
    f32x2 t; t.x = __builtin_amdgcn_rcpf(d.x); t.y = __builtin_amdgcn_rcpf(d.y);
    f32x2 q = t * 0.5307027145f + (-0.7265760135f); q = q * t + 0.7107068705f; q = q * t + (-0.142248368f); q = q * t + 0.127414796f; q = q * t;
    const f32x2 s = (v * v) * (-0.72134752044f);
    f32x2 e; e.x = __builtin_amdgcn_exp2f(s.x); e.y = __builtin_amdgcn_exp2f(s.y);
    const f32x2 m = v * (q * e), r = v - m;
    f32x2 o; o.x = v.x < 0.f ? m.x : r.x; o.y = v.y < 0.f ? m.y : r.y; return o;
}

template <int ACT  > struct EpiBf16 {
    static constexpr bool PERM = true, AFTER_DRAIN = false; static_assert(ACT == 0 || ACT == 1, "EpiBf16: ACT is 0 (none) or 1 (gelu_pk)");
    bf16_t* O; int ldc; const float* bias; int split_cols; size_t split_stride; float scale0;
    __device__ __forceinline__ void operator()(const f32x4 (&acc)[2][2][4][2], const Unit& u, int wr, int wc, int fr, int fq) const {
        const int row0 = u.pm * BM + wr * 64 + fr; int colt = u.pn * BM; bf16_t* base = O;
        float sc = 1.f; if (split_cols) { const int t = colt / split_cols; base += (size_t)t * split_stride; colt -= t * split_cols; if (t == 0) sc = scale0; }
        const int col0 = colt + wc * 32 + 8 * fq, bcol0 = u.pn * BM + wc * 32 + 8 * fq;
        f32x4 bv[2][2];
#pragma unroll
        for (int bj = 0; bj < 2; ++bj)
#pragma unroll
            for (int n = 0; n < 2; ++n) bv[bj][n] = bias ? *(const f32x4*)(bias + bcol0 + bj * HALF + 4 * n) : (f32x4){0.f, 0.f, 0.f, 0.f};
#pragma unroll
        for (int ai = 0; ai < 2; ++ai)
#pragma unroll
            for (int m = 0; m < 4; ++m) { bf16_t* rowp = base + (size_t)(row0 + ai * HALF + m * 16) * ldc + col0;
#pragma unroll
                for (int bj = 0; bj < 2; ++bj) { f32x4 v0 = acc[ai][bj][m][0] + bv[bj][0], v1 = acc[ai][bj][m][1] + bv[bj][1];
                    if (ACT == 1) { f32x2 a = gelu_pk((f32x2){v0[0], v0[1]}), b = gelu_pk((f32x2){v0[2], v0[3]}), c = gelu_pk((f32x2){v1[0], v1[1]}), d = gelu_pk((f32x2){v1[2], v1[3]});
                        v0 = (f32x4){a.x, a.y, b.x, b.y}; v1 = (f32x4){c.x, c.y, d.x, d.y}; }
                    v0 = v0 * sc; v1 = v1 * sc; u32x4 w; w.x = cvt_pk_bf16(v0[0], v0[1]); w.y = cvt_pk_bf16(v0[2], v0[3]); w.z = cvt_pk_bf16(v1[0], v1[1]); w.w = cvt_pk_bf16(v1[2], v1[3]);
                    *(u32x4*)(rowp + bj * HALF) = w; } }
    }
};


template <class Epi, class Sched, bool ALIGN_EPI = false, bool SP2 = false>
__device__ __forceinline__ void gemm_phase(PG8_LAS unsigned char* lds, const Gemm g, const Sched& S, const Epi& E) {
    int tid_l = threadIdx.x; asm volatile("" : "+v"(tid_l));
    const int tid = tid_l, wid = __builtin_amdgcn_readfirstlane(tid >> 6), lane = tid & 63, wr = wid >> 2, wc = wid & 3, fr = lane & 15, fq = lane >> 4;
    const int K = g.K, nt = K / BK;
    unsigned voffA[2], voffB[2];
#pragma unroll
    for (int i = 0; i < 2; ++i) { int R, C; stage_rc(tid * 16 + i * 8192, R, C); const int Rb = Epi::PERM ? ((R & ~31) + perm32(R & 31)) : R;
        voffA[i] = (unsigned)(R * g.lda + C) * 2u; voffB[i] = (unsigned)(Rb * g.ldb + C) * 2u; }
    const size_t kstep = (size_t)(BK * 2);
    const size_t hstepA = (size_t)HALF * g.lda * 2, hstepB = (size_t)HALF * g.ldb * 2;
    const size_t tstepA = 2 * hstepA, tstepB = 2 * hstepB;
    const unsigned ldsw = (unsigned)wid * 1024u;
    const int aoff = lds_byte(wr * 64 + fr, fq * 8), boff = lds_byte(wc * 32 + fr, fq * 8);
#define PG8_SA(b, h) (((b) * 2 + (h)) * HTB)
#define PG8_SB(b, h) ((4 + (b) * 2 + (h)) * HTB)
#define PG8_STAGE(bufoff, gbase, voff) do { _Pragma("unroll") for (int _i = 0; _i < 2; ++_i) \
        __builtin_amdgcn_global_load_lds((const unsigned*)((const char*)(gbase) + (voff)[_i]), (PG8_LAS unsigned*)(lds + (bufoff) + ldsw + _i * 8192), 16, 0, 0); } while (0)
#define PG8_LDA(dst, b, h) do { _Pragma("unroll") for (int m = 0; m < 4; ++m) _Pragma("unroll") for (int k = 0; k < 2; ++k) dst[m][k] = *(const PG8_LAS bf16x8*)(lds + PG8_SA(b, h) + aoff + m * 2048 + k * 1024); } while (0)
#define PG8_LDB(dst, b, h) do { _Pragma("unroll") for (int n = 0; n < 2; ++n) _Pragma("unroll") for (int k = 0; k < 2; ++k) dst[n][k] = *(const PG8_LAS bf16x8*)(lds + PG8_SB(b, h) + boff + n * 2048 + k * 1024); } while (0)
#define PG8_MMA(ai, bj, At, Bt) do { __builtin_amdgcn_s_setprio(1); _Pragma("unroll") for (int m = 0; m < 4; ++m) _Pragma("unroll") for (int n = 0; n < 2; ++n) _Pragma("unroll") for (int k = 0; k < 2; ++k) \
        acc[ai][bj][m][n] = __builtin_amdgcn_mfma_f32_16x16x32_bf16(Bt[n][k], At[m][k], acc[ai][bj][m][n], 0, 0, 0); __builtin_amdgcn_s_setprio(0); } while (0)
#define PG8_WAIT_V(n) asm volatile("s_waitcnt vmcnt(" #n ")" ::: "memory")
#define PG8_WAIT_L(n) asm volatile("s_waitcnt lgkmcnt(" #n ")" ::: "memory")
#define PG8_BAR __builtin_amdgcn_s_barrier()
#define PG8_SCHED __builtin_amdgcn_sched_barrier(0)
    Unit cur, nxt; int ui = 0;
    if (!S.next(0, cur)) return;
    f32x4 acc[2][2][4][2];
#pragma unroll
    for (int a = 0; a < 2; ++a)
#pragma unroll
        for (int b = 0; b < 2; ++b)
#pragma unroll
            for (int m = 0; m < 4; ++m)
#pragma unroll
                for (int n = 0; n < 2; ++n) acc[a][b][m][n] = (f32x4){0.f, 0.f, 0.f, 0.f};
    bf16x8 At[4][2], B0[2][2], B1[2][2];
    const char* cA = (const char*)g.A + (size_t)cur.pm * tstepA + cur.kofs; const char* cB = (const char*)g.Bt + (size_t)cur.pn * tstepB + cur.kofs;
    S.a_ready(cur);
    if constexpr (SP2) {
        PG8_STAGE(PG8_SB(0, 0), cB, voffB); PG8_STAGE(PG8_SB(0, 1), cB + hstepB, voffB); PG8_STAGE(PG8_SA(0, 0), cA, voffA); PG8_STAGE(PG8_SA(0, 1), cA + hstepA, voffA);
        if (wr == 1) PG8_BAR;
        PG8_WAIT_V(2); PG8_BAR;
        PG8_STAGE(PG8_SB(1, 0), cB + kstep, voffB); PG8_STAGE(PG8_SA(1, 0), cA + kstep, voffA); PG8_STAGE(PG8_SB(1, 1), cB + hstepB + kstep, voffB);
        PG8_WAIT_V(6); PG8_BAR;
    } else {
        PG8_STAGE(PG8_SB(0, 0), cB, voffB); PG8_STAGE(PG8_SA(0, 0), cA, voffA); PG8_STAGE(PG8_SB(0, 1), cB + hstepB, voffB); PG8_STAGE(PG8_SA(0, 1), cA + hstepA, voffA);
        if (wr == 1) PG8_BAR;
        PG8_WAIT_V(4); PG8_BAR;
        PG8_STAGE(PG8_SB(1, 0), cB + kstep, voffB); PG8_STAGE(PG8_SA(1, 0), cA + kstep, voffA); PG8_STAGE(PG8_SB(1, 1), cB + hstepB + kstep, voffB);
        PG8_WAIT_V(6); PG8_BAR;
    }
    for (;;) {
        const bool has_next = S.next(ui + 1, nxt);
        const char* nA = has_next ? (const char*)g.A + (size_t)nxt.pm * tstepA + nxt.kofs : cA; const char* nB = has_next ? (const char*)g.Bt + (size_t)nxt.pn * tstepB + nxt.kofs : cB;
        for (int t = 0; t < nt; t += 2) {
            const bool last = (t == nt - 2);
            const char* a1 = cA + (size_t)(t + 1) * kstep;
            const char* a2 = last ? nA : cA + (size_t)(t + 2) * kstep; const char* b2 = last ? nB : cB + (size_t)(t + 2) * kstep;
            const char* a3 = a2 + kstep; const char* b3 = b2 + kstep;
            if (last && has_next) S.a_ready(nxt);
            if constexpr (SP2) {
            PG8_LDB(B0, 0, 0); PG8_LDB(B1, 0, 1); PG8_SCHED; PG8_LDA(At, 0, 0); PG8_STAGE(PG8_SA(1, 1), a1 + hstepA, voffA);
            PG8_WAIT_V(8); PG8_WAIT_L(0); PG8_BAR; PG8_MMA(0, 0, At, B0); PG8_MMA(0, 1, At, B1); PG8_BAR; PG8_SCHED;
            PG8_LDA(At, 0, 1); PG8_STAGE(PG8_SB(0, 0), b2, voffB); PG8_STAGE(PG8_SB(0, 1), b2 + hstepB, voffB); PG8_STAGE(PG8_SA(0, 0), a2, voffA);
            PG8_WAIT_V(8); PG8_WAIT_L(0); PG8_BAR; PG8_MMA(1, 0, At, B0); PG8_MMA(1, 1, At, B1); PG8_BAR; PG8_SCHED;
            PG8_LDB(B0, 1, 0); PG8_LDB(B1, 1, 1); PG8_SCHED; PG8_LDA(At, 1, 0); PG8_STAGE(PG8_SA(0, 1), a2 + hstepA, voffA);
            PG8_WAIT_V(8); PG8_WAIT_L(0); PG8_BAR; PG8_MMA(0, 0, At, B0); PG8_MMA(0, 1, At, B1); PG8_BAR; PG8_SCHED;
            PG8_LDA(At, 1, 1); PG8_STAGE(PG8_SB(1, 0), b3, voffB); PG8_STAGE(PG8_SB(1, 1), b3 + hstepB, voffB); PG8_STAGE(PG8_SA(1, 0), a3, voffA);
            PG8_WAIT_V(8); PG8_WAIT_L(0); PG8_BAR; PG8_MMA(1, 0, At, B0); PG8_MMA(1, 1, At, B1); PG8_BAR; PG8_SCHED;
            } else {
            PG8_LDB(B0, 0, 0); PG8_SCHED; PG8_LDA(At, 0, 0); PG8_STAGE(PG8_SA(1, 1), a1 + hstepA, voffA);
            PG8_WAIT_L(8); PG8_BAR; PG8_WAIT_L(0); PG8_MMA(0, 0, At, B0); PG8_BAR; PG8_SCHED;
            PG8_LDB(B1, 0, 1); PG8_STAGE(PG8_SB(0, 0), b2, voffB);
            PG8_BAR; PG8_WAIT_L(0); PG8_MMA(0, 1, At, B1); PG8_BAR;
            PG8_LDA(At, 0, 1); PG8_STAGE(PG8_SA(0, 0), a2, voffA);
            PG8_BAR; PG8_WAIT_L(0); PG8_MMA(1, 0, At, B0); PG8_BAR; PG8_SCHED;
            PG8_STAGE(PG8_SB(0, 1), b2 + hstepB, voffB);
            PG8_WAIT_V(6); PG8_BAR; PG8_MMA(1, 1, At, B1); PG8_BAR;
            PG8_LDB(B0, 1, 0); PG8_SCHED; PG8_LDA(At, 1, 0); PG8_STAGE(PG8_SA(0, 1), a2 + hstepA, voffA);
            PG8_WAIT_L(8); PG8_BAR; PG8_WAIT_L(0); PG8_MMA(0, 0, At, B0); PG8_BAR; PG8_SCHED;
            PG8_LDB(B1, 1, 1); PG8_STAGE(PG8_SB(1, 0), b3, voffB);
            PG8_BAR; PG8_WAIT_L(0); PG8_MMA(0, 1, At, B1); PG8_BAR;
            PG8_LDA(At, 1, 1); PG8_STAGE(PG8_SA(1, 0), a3, voffA);
            PG8_BAR; PG8_WAIT_L(0); PG8_MMA(1, 0, At, B0); PG8_BAR; PG8_SCHED;
            PG8_STAGE(PG8_SB(1, 1), b3 + hstepB, voffB);
            PG8_WAIT_V(6); PG8_BAR; PG8_MMA(1, 1, At, B1); PG8_BAR;
            }
        }
        if constexpr (ALIGN_EPI) { if (wr == 0) PG8_BAR; }
        if constexpr (!Epi::AFTER_DRAIN) { E(acc, cur, wr, wc, fr, fq); S.done(cur); }
        if (!has_next) break;
#pragma unroll
        for (int a = 0; a < 2; ++a)
#pragma unroll
            for (int b = 0; b < 2; ++b)
#pragma unroll
                for (int m = 0; m < 4; ++m)
#pragma unroll
                    for (int n = 0; n < 2; ++n) acc[a][b][m][n] = (f32x4){0.f, 0.f, 0.f, 0.f};
        cur = nxt; cA = nA; cB = nB; ++ui;
        if constexpr (ALIGN_EPI) { if (wr == 1) PG8_BAR; }
    }
    PG8_WAIT_V(0);
    if constexpr (!ALIGN_EPI) { if (wr == 0) PG8_BAR; }
    PG8_BAR;
    if constexpr (Epi::AFTER_DRAIN) { E.fused(acc, cur, wr, wc, fr, fq, lds, wid, lane); S.done(cur); }
#undef PG8_SA
#undef PG8_SB
#undef PG8_STAGE
#undef PG8_LDA
#undef PG8_LDB
#undef PG8_MMA
#undef PG8_WAIT_V
#undef PG8_WAIT_L
#undef PG8_BAR
#undef PG8_SCHED
}
}

namespace at128 {
using bf16 = __hip_bfloat16;
constexpr int D = 128, NW = 8, QBLK = 32, KVBLK = 64, SDEPTH = 2;
constexpr float SCALE = 0.088388347648318440f, THR = 8.f;
constexpr size_t SHM_V = KVBLK * D * 2, SHM_K = KVBLK * D * 2, SHM_ATTN = 2 * SHM_V + 2 * SHM_K + NW * 64 * 4;
constexpr int DMA_SCRATCH_OFF = 131072 + 4096;
using bf16x8 = __attribute__((ext_vector_type(8))) short;
using s16x4  = __attribute__((ext_vector_type(4))) short;
using f32x16 = __attribute__((ext_vector_type(16))) float;
using f32x8  = __attribute__((ext_vector_type(8))) float;
using u32x4  = __attribute__((ext_vector_type(4))) unsigned;
#define KSWZ(row, colB) ((row) * 256 + ((colB) ^ (((row) & 7) << 4)))
#define SBAR() __builtin_amdgcn_sched_barrier(0)
__device__ __forceinline__ int crow(int r, int hi) { return (r & 3) + 8 * (r >> 2) + 4 * hi; }
__device__ __forceinline__ unsigned cvtpk(float lo, float hi) {
  unsigned r; asm volatile("v_cvt_pk_bf16_f32 %0, %1, %2" : "=v"(r) : "v"(lo), "v"(hi)); return r;
}
template <typename TIn> struct Stage;
template <> struct Stage<bf16>  { using T = bf16x8;
  __device__ static __forceinline__ T ld8(const bf16* p) { return *reinterpret_cast<const bf16x8*>(p); }
  __device__ static __forceinline__ bf16x8 tobf(T x) { return x; } };
template <> struct Stage<float> { using T = f32x8;
  __device__ static __forceinline__ T ld8(const float* p) { return *reinterpret_cast<const f32x8*>(p); }
  __device__ static __forceinline__ bf16x8 tobf(T x) {
    u32x4 w = {cvtpk(x[0], x[1]), cvtpk(x[2], x[3]), cvtpk(x[4], x[5]), cvtpk(x[6], x[7])}; return *reinterpret_cast<bf16x8*>(&w); } };

__device__ __forceinline__ void partialSM(f32x16& p0, f32x16& p1, float& m_reg, float& mn, float& alpha) {
  constexpr float C = SCALE * 1.4426950408889634f;
  float pmax = p0[0]; for (int r = 1; r < 16; ++r) pmax = fmaxf(pmax, p0[r]); for (int r = 0; r < 16; ++r) pmax = fmaxf(pmax, p1[r]);
  { auto rr = __builtin_amdgcn_permlane32_swap(__float_as_uint(pmax), __float_as_uint(pmax), false, false);
    pmax = fmaxf(__uint_as_float(rr[0]), __uint_as_float(rr[1])); }
  if (__builtin_expect(__all(pmax - m_reg <= THR / SCALE), 1)) { mn = m_reg; alpha = 1.f; }
  else { mn = fmaxf(m_reg, pmax); alpha = __builtin_amdgcn_exp2f((m_reg - mn) * C); m_reg = mn; }
  float mnC = -mn * C;
  for (int r = 0; r < 16; ++r) p0[r] = fmaf(p0[r], C, mnC); for (int r = 0; r < 16; ++r) p1[r] = fmaf(p1[r], C, mnC);
  for (int r = 0; r < 16; ++r) p0[r] = __builtin_amdgcn_exp2f(p0[r]);
}
__device__ __forceinline__ void finishSM(f32x16& p0, f32x16& p1, float alpha, float& l_reg, bf16x8& pa0, bf16x8& pa1, bf16x8& pa2, bf16x8& pa3) {
  for (int r = 0; r < 16; ++r) p1[r] = __builtin_amdgcn_exp2f(p1[r]);
  float ps = 0; for (int r = 0; r < 16; ++r) ps += p0[r]; for (int r = 0; r < 16; ++r) ps += p1[r];
  { auto rr = __builtin_amdgcn_permlane32_swap(__float_as_uint(ps), __float_as_uint(ps), false, false);
    ps = __uint_as_float(rr[0]) + __uint_as_float(rr[1]); }
  l_reg = l_reg * alpha + ps;
#define PK4(P, BASE, OUT) do { unsigned a0 = cvtpk(P[BASE + 0], P[BASE + 1]), a1 = cvtpk(P[BASE + 2], P[BASE + 3]);   \
    unsigned b0 = cvtpk(P[BASE + 4], P[BASE + 5]), b1 = cvtpk(P[BASE + 6], P[BASE + 7]);                              \
    auto r0 = __builtin_amdgcn_permlane32_swap(a0, b0, false, false); auto r1 = __builtin_amdgcn_permlane32_swap(a1, b1, false, false); \
    u32x4 w = {r0[0], r1[0], r0[1], r1[1]}; OUT = *reinterpret_cast<bf16x8*>(&w); } while (0)
  PK4(p0, 0, pa0); PK4(p0, 8, pa1); PK4(p1, 0, pa2); PK4(p1, 8, pa3);
#undef PK4
}
template <int ND> __device__ __forceinline__ void qkt(f32x16& p0, f32x16& p1, const bf16* Ks, const bf16x8* qr, int r32, int hi, int kcb) {
  p0 = f32x16{}; p1 = f32x16{};
  const char* Kb = (const char*)Ks + kcb;
#pragma unroll
  for (int d0 = 0; d0 < ND; ++d0) { int cb = (d0 * 16 + hi * 8) * 2;
    bf16x8 b0 = *reinterpret_cast<const bf16x8*>(Kb + KSWZ(r32, cb));
    bf16x8 b1 = *reinterpret_cast<const bf16x8*>(Kb + KSWZ(32 + r32, cb));
    p0 = __builtin_amdgcn_mfma_f32_32x32x16_bf16(b0, qr[d0], p0, 0, 0, 0);
    p1 = __builtin_amdgcn_mfma_f32_32x32x16_bf16(b1, qr[d0], p1, 0, 0, 0); }
}
__device__ __forceinline__ int v_st(int k, int c) { const int kk = (k & ~0xC) | ((k & 4) << 1) | ((k & 8) >> 1); return ((kk >> 3) * 4 + (c >> 5)) * 512 + ((kk & 7) * 32 + (c & 31)) * 2; }
__device__ __forceinline__ int v_rd_base(int lane) { return ((lane & 3) << 3) | (((lane >> 2) & 3) << 6) | (((lane >> 4) & 1) << 5) | (((lane >> 5) & 1) << 8); }
constexpr int v_rd_off(int d0, int ks, int half) { return d0 * 512 + ks * 4096 + half * 2048; }
template <int OFF> __device__ __forceinline__ s16x4 tr_read(int vb) {
  s16x4 r; asm volatile("ds_read_b64_tr_b16 %0, %1 offset:%2" : "=&v"(r) : "v"(vb), "i"(OFF) : "memory"); return r;
}
template <int D0> __device__ __forceinline__ void pv_one(f32x16& od, int vb, bf16x8 pa0, bf16x8 pa1, bf16x8 pa2, bf16x8 pa3) {
  const s16x4 l0 = tr_read<v_rd_off(D0, 0, 0)>(vb), h0 = tr_read<v_rd_off(D0, 0, 1)>(vb), l1 = tr_read<v_rd_off(D0, 1, 0)>(vb), h1 = tr_read<v_rd_off(D0, 1, 1)>(vb);
  const s16x4 l2 = tr_read<v_rd_off(D0, 2, 0)>(vb), h2 = tr_read<v_rd_off(D0, 2, 1)>(vb), l3 = tr_read<v_rd_off(D0, 3, 0)>(vb), h3 = tr_read<v_rd_off(D0, 3, 1)>(vb);
  asm volatile("s_waitcnt lgkmcnt(0)" ::: "memory"); SBAR();
#define PK(L, H) (bf16x8){L[0], L[1], L[2], L[3], H[0], H[1], H[2], H[3]}
  od = __builtin_amdgcn_mfma_f32_32x32x16_bf16(pa0, PK(l0, h0), od, 0, 0, 0);
  od = __builtin_amdgcn_mfma_f32_32x32x16_bf16(pa1, PK(l1, h1), od, 0, 0, 0);
  od = __builtin_amdgcn_mfma_f32_32x32x16_bf16(pa2, PK(l2, h2), od, 0, 0, 0);
  od = __builtin_amdgcn_mfma_f32_32x32x16_bf16(pa3, PK(l3, h3), od, 0, 0, 0);
#undef PK
}
__device__ __forceinline__ void pv_d0(f32x16* o, int vb, bf16x8 pa0, bf16x8 pa1, bf16x8 pa2, bf16x8 pa3) {
  pv_one<0>(o[0], vb, pa0, pa1, pa2, pa3); pv_one<1>(o[1], vb, pa0, pa1, pa2, pa3); pv_one<2>(o[2], vb, pa0, pa1, pa2, pa3); pv_one<3>(o[3], vb, pa0, pa1, pa2, pa3);
}

template <int ND, int LDQ, int LDK, int LDV, int LDOF, int LDOB>
__device__ __forceinline__ void attn_dense_body(const bf16* __restrict__ Qb, const bf16* __restrict__ Kh, const bf16* __restrict__ Vh,
                                                float* __restrict__ Of, bf16* __restrict__ Ob16, int seq, char* lds, int kcb,
                                                const float* __restrict__ qgain, const float* __restrict__ rope, int tpos0) {
  using TQ = bf16; using St = Stage<bf16>; using SQ = Stage<TQ>;
  int tid_l = threadIdx.x; asm volatile("" : "+v"(tid_l));
  const int tid = tid_l, wid = tid >> 6, lane = tid & 63, r32 = lane & 31, hi = lane >> 5;
  bf16* V_lds = (bf16*)lds; bf16* K_lds = (bf16*)(lds + 2 * SHM_V);
  float* ws = (float*)(lds + 2 * SHM_V + 2 * SHM_K) + wid * 64; float* li_l = ws; float* al_l = ws + 32;
  float m_reg = -1e30f, l_reg = 0; f32x16 o[4] = {}; bf16x8 qr[ND];
  const TQ* Qw = Qb + (long)(wid * QBLK + r32) * LDQ + hi * 8;
  {
    float f[ND][8];
#pragma unroll
    for (int d0 = 0; d0 < ND; ++d0) { const u32x4 w = *reinterpret_cast<const u32x4*>(Qw + d0 * 16);
      f[d0][0] = __uint_as_float(w[0] << 16); f[d0][1] = __uint_as_float(w[0] & 0xffff0000u); f[d0][2] = __uint_as_float(w[1] << 16); f[d0][3] = __uint_as_float(w[1] & 0xffff0000u);
      f[d0][4] = __uint_as_float(w[2] << 16); f[d0][5] = __uint_as_float(w[2] & 0xffff0000u); f[d0][6] = __uint_as_float(w[3] << 16); f[d0][7] = __uint_as_float(w[3] & 0xffff0000u); }
    if constexpr (ND == 8) {
      float ss = 0.f;
#pragma unroll
      for (int d0 = 0; d0 < ND; ++d0)
#pragma unroll
        for (int e = 0; e < 8; ++e) ss += f[d0][e] * f[d0][e];
      ss += __shfl_xor(ss, 32);
      const float rstd = 1.f / sqrtf(ss * (1.f / 128.f) + 1e-6f);
#pragma unroll
      for (int d0 = 0; d0 < ND; ++d0) { const float* gp = qgain + d0 * 16 + hi * 8;
#pragma unroll
        for (int e = 0; e < 8; ++e) f[d0][e] = f[d0][e] * rstd * gp[e]; }
    }
    if (tpos0 >= 0) { const int t = tpos0 + wid * QBLK + r32; constexpr int Q4 = ND / 4, TOFF = ND == 8 ? 16 : 0;
#pragma unroll
      for (int hf = 0; hf < 2; ++hf) { const float* tb = rope + (size_t)((hf == 0 ? (t >> 6) : (t & 63)) * 48 + TOFF + hi * 8) * 2;
#pragma unroll
        for (int q = 0; q < Q4; ++q)
#pragma unroll
          for (int e = 0; e < 8; ++e) { const float cs = tb[(q * 16 + e) * 2], sn = tb[(q * 16 + e) * 2 + 1]; const int da = hf * 2 * Q4 + q, db = da + Q4;
            const float x1 = f[da][e], x2 = f[db][e]; f[da][e] = x1 * cs - x2 * sn; f[db][e] = x1 * sn + x2 * cs; } }
    }
    constexpr float QS = ND == 8 ? 1.f : 1.4142135623730951f;
#pragma unroll
    for (int d0 = 0; d0 < ND; ++d0) { u32x4 w = {cvtpk(f[d0][0] * QS, f[d0][1] * QS), cvtpk(f[d0][2] * QS, f[d0][3] * QS), cvtpk(f[d0][4] * QS, f[d0][5] * QS), cvtpk(f[d0][6] * QS, f[d0][7] * QS)};
      qr[d0] = *reinterpret_cast<bf16x8*>(&w); }
  }
  const int sr = tid >> 4, sc = (tid & 15) * 8, vst0 = v_st(sr, sc), vst1 = v_st(32 + sr, sc);
  const int vb0 = (int)(uintptr_t)V_lds + v_rd_base(lane);
  struct { typename St::T vs0, vs1, ks0, ks1; } sr_[SDEPTH];
#define SLOAD(i, k0) do { sr_[i].vs0 = St::ld8(&Vh[(long)((k0) + sr) * LDV + sc]); sr_[i].vs1 = St::ld8(&Vh[(long)((k0) + 32 + sr) * LDV + sc]); \
    sr_[i].ks0 = St::ld8(&Kh[(long)((k0) + sr) * LDK + sc]); sr_[i].ks1 = St::ld8(&Kh[(long)((k0) + 32 + sr) * LDK + sc]); } while (0)
#define SWRITE(b, i) do { *(bf16x8*)((char*)V_lds + (b) * SHM_V + vst0) = St::tobf(sr_[i].vs0);          \
    *(bf16x8*)((char*)V_lds + (b) * SHM_V + vst1) = St::tobf(sr_[i].vs1); int kc = sc * 2;               \
    *(bf16x8*)((char*)K_lds + (b) * SHM_K + KSWZ(sr, kc)) = St::tobf(sr_[i].ks0);                       \
    *(bf16x8*)((char*)K_lds + (b) * SHM_K + KSWZ(32 + sr, kc)) = St::tobf(sr_[i].ks1); } while (0)
#define SWAIT() do { if constexpr (SDEPTH == 2) asm volatile("s_waitcnt vmcnt(4)" ::: "memory"); else asm volatile("s_waitcnt vmcnt(0)" ::: "memory"); } while (0)
#define RESC(a) do { if (__any((a) < 1.f)) { if (hi == 0) al_l[r32] = (a); asm volatile("s_waitcnt lgkmcnt(0)" ::: "memory"); \
    for (int d = 0; d < 4; ++d) for (int r = 0; r < 16; ++r) o[d][r] *= al_l[crow(r, hi)]; } } while (0)
  f32x16 pA0, pA1, pB0, pB1; float mnA, mnB, alA, alB; bf16x8 pa0, pa1, pa2, pa3; const int NT = seq / KVBLK;
  constexpr int SE = 0, SO = SDEPTH - 1;
  SLOAD(SE, 0); asm volatile("s_waitcnt vmcnt(0)" ::: "memory"); SWRITE(0, SE); __syncthreads();
  qkt<ND>(pA0, pA1, K_lds, qr, r32, hi, kcb); partialSM(pA0, pA1, m_reg, mnA, alA);
  SLOAD(SO, KVBLK); if constexpr (SDEPTH == 2) { if (2 < NT) SLOAD(SE, 2 * KVBLK); }
  SWAIT(); SWRITE(1, SO); __syncthreads();
  for (int j = 1; j + 1 < NT; j += 2) {
    SBAR(); qkt<ND>(pB0, pB1, (bf16*)((char*)K_lds + SHM_K), qr, r32, hi, kcb);
    finishSM(pA0, pA1, alA, l_reg, pa0, pa1, pa2, pa3); SBAR();
    SLOAD(SO, (j + SDEPTH) * KVBLK); SBAR();
    pv_d0(o, vb0, pa0, pa1, pa2, pa3); partialSM(pB0, pB1, m_reg, mnB, alB);
    __syncthreads(); SWAIT(); SWRITE(0, SE);
    RESC(alB); __syncthreads();
    SBAR(); qkt<ND>(pA0, pA1, K_lds, qr, r32, hi, kcb);
    finishSM(pB0, pB1, alB, l_reg, pa0, pa1, pa2, pa3); SBAR();
    if (SDEPTH == 1 || j + 3 < NT) SLOAD(SE, (j + 1 + SDEPTH) * KVBLK); SBAR();
    pv_d0(o, vb0 + (int)SHM_V, pa0, pa1, pa2, pa3); partialSM(pA0, pA1, m_reg, mnA, alA);
    __syncthreads(); SWAIT(); SWRITE(1, SO);
    RESC(alA); __syncthreads();
  }
  SBAR(); qkt<ND>(pB0, pB1, (bf16*)((char*)K_lds + SHM_K), qr, r32, hi, kcb);
  finishSM(pA0, pA1, alA, l_reg, pa0, pa1, pa2, pa3); SBAR();
  pv_d0(o, vb0, pa0, pa1, pa2, pa3); partialSM(pB0, pB1, m_reg, mnB, alB);
  __syncthreads(); RESC(alB);
  finishSM(pB0, pB1, alB, l_reg, pa0, pa1, pa2, pa3); SBAR();
  pv_d0(o, vb0 + (int)SHM_V, pa0, pa1, pa2, pa3);
  if (hi == 0) li_l[r32] = l_reg; asm volatile("s_waitcnt lgkmcnt(0)" ::: "memory");
  float rli[16];
#pragma unroll
  for (int r = 0; r < 16; ++r) rli[r] = __builtin_amdgcn_rcpf(li_l[crow(r, hi)]);
  if (Of) { float* Ow = Of + (long)(wid * QBLK) * LDOF;
#pragma unroll
    for (int r = 0; r < 16; ++r) { int orow = crow(r, hi);
#pragma unroll
      for (int d0 = 0; d0 < 4; ++d0) Ow[(long)orow * LDOF + d0 * 32 + r32] = o[d0][r] * rli[r]; }
  } else { unsigned short* Ow = (unsigned short*)Ob16 + (long)(wid * QBLK) * LDOB;
#pragma unroll
    for (int r = 0; r < 16; ++r) { int orow = crow(r, hi);
#pragma unroll
      for (int d0 = 0; d0 < 4; ++d0) Ow[(long)orow * LDOB + d0 * 32 + r32] = (unsigned short)(cvtpk(o[d0][r] * rli[r], 0.f) & 0xffffu); }
  }
#undef SLOAD
#undef SWRITE
#undef SWAIT
#undef RESC
}

template <int ND, int LDQ, int LDK, int LDV, int LDOF, int LDOB>
__device__ __forceinline__ void attn_dma_body(const bf16* __restrict__ Qb, const bf16* __restrict__ Kh, const bf16* __restrict__ Vh,
                                                float* __restrict__ Of, bf16* __restrict__ Ob16, int seq, char* lds, int kcb,
                                                const float* __restrict__ qgain, const float* __restrict__ rope, int tpos0) {
  using TQ = bf16; using St = Stage<bf16>; using SQ = Stage<TQ>;
  int tid_l = threadIdx.x; asm volatile("" : "+v"(tid_l));
  const int tid = tid_l, wid = __builtin_amdgcn_readfirstlane(tid >> 6), lane = tid & 63, r32 = lane & 31, hi = lane >> 5;
  bf16* V_lds = (bf16*)lds; bf16* K_lds = (bf16*)(lds + 4 * SHM_V);
  float* ws = (float*)(lds + DMA_SCRATCH_OFF) + wid * 64; float* li_l = ws; float* al_l = ws + 32;
  float m_reg = -1e30f, l_reg = 0; f32x16 o[4] = {}; bf16x8 qr[ND];
  const TQ* Qw = Qb + (long)(wid * QBLK + r32) * LDQ + hi * 8;
  const int vb0 = (int)(uintptr_t)V_lds + v_rd_base(lane);
  unsigned koff[2], voff[2];
#pragma unroll
  for (int i = 0; i < 2; ++i) { const int g = (wid * 2 + i) * 64 + lane;
    { const int row = g >> 4, cg = g & 15; koff[i] = (unsigned)(row * LDK * 2 + ((cg ^ (row & 7)) << 4)); }
    { const int st = g >> 5, w = g & 31, kk = (st >> 2) * 8 + (w >> 2), c = (st & 3) * 32 + (w & 3) * 8, k = (kk & ~0xC) | ((kk & 4) << 1) | ((kk & 8) >> 1); voff[i] = (unsigned)(k * LDV * 2 + c * 2); } }
  const unsigned ldsV = (unsigned)(uintptr_t)V_lds + (unsigned)wid * 2048u, ldsK = (unsigned)(uintptr_t)K_lds + (unsigned)wid * 2048u;
#define DMA16(gsrc, ldsdst) do { unsigned keep_; asm volatile("s_mov_b32 %0, m0\n\ts_mov_b32 m0, %2\n\ts_nop 0\n\tglobal_load_lds_dwordx4 %1, off\n\ts_mov_b32 m0, %0" : "=&s"(keep_) : "v"(gsrc), "s"(ldsdst) : "memory"); } while (0)
#define ISSUE(t) do { const char* kt_ = (const char*)Kh + (size_t)(t) * (KVBLK * LDK * 2); const char* vt_ = (const char*)Vh + (size_t)(t) * (KVBLK * LDV * 2); const unsigned so_ = (unsigned)((t) & 3) * (unsigned)SHM_K; \
    DMA16(kt_ + koff[0], __builtin_amdgcn_readfirstlane(ldsK + so_)); DMA16(kt_ + koff[1], __builtin_amdgcn_readfirstlane(ldsK + so_ + 1024u)); \
    DMA16(vt_ + voff[0], __builtin_amdgcn_readfirstlane(ldsV + so_)); DMA16(vt_ + voff[1], __builtin_amdgcn_readfirstlane(ldsV + so_ + 1024u)); } while (0)
  ISSUE(0); ISSUE(1);
  {
    float f[ND][8];
#pragma unroll
    for (int d0 = 0; d0 < ND; ++d0) { const u32x4 w = *reinterpret_cast<const u32x4*>(Qw + d0 * 16);
      f[d0][0] = __uint_as_float(w[0] << 16); f[d0][1] = __uint_as_float(w[0] & 0xffff0000u); f[d0][2] = __uint_as_float(w[1] << 16); f[d0][3] = __uint_as_float(w[1] & 0xffff0000u);
      f[d0][4] = __uint_as_float(w[2] << 16); f[d0][5] = __uint_as_float(w[2] & 0xffff0000u); f[d0][6] = __uint_as_float(w[3] << 16); f[d0][7] = __uint_as_float(w[3] & 0xffff0000u); }
    if constexpr (ND == 8) {
      float ss = 0.f;
#pragma unroll
      for (int d0 = 0; d0 < ND; ++d0)
#pragma unroll
        for (int e = 0; e < 8; ++e) ss += f[d0][e] * f[d0][e];
      ss += __shfl_xor(ss, 32);
      const float rstd = 1.f / sqrtf(ss * (1.f / 128.f) + 1e-6f);
#pragma unroll
      for (int d0 = 0; d0 < ND; ++d0) { const float* gp = qgain + d0 * 16 + hi * 8;
#pragma unroll
        for (int e = 0; e < 8; ++e) f[d0][e] = f[d0][e] * rstd * gp[e]; }
    }
    if (tpos0 >= 0) { const int t = tpos0 + wid * QBLK + r32; constexpr int Q4 = ND / 4, TOFF = ND == 8 ? 16 : 0;
#pragma unroll
      for (int hf = 0; hf < 2; ++hf) { const float* tb = rope + (size_t)((hf == 0 ? (t >> 6) : (t & 63)) * 48 + TOFF + hi * 8) * 2;
#pragma unroll
        for (int q = 0; q < Q4; ++q)
#pragma unroll
          for (int e = 0; e < 8; ++e) { const float cs = tb[(q * 16 + e) * 2], sn = tb[(q * 16 + e) * 2 + 1]; const int da = hf * 2 * Q4 + q, db = da + Q4;
            const float x1 = f[da][e], x2 = f[db][e]; f[da][e] = x1 * cs - x2 * sn; f[db][e] = x1 * sn + x2 * cs; } }
    }
    constexpr float QS = ND == 8 ? 1.f : 1.4142135623730951f;
#pragma unroll
    for (int d0 = 0; d0 < ND; ++d0) { u32x4 w = {cvtpk(f[d0][0] * QS, f[d0][1] * QS), cvtpk(f[d0][2] * QS, f[d0][3] * QS), cvtpk(f[d0][4] * QS, f[d0][5] * QS), cvtpk(f[d0][6] * QS, f[d0][7] * QS)};
      qr[d0] = *reinterpret_cast<bf16x8*>(&w); }
  }
#define WAIT_BAR(N) asm volatile("s_waitcnt vmcnt(" #N ") lgkmcnt(0)\n\ts_barrier" ::: "memory")
#define RESC(a) do { if (__any((a) < 1.f)) { if (hi == 0) al_l[r32] = (a); asm volatile("s_waitcnt lgkmcnt(0)" ::: "memory"); \
    for (int d = 0; d < 4; ++d) for (int r = 0; r < 16; ++r) o[d][r] *= al_l[crow(r, hi)]; } } while (0)
  f32x16 pA0, pA1, pB0, pB1; float mnA, mnB, alA, alB; bf16x8 pa0, pa1, pa2, pa3; const int NT = seq / KVBLK;
#define STEP(PC0, PC1, mnC, alC, PP0, PP1, alP, t) do { if ((t) + 1 < NT) WAIT_BAR(4); else WAIT_BAR(0); \
    if ((t) + 2 < NT) ISSUE((t) + 2); \
    SBAR(); qkt<ND>(PC0, PC1, (bf16*)((char*)K_lds + ((t) & 3) * SHM_K), qr, r32, hi, kcb); \
    finishSM(PP0, PP1, alP, l_reg, pa0, pa1, pa2, pa3); SBAR(); \
    pv_d0(o, vb0 + (((t) - 1) & 3) * (int)SHM_V, pa0, pa1, pa2, pa3); partialSM(PC0, PC1, m_reg, mnC, alC); \
    RESC(alC); } while (0)
  WAIT_BAR(4);
  if (2 < NT) ISSUE(2);
  qkt<ND>(pA0, pA1, K_lds, qr, r32, hi, kcb); partialSM(pA0, pA1, m_reg, mnA, alA);
  for (int t0 = 0; t0 < NT; t0 += 4) {
    STEP(pB0, pB1, mnB, alB, pA0, pA1, alA, t0 + 1);
    STEP(pA0, pA1, mnA, alA, pB0, pB1, alB, t0 + 2);
    STEP(pB0, pB1, mnB, alB, pA0, pA1, alA, t0 + 3);
    if (t0 + 4 < NT) STEP(pA0, pA1, mnA, alA, pB0, pB1, alB, t0 + 4);
  }
  finishSM(pB0, pB1, alB, l_reg, pa0, pa1, pa2, pa3); SBAR();
  pv_d0(o, vb0 + 3 * (int)SHM_V, pa0, pa1, pa2, pa3);
  if (hi == 0) li_l[r32] = l_reg; asm volatile("s_waitcnt lgkmcnt(0)" ::: "memory");
  float rli[16];
#pragma unroll
  for (int r = 0; r < 16; ++r) rli[r] = __builtin_amdgcn_rcpf(li_l[crow(r, hi)]);
  if (Of) { float* Ow = Of + (long)(wid * QBLK) * LDOF;
#pragma unroll
    for (int r = 0; r < 16; ++r) { int orow = crow(r, hi);
#pragma unroll
      for (int d0 = 0; d0 < 4; ++d0) Ow[(long)orow * LDOF + d0 * 32 + r32] = o[d0][r] * rli[r]; }
  } else { unsigned short* Ow = (unsigned short*)Ob16 + (long)(wid * QBLK) * LDOB;
#pragma unroll
    for (int r = 0; r < 16; ++r) { int orow = crow(r, hi);
#pragma unroll
      for (int d0 = 0; d0 < 4; ++d0) Ow[(long)orow * LDOB + d0 * 32 + r32] = (unsigned short)(cvtpk(o[d0][r] * rli[r], 0.f) & 0xffffu); }
  }
#undef DMA16
#undef ISSUE
#undef WAIT_BAR
#undef STEP
#undef RESC
}

}
#define GAS __attribute__((address_space(1)))
#define LAS __attribute__((address_space(3)))
typedef unsigned short bf16_t;
typedef unsigned u32x4v __attribute__((ext_vector_type(4)));
typedef unsigned v4u __attribute__((ext_vector_type(4)));
typedef float f32x4 __attribute__((ext_vector_type(4)));
typedef short bf16x8 __attribute__((ext_vector_type(8)));
typedef GAS unsigned gu32;
typedef GAS unsigned long long gu64;
#define RLX_AGENT __ATOMIC_RELAXED, __HIP_MEMORY_SCOPE_AGENT
#define LDS_WAIT() asm volatile("s_waitcnt lgkmcnt(0)" ::: "memory")
#define VM_WAIT() asm volatile("s_waitcnt vmcnt(0)" ::: "memory")
__device__ __forceinline__ unsigned long long rt() { return __builtin_amdgcn_s_memrealtime(); }
__device__ __forceinline__ unsigned f2bf(float f) { unsigned u = __builtin_bit_cast(unsigned, f); return (u + 0x7fffu + ((u >> 16) & 1u)) >> 16; }
__device__ __forceinline__ unsigned pk2(float lo, float hi) { return f2bf(lo) | (f2bf(hi) << 16); }
#define XB_TMO      128
#define XB_XCNT(j)  (256  + 64 * (j))
#define XB_XSUB(j)  (1280 + 64 * (j))
#define XB_XGEN(j)  (2304 + 64 * (j))
#define XB_TOP      3328
#define XB_TOPGEN   3392
#define XCD_BAR_WORDS 3456
#define XB_SPIN_CAP (1u << 18)

__device__ __forceinline__ unsigned xb_ld(unsigned* p)              { return __hip_atomic_load(p, __ATOMIC_RELAXED, __HIP_MEMORY_SCOPE_AGENT); }
__device__ __forceinline__ unsigned xb_add(unsigned* p, unsigned v) { return __hip_atomic_fetch_add(p, v, __ATOMIC_RELAXED, __HIP_MEMORY_SCOPE_AGENT); }
__device__ __forceinline__ unsigned xb_xcc_id() { return (unsigned)__builtin_amdgcn_s_getreg((3 << 11) | 20) & 0xFu; }
#define XB_SPIN(cond, bar) do { unsigned _sp = 0; while (cond) { __builtin_amdgcn_s_sleep(1); \
    if ((++_sp & 255u) == 0u) { if (xb_ld(&(bar)[XB_TMO])) break; if (_sp > XB_SPIN_CAP) { atomicAdd(&(bar)[XB_TMO], 1u); break; } } } } while (0)

struct XcdBarrier {
    unsigned* bar; unsigned x;
    volatile LAS unsigned* st;
};

__device__ __forceinline__ XcdBarrier xcd_barrier_post(unsigned* bar, volatile LAS unsigned* st) {
    XcdBarrier b; b.bar = bar; b.x = xb_xcc_id(); b.st = st;
    if (threadIdx.x == 0) (void)xb_add(&bar[XB_XCNT(b.x)], 1u);
    return b;
}
__device__ __forceinline__ void xcd_barrier_complete(unsigned* bar, unsigned x, unsigned& nloc, unsigned& nx) {
    const unsigned G = gridDim.x * gridDim.y * gridDim.z;
    unsigned sum, cnt, mine, sp = 0u;
    for (;;) {
        sum = 0u; cnt = 0u; mine = 0u;
#pragma unroll
        for (unsigned j = 0; j < 16; ++j) { const unsigned c = xb_ld(&bar[XB_XCNT(j)]); sum += c; cnt += (c > 0u) ? 1u : 0u; mine = (j == x) ? c : mine; }
        if (sum == G) break;
        __builtin_amdgcn_s_sleep(1);
        if ((++sp & 255u) == 0u) { if (xb_ld(&bar[XB_TMO])) break; if (sp > XB_SPIN_CAP) { atomicAdd(&bar[XB_TMO], 1u); break; } }
    }
    nloc = mine > 0u ? mine : 1u; nx = cnt > 0u ? cnt : 1u;
}

__device__ __forceinline__ void xcd_barrier(const XcdBarrier& b) {
    asm volatile("s_waitcnt vmcnt(0)" ::: "memory");
    __syncthreads();
    if (threadIdx.x == 0) {
        unsigned* bar = b.bar;
        __builtin_amdgcn_s_waitcnt(0);
        unsigned nloc = b.st[0], nx = b.st[1];
        if (nloc == 0u) { xcd_barrier_complete(bar, b.x, nloc, nx); b.st[0] = nloc; b.st[1] = nx; }
        const unsigned old = xb_add(&bar[XB_XSUB(b.x)], 1u);
        const unsigned gen = old / nloc;
        if (old + 1u == (gen + 1u) * nloc) {
            __builtin_amdgcn_fence(__ATOMIC_RELEASE, "agent");
            asm volatile("s_waitcnt vmcnt(0)" ::: "memory");
            const unsigned og = xb_add(&bar[XB_TOP], 1u);
            const unsigned tg = og / nx;
            if (og + 1u == (tg + 1u) * nx) xb_add(&bar[XB_TOPGEN], 1u);
            else XB_SPIN(xb_ld(&bar[XB_TOPGEN]) == tg, bar);
            __builtin_amdgcn_fence(__ATOMIC_ACQUIRE, "agent");
            xb_add(&bar[XB_XGEN(b.x)], 1u);
            asm volatile("s_waitcnt vmcnt(0)" ::: "memory");
        } else {
            XB_SPIN(xb_ld(&bar[XB_XGEN(b.x)]) == gen, bar);
            __builtin_amdgcn_fence(__ATOMIC_ACQUIRE, "agent");
            asm volatile("s_waitcnt vmcnt(0)" ::: "memory");
        }
    }
    __syncthreads();
}


constexpr int DM = 2048, NB = 4, SEQL = 4096, CTXL = 256, SPB = 4352, R = NB * SPB, FF = 5632, INC = 3584, NMOD = 9, MODW = NMOD * DM;
constexpr int S5G = 32, S5P = 64, S5H = 16, TCH = 32;
constexpr int NCH = SPB / TCH, NCC = CTXL / TCH, RCV = NB * NCH, RCT = (RCV + 255) / 256, RCP = RCT * 256;
constexpr int KU = TCH * S5H, KS5 = KU + 256, NT5 = KU / 256, NLAG = 2 * TCH - 1;
static_assert(NCH % 17 == 0 && KU % 256 == 0, "S5 chunk geometry");
constexpr float EPS = 1e-6f;
constexpr int NWAVES = 8;
constexpr size_t MiB = 1u << 20;
constexpr size_t WS_CTL = 0, CTL_ZERO_BYTES = 1 * MiB;
constexpr size_t WS_MODV = 1 * MiB;
constexpr size_t WS_APOW = 2 * MiB;
constexpr size_t WS_BBAR = 7 * MiB;
constexpr size_t WS_ROPE = 6 * MiB + 512 * 1024;
constexpr size_t WS_KTAB = 8 * MiB;
constexpr size_t WS_WGU = 16 * MiB;
constexpr size_t WS_WD = 192 * MiB;
constexpr size_t WS_WIN = 280 * MiB;
constexpr size_t WS_WOUT = 308 * MiB;
constexpr size_t WS_GLU = 324 * MiB;
constexpr size_t WS_TZE = 326 * MiB;
constexpr size_t WS_SM = 486 * MiB;
constexpr size_t WS_XS = 518 * MiB;
constexpr size_t WS_H = 654 * MiB;
constexpr size_t WS_HACT = 722 * MiB;
constexpr size_t WS_P = 722 * MiB;
constexpr size_t WS_KA = 841 * MiB;
constexpr size_t WS_OD = 867 * MiB;
constexpr size_t WS_VA = 901 * MiB;
constexpr size_t WS_MIX = 935 * MiB;
constexpr size_t WS_UG = 1003 * MiB;
constexpr size_t WS_SST = 1043 * MiB;
constexpr size_t WS_YG = 1067 * MiB;
constexpr size_t WS_PART = 1084 * MiB;
constexpr size_t WS_END = 1116 * MiB;
static_assert((size_t)S5G * RCP * 256 * 4 <= 24 * MiB && (size_t)S5G * RCP * KS5 * 2 <= 40 * MiB && (size_t)2 * S5G * KU * KS5 * 2 <= 160 * MiB, "S5 buffers");
constexpr int CW_BAR = 4096;
constexpr int RING_BYTES = 131072, LDSCTL_OFF = RING_BYTES, MISC_OFF = LDSCTL_OFF + 320, PTR_OFF = MISC_OFF + 128, LDS_BYTES = 147456;
constexpr int NPH = 28;
#ifndef MK_N_LAUNCHES
#define MK_N_LAUNCHES 1
#endif
#ifndef PROBE_MASK
#define PROBE_MASK 0u
#endif
#define PROBE_REPS(ph) ((((unsigned)PROBE_MASK >> (ph)) & 1u) ? 2 : 1)

typedef float f32x2v __attribute__((ext_vector_type(2)));
__device__ __forceinline__ float wave_sum(float v) {
#pragma unroll
    for (int o = 1; o < 64; o <<= 1) v += __shfl_xor(v, o);
    return v;
}
__device__ __forceinline__ float bflo(unsigned w) { return __uint_as_float(w << 16); }
__device__ __forceinline__ float bfhi(unsigned w) { return __uint_as_float(w & 0xffff0000u); }
__device__ __forceinline__ unsigned cvtpk2(float lo, float hi) { unsigned r; asm volatile("v_cvt_pk_bf16_f32 %0, %1, %2" : "=v"(r) : "v"(lo), "v"(hi)); return r; }
__device__ __forceinline__ float sigmoidf_fast(float z) { return __builtin_amdgcn_rcpf(1.f + __builtin_amdgcn_exp2f(-1.4426950408889634f * z)); }

namespace pg8 {
struct EpiGU { static constexpr bool PERM = true, AFTER_DRAIN = false; bf16_t* O;
    __device__ __forceinline__ void operator()(const f32x4 (&acc)[2][2][4][2], const Unit& u, int wr, int wc, int fr, int fq) const {
        const int row0 = u.pm * BM + wr * 64 + fr, col0 = u.pn * HALF + wc * 32 + 8 * fq;
#pragma unroll
        for (int ai = 0; ai < 2; ++ai)
#pragma unroll
            for (int m = 0; m < 4; ++m) { bf16_t* rowp = O + (size_t)(row0 + ai * HALF + m * 16) * FF + col0;
                float o[8];
#pragma unroll
                for (int n = 0; n < 2; ++n)
#pragma unroll
                    for (int i = 0; i < 4; ++i) { const float g = acc[ai][0][m][n][i], up = acc[ai][1][m][n][i]; o[4 * n + i] = g * up * sigmoidf_fast(g); }
                u32x4 w; w.x = cvt_pk_bf16(o[0], o[1]); w.y = cvt_pk_bf16(o[2], o[3]); w.z = cvt_pk_bf16(o[4], o[5]); w.w = cvt_pk_bf16(o[6], o[7]);
                *(u32x4*)rowp = w; }
    }
};
struct EpiResid { static constexpr bool PERM = false, AFTER_DRAIN = false; float* X; const float* gate; float coef;
    __device__ __forceinline__ void operator()(const f32x4 (&acc)[2][2][4][2], const Unit& u, int wr, int wc, int fr, int fq) const {
        const int bb = u.pm / 17, jj = u.pm % 17, midx = jj == 0 ? 4 : bb;
        const int col0 = u.pn * BM + wc * 32 + 4 * fq; const float* gv = gate + (size_t)midx * MODW + col0;
        f32x4 gt[2][2];
#pragma unroll
        for (int bj = 0; bj < 2; ++bj)
#pragma unroll
            for (int n = 0; n < 2; ++n) gt[bj][n] = *(const f32x4*)(gv + bj * HALF + n * 16) * coef;
        float* const row0 = X + (size_t)(u.pm * BM + wr * 64 + fr) * DM + col0;
        f32x4 b[2][2][4];
#define ER_LOAD(buf, p) do { _Pragma("unroll") for (int q = 0; q < 2; ++q) { const int s_ = 2 * (p) + q; const float* rp = row0 + (size_t)((s_ >> 2) * HALF + (s_ & 3) * 16) * DM; \
            _Pragma("unroll") for (int c = 0; c < 4; ++c) b[buf][q][c] = *(const f32x4*)(rp + (c >> 1) * HALF + (c & 1) * 16); } } while (0)
        ER_LOAD(0, 0);
#pragma unroll
        for (int p = 0; p < 4; ++p) { if (p < 3) ER_LOAD((p + 1) & 1, p + 1);
#pragma unroll
            for (int q = 0; q < 2; ++q) { const int s_ = 2 * p + q, ai = s_ >> 2, m = s_ & 3; float* rp = row0 + (size_t)(ai * HALF + m * 16) * DM;
#pragma unroll
                for (int c = 0; c < 4; ++c) *(f32x4*)(rp + (c >> 1) * HALF + (c & 1) * 16) = b[p & 1][q][c] + gt[c >> 1][c & 1] * acc[ai][c >> 1][m][c & 1]; } }
#undef ER_LOAD
    }
};
struct EpiResidX { static constexpr bool PERM = false, AFTER_DRAIN = false; float* X; const float* gate; const float* xin;
    __device__ __forceinline__ void operator()(const f32x4 (&acc)[2][2][4][2], const Unit& u, int wr, int wc, int fr, int fq) const {
        const int bb = u.pm / 17, jj = u.pm % 17;
        const int col0 = u.pn * BM + wc * 32 + 4 * fq; const float* gv = gate + (size_t)bb * MODW + col0;
        f32x4 gt[2][2];
#pragma unroll
        for (int bj = 0; bj < 2; ++bj)
#pragma unroll
            for (int n = 0; n < 2; ++n) gt[bj][n] = *(const f32x4*)(gv + bj * HALF + n * 16) * 0.5f;
        float* const row0 = X + (size_t)(u.pm * BM + wr * 64 + fr) * DM + col0; const float* const src0 = xin + (size_t)(bb * SEQL + (jj - 1) * BM + wr * 64 + fr) * DM + col0;
        f32x4 b[2][2][4];
#define ER_LOAD(buf, p) do { _Pragma("unroll") for (int q = 0; q < 2; ++q) { const int s_ = 2 * (p) + q; const float* rp = src0 + (size_t)((s_ >> 2) * HALF + (s_ & 3) * 16) * DM; \
            _Pragma("unroll") for (int c = 0; c < 4; ++c) b[buf][q][c] = *(const f32x4*)(rp + (c >> 1) * HALF + (c & 1) * 16); } } while (0)
        ER_LOAD(0, 0);
#pragma unroll
        for (int p = 0; p < 4; ++p) { if (p < 3) ER_LOAD((p + 1) & 1, p + 1);
#pragma unroll
            for (int q = 0; q < 2; ++q) { const int s_ = 2 * p + q, ai = s_ >> 2, m = s_ & 3; float* rp = row0 + (size_t)(ai * HALF + m * 16) * DM;
#pragma unroll
                for (int c = 0; c < 4; ++c) *(f32x4*)(rp + (c >> 1) * HALF + (c & 1) * 16) = b[p & 1][q][c] + gt[c >> 1][c & 1] * acc[ai][c >> 1][m][c & 1]; } }
#undef ER_LOAD
    }
};
struct EpiWin { static constexpr bool PERM = true, AFTER_DRAIN = false; bf16_t* P; bf16_t* UG; bf16_t* VA;
    __device__ __forceinline__ void operator()(const f32x4 (&acc)[2][2][4][2], const Unit& u, int wr, int wc, int fr, int fq) const {
        const int row0 = u.pm * BM + wr * 64 + fr, col0 = u.pn * BM + wc * 32 + 8 * fq;
#pragma unroll
        for (int ai = 0; ai < 2; ++ai)
#pragma unroll
            for (int m = 0; m < 4; ++m) { const int row = row0 + ai * HALF + m * 16;
                const int b = row / SPB, s = row % SPB, rc = b * NCH + s / TCH, j = s % TCH;
#pragma unroll
                for (int bj = 0; bj < 2; ++bj) { const f32x4 v0 = acc[ai][bj][m][0], v1 = acc[ai][bj][m][1];
                    u32x4 w; w.x = cvt_pk_bf16(v0[0], v0[1]); w.y = cvt_pk_bf16(v0[2], v0[3]); w.z = cvt_pk_bf16(v1[0], v1[1]); w.w = cvt_pk_bf16(v1[2], v1[3]);
                    const int col = col0 + bj * HALF;
                    if (u.pn < 2) { const int g = col >> 4, ho0 = col & 15; *(u32x4*)(UG + (size_t)(g * RCP + rc) * KS5 + j * 16 + ho0) = w; }
                    else if (u.pn == 6 || u.pn == 7) *(u32x4*)(VA + ((size_t)(b * 6 + ((col - 1536) >> 7)) * SPB + s) * 128 + ((col - 1536) & 127)) = w;
                    else if (u.pn == 13) *(u32x4*)(VA + ((size_t)(b * 6 + 4 + ((col - 3328) >> 7)) * SPB + s) * 128 + ((col - 3328) & 127)) = w;
                    else *(u32x4*)(P + (size_t)row * INC + col) = w; } }
    }
};
struct EpiS5State { static constexpr bool PERM = false, AFTER_DRAIN = false; float* SST;
    __device__ __forceinline__ void operator()(const f32x4 (&acc)[2][2][4][2], const Unit& u, int wr, int wc, int fr, int fq) const {
        const int col0 = wc * 32 + 4 * fq;
#pragma unroll
        for (int ai = 0; ai < 2; ++ai)
#pragma unroll
            for (int m = 0; m < 4; ++m) { float* rowp = SST + (size_t)(u.pm * BM + ai * HALF + wr * 64 + m * 16 + fr) * 256 + col0;
#pragma unroll
                for (int bj = 0; bj < 2; ++bj)
#pragma unroll
                    for (int n = 0; n < 2; ++n) *(f32x4*)(rowp + bj * HALF + n * 16) = acc[ai][bj][m][n]; }
    }
};
struct EpiS5Out { static constexpr bool PERM = true, AFTER_DRAIN = false; const bf16_t* UG; const float* dskip; bf16_t* YG;
    __device__ __forceinline__ void operator()(const f32x4 (&acc)[2][2][4][2], const Unit& u, int wr, int wc, int fr, int fq) const {
        const int g = u.pm / RCT, pmr = u.pm % RCT, pnr = u.pn % NT5;
#pragma unroll
        for (int bj = 0; bj < 2; ++bj) { const int cn8 = 256 * pnr + 128 * bj + 32 * wc + 8 * fq, l = cn8 >> 4, ho0 = cn8 & 15;
            const f32x4 d0 = *(const f32x4*)(dskip + g * 16 + ho0), d1 = *(const f32x4*)(dskip + g * 16 + ho0 + 4);
            u32x4 ub[2][4];
#pragma unroll
            for (int ai = 0; ai < 2; ++ai)
#pragma unroll
                for (int m = 0; m < 4; ++m) ub[ai][m] = *(const u32x4*)(UG + (size_t)(g * RCP + 256 * pmr + 128 * ai + 64 * wr + 16 * m + fr) * KS5 + cn8);
#pragma unroll
            for (int ai = 0; ai < 2; ++ai)
#pragma unroll
                for (int m = 0; m < 4; ++m) { const int rc = 256 * pmr + 128 * ai + 64 * wr + 16 * m + fr;
                    if (rc < RCV) { const int b = rc / NCH, c = rc % NCH; const size_t row = (size_t)b * SPB + c * TCH + l;
                        const u32x4 uu = ub[ai][m];
                        float y[8];
                        y[0] = acc[ai][bj][m][0][0] + d0[0] * bflo(uu.x); y[1] = acc[ai][bj][m][0][1] + d0[1] * bfhi(uu.x);
                        y[2] = acc[ai][bj][m][0][2] + d0[2] * bflo(uu.y); y[3] = acc[ai][bj][m][0][3] + d0[3] * bfhi(uu.y);
                        y[4] = acc[ai][bj][m][1][0] + d1[0] * bflo(uu.z); y[5] = acc[ai][bj][m][1][1] + d1[1] * bfhi(uu.z);
                        y[6] = acc[ai][bj][m][1][2] + d1[2] * bflo(uu.w); y[7] = acc[ai][bj][m][1][3] + d1[3] * bfhi(uu.w);
#pragma unroll
                        for (int i = 0; i < 8; ++i) { const float v = y[i]; y[i] = v * sigmoidf_fast(1.5957691216057308f * (v + 0.044715f * v * v * v)); }
                        u32x4 w; w.x = cvt_pk_bf16(y[0], y[1]); w.y = cvt_pk_bf16(y[2], y[3]); w.z = cvt_pk_bf16(y[4], y[5]); w.w = cvt_pk_bf16(y[6], y[7]);
                        *(u32x4*)(YG + row * 512 + g * 16 + ho0) = w; } } }
    }
};
struct EpiGLU { static constexpr bool PERM = true, AFTER_DRAIN = false; const bf16_t* YG; const float* gb; bf16_t* MIX;
    __device__ __forceinline__ void operator()(const f32x4 (&acc)[2][2][4][2], const Unit& u, int wr, int wc, int fr, int fq) const {
        const int row0 = u.pm * BM + wr * 64 + fr, col0 = u.pn * BM + wc * 32 + 8 * fq;
#pragma unroll
        for (int bj = 0; bj < 2; ++bj) { const int col = col0 + bj * HALF; const f32x4 b0 = *(const f32x4*)(gb + col), b1 = *(const f32x4*)(gb + col + 4);
            u32x4 yb[2][4];
#pragma unroll
            for (int ai = 0; ai < 2; ++ai)
#pragma unroll
                for (int m = 0; m < 4; ++m) yb[ai][m] = *(const u32x4*)(YG + (size_t)(row0 + ai * HALF + m * 16) * 512 + col);
#pragma unroll
            for (int ai = 0; ai < 2; ++ai)
#pragma unroll
                for (int m = 0; m < 4; ++m) { const size_t row = (size_t)(row0 + ai * HALF + m * 16);
                    const u32x4 yy = yb[ai][m];
                    const f32x4 z0 = acc[ai][bj][m][0] + b0, z1 = acc[ai][bj][m][1] + b1;
                    float o[8];
                    o[0] = bflo(yy.x) * sigmoidf_fast(z0[0]); o[1] = bfhi(yy.x) * sigmoidf_fast(z0[1]); o[2] = bflo(yy.y) * sigmoidf_fast(z0[2]); o[3] = bfhi(yy.y) * sigmoidf_fast(z0[3]);
                    o[4] = bflo(yy.z) * sigmoidf_fast(z1[0]); o[5] = bfhi(yy.z) * sigmoidf_fast(z1[1]); o[6] = bflo(yy.w) * sigmoidf_fast(z1[2]); o[7] = bfhi(yy.w) * sigmoidf_fast(z1[3]);
                    u32x4 w; w.x = cvt_pk_bf16(o[0], o[1]); w.y = cvt_pk_bf16(o[2], o[3]); w.z = cvt_pk_bf16(o[4], o[5]); w.w = cvt_pk_bf16(o[6], o[7]);
                    *(u32x4*)(MIX + row * DM + col) = w; } }
    }
};
struct S5StateOrder { int G, c;
    __device__ bool next(int i, Unit& u) const { const int L = i * G + c; if (L >= S5G * RCT) return false; u.pm = L; u.pn = L / RCT; u.kofs = 0; u.ks = 0; return true; }
    __device__ __forceinline__ void a_ready(const Unit&) const {}
    __device__ __forceinline__ void done(const Unit&) const {}
};
struct S5OutOrder { int G, c;
    __device__ bool next(int i, Unit& u) const { const int L = i * G + c; if (L >= S5G * RCT * NT5) return false; const int g = L / (RCT * NT5), rem = L % (RCT * NT5); u.pm = RCT * g + rem % RCT; u.pn = NT5 * g + rem / RCT; u.kofs = 0; u.ks = 0; return true; }
    __device__ __forceinline__ void a_ready(const Unit&) const {}
    __device__ __forceinline__ void done(const Unit&) const {}
};
struct FlexOrder { StaticOrder so; bool lat;
    __device__ void init(bool lat_, int N, int G_, int c_) { lat = lat_; so.init(lat_ ? 64 * BM : R, N, G_, c_); }
    __device__ bool next(int i, Unit& u) const { if (!so.next(i, u)) return false; if (lat) u.pm = (u.pm >> 4) * 17 + 1 + (u.pm & 15); return true; }
    __device__ __forceinline__ void a_ready(const Unit&) const {}
    __device__ __forceinline__ void done(const Unit&) const {}
};
struct CtxSplitOrder { int G, c, ksbytes;
    __device__ bool next(int i, Unit& u) const { const int L = i * G + c; if (L >= 128) return false; const int p = L >> 5, rem = L & 31; u.pm = 17 * p; u.pn = rem & 7; u.ks = rem >> 3; u.kofs = u.ks * ksbytes; return true; }
    __device__ __forceinline__ void a_ready(const Unit&) const {}
    __device__ __forceinline__ void done(const Unit&) const {}
};
struct EpiPart { static constexpr bool PERM = false, AFTER_DRAIN = false; float* PART;
    __device__ __forceinline__ void operator()(const f32x4 (&acc)[2][2][4][2], const Unit& u, int wr, int wc, int fr, int fq) const {
        const int col0 = u.pn * BM + wc * 32 + 4 * fq, prow = (u.pm / 17) * 256;
#pragma unroll
        for (int ai = 0; ai < 2; ++ai)
#pragma unroll
            for (int m = 0; m < 4; ++m) { float* rowp = PART + ((size_t)u.ks * 1024 + prow + ai * HALF + wr * 64 + m * 16 + fr) * DM + col0;
#pragma unroll
                for (int bj = 0; bj < 2; ++bj)
#pragma unroll
                    for (int n = 0; n < 2; ++n) *(f32x4*)(rowp + bj * HALF + n * 16) = acc[ai][bj][m][n]; }
    }
};
}

__device__ __forceinline__ void transpose_item(const float* W, int K, int N, bf16_t* WT, int k0, int n0, int rowbase, LAS float* scr, int lane) {
#pragma unroll 8
    for (int i = 0; i < 32; ++i) { const int kk = 2 * i + (lane >> 5); scr[kk * 33 + (lane & 31)] = W[(size_t)(k0 + kk) * N + n0 + (lane & 31)]; }
    LDS_WAIT(); asm volatile("" ::: "memory");
    const int c = lane & 7;
#pragma unroll
    for (int j = 0; j < 4; ++j) { const int n = (lane >> 3) + 8 * j; const LAS float* s = scr + (8 * c) * 33 + n;
        v4u o; o.x = pk2(s[0 * 33], s[1 * 33]); o.y = pk2(s[2 * 33], s[3 * 33]); o.z = pk2(s[4 * 33], s[5 * 33]); o.w = pk2(s[6 * 33], s[7 * 33]);
        *(GAS v4u*)(WT + (size_t)(rowbase + n) * K + k0 + 8 * c) = o; }
    LDS_WAIT(); asm volatile("" ::: "memory");
}
__device__ __forceinline__ void norm_mod_rows(float* XS, bf16_t* H, const float* g, const float* modl, int modk, int gw, int NGW, int lane, int tid, LAS float* tab, const float* part, const float* pgate, float pcoef, bool skipctx, const float* xin) {
    for (int i = tid; i < 5 * DM; i += NWAVES * 64) { const int m = i / DM, k = i % DM; const float* mv = modl + (size_t)m * MODW + (3 * modk) * DM + k; tab[i] = g[k] * (1.f + mv[DM]); tab[5 * DM + i] = mv[0]; }
    __syncthreads();
    auto rowsrc = [&](int r) { const int b = r / SPB, s = r % SPB; return (const f32x4*)((xin && s >= CTXL) ? xin + (size_t)(b * SEQL + s - CTXL) * DM : XS + (size_t)r * DM) + lane; };
    auto finish = [&](f32x4 (&v)[8], int r) {
        const int b = r / SPB, s = r % SPB, midx = s < CTXL ? 4 : b;
        if (skipctx && s < CTXL) return;
        if (part && s < CTXL) { const f32x4* pr = (const f32x4*)(part + (size_t)(b * CTXL + s) * DM) + lane; f32x4* xw = (f32x4*)(XS + (size_t)r * DM) + lane;
#pragma unroll
            for (int j = 0; j < 8; ++j) { const f32x4 ps = (pr[64 * j] + pr[64 * j + 1024 * DM / 4]) + (pr[64 * j + 2 * 1024 * DM / 4] + pr[64 * j + 3 * 1024 * DM / 4]);
                v[j] = v[j] + (*(const f32x4*)(pgate + 4 * (lane + 64 * j)) * pcoef) * ps; xw[64 * j] = v[j]; } }
        float ss = 0.f;
#pragma unroll
        for (int j = 0; j < 8; ++j) ss += (v[j].x * v[j].x + v[j].y * v[j].y) + (v[j].z * v[j].z + v[j].w * v[j].w);
        const float rstd = 1.f / sqrtf(wave_sum(ss) * (1.f / DM) + EPS);
        unsigned long long* o8 = (unsigned long long*)(H + (size_t)r * DM) + lane; const LAS f32x4* cs = (const LAS f32x4*)(tab + midx * DM) + lane; const LAS f32x4* sh = (const LAS f32x4*)(tab + (5 + midx) * DM) + lane;
#pragma unroll
        for (int j = 0; j < 8; ++j) { const f32x4 o = (v[j] * rstd) * cs[64 * j] + sh[64 * j];
            o8[64 * j] = (unsigned long long)cvtpk2(o.x, o.y) | ((unsigned long long)cvtpk2(o.z, o.w) << 32); }
    };
    for (int r0 = gw; r0 < R; r0 += 2 * NGW) {
        const int r1 = r0 + NGW; const bool two = r1 < R;
        const f32x4* xa = rowsrc(r0); const f32x4* xb = rowsrc(two ? r1 : r0);
        f32x4 va[8], vb[8];
#pragma unroll
        for (int j = 0; j < 8; ++j) va[j] = xa[64 * j];
#pragma unroll
        for (int j = 0; j < 8; ++j) vb[j] = xb[64 * j];
        finish(va, r0); if (two) finish(vb, r1);
    }
}
__device__ __forceinline__ void unpack8(const u32x4v w, float (&f)[8]) {
    f[0] = bflo(w.x); f[1] = bfhi(w.x); f[2] = bflo(w.y); f[3] = bfhi(w.y); f[4] = bflo(w.z); f[5] = bfhi(w.z); f[6] = bflo(w.w); f[7] = bfhi(w.w);
}
__device__ __forceinline__ u32x4v pack8(const float (&f)[8]) { u32x4v w; w.x = cvtpk2(f[0], f[1]); w.y = cvtpk2(f[2], f[3]); w.z = cvtpk2(f[4], f[5]); w.w = cvtpk2(f[6], f[7]); return w; }
template <int XORL> __device__ __forceinline__ void rope8(float (&f)[8], bool first, const f32x2v* tab) {
#pragma unroll
    for (int e = 0; e < 8; ++e) {
        const f32x2v cs = tab[e];
        const float other = __shfl_xor(f[e], XORL);
        f[e] = first ? (f[e] * cs.x - other * cs.y) : (other * cs.y + f[e] * cs.x);
    }
}
__device__ __forceinline__ void s5_tables(unsigned char* ws, const float* p_cre, const float* p_cim, int mask, int layer, int t0, int stride) {
    const f32x2v* const APOW = (const f32x2v*)(ws + WS_APOW); const f32x2v* const BBAR = (const f32x2v*)(ws + WS_BBAR);
    const float* const KTAB = (const float*)(ws + WS_KTAB); bf16_t* const TZE = (bf16_t*)(ws + WS_TZE); bf16_t* const SM = (bf16_t*)(ws + WS_SM);
                    if (mask & 1) {   constexpr int NL = S5G * KU * (KU / 8); const int N1 = (layer + 1) * NL;
                        for (int e0 = layer * NL + t0; e0 < N1; e0 += 4 * stride) {
                            f32x4 a0[4], a1[4]; size_t dsto[4];
#pragma unroll
                            for (int u = 0; u < 4; ++u) { int e = e0 + u * stride; e = e < N1 ? e : N1 - 1;
                                { const int k8 = e % (KU / 8), n = (e / (KU / 8)) % KU, lg = e / ((KU / 8) * KU), t = n >> 4, ho = n & 15, jj = k8 >> 1, hi0 = (k8 & 1) * 8;
                                    const float* src = KTAB + ((size_t)lg * NLAG + (t - jj + TCH - 1)) * 256 + ho * 16 + hi0; a0[u] = *(const f32x4*)src; a1[u] = *(const f32x4*)(src + 4);
                                    dsto[u] = ((size_t)lg * KU + n) * KS5 + k8 * 8; } }
#pragma unroll
                            for (int u = 0; u < 4; ++u) { const float o[8] = {a0[u].x, a0[u].y, a0[u].z, a0[u].w, a1[u].x, a1[u].y, a1[u].z, a1[u].w}; *(u32x4v*)(TZE + dsto[u]) = pack8(o); }
                        } }
                    if (mask & 2) {   constexpr int NL = S5G * KU * 32; const int N2 = (layer + 1) * NL;
                        for (int e0 = layer * NL + t0; e0 < N2; e0 += 4 * stride) {
                            f32x2v ap[4][4]; f32x4 cr4[4], ci4[4]; size_t dsto[4];
#pragma unroll
                            for (int u = 0; u < 4; ++u) { int e = e0 + u * stride; e = e < N2 ? e : N2 - 1;
                                { const int q = e & 31, n = (e >> 5) % KU, lg = (e >> 5) / KU, t = n >> 4, ho = n & 15, d = q >> 4, p0 = (q & 15) * 4, l = lg / S5G, g = lg % S5G, base = (l * 2 + d) * S5G + g, pw = d == 0 ? t + 1 : TCH - t;
                                    cr4[u] = *(const f32x4*)(p_cre + ((size_t)base * S5H + ho) * S5P + p0); ci4[u] = *(const f32x4*)(p_cim + ((size_t)base * S5H + ho) * S5P + p0);
#pragma unroll
                                    for (int pp = 0; pp < 4; ++pp) ap[u][pp] = APOW[((size_t)base * S5P + p0 + pp) * 65 + pw];
                                    dsto[u] = ((size_t)lg * KU + n) * KS5 + (KU / 8 + q) * 8; } }
#pragma unroll
                            for (int u = 0; u < 4; ++u) { float o[8];
#pragma unroll
                                for (int pp = 0; pp < 4; ++pp) { const float cr = cr4[u][pp], ci = ci4[u][pp]; o[2 * pp] = cr * ap[u][pp].x - ci * ap[u][pp].y; o[2 * pp + 1] = -(cr * ap[u][pp].y + ci * ap[u][pp].x); }
                                *(u32x4v*)(TZE + dsto[u]) = pack8(o); }
                        } }
                    if (mask & 4) {   constexpr int NL = S5G * 256 * (KU / 8); const int N3 = (layer + 1) * NL;
                        for (int e0 = layer * NL + t0; e0 < N3; e0 += 4 * stride) {
                            f32x2v ap[4]; f32x4 bq[4][4]; size_t dsto[4]; int ri[4];
#pragma unroll
                            for (int u = 0; u < 4; ++u) { int e = e0 + u * stride; e = e < N3 ? e : N3 - 1;
                                { const int k8 = e % (KU / 8), n = (e / (KU / 8)) & 255, lg = e / ((KU / 8) * 256), l = lg / S5G, g = lg % S5G, d = n >> 7, p = (n & 127) >> 1, jj = k8 >> 1, hi0 = (k8 & 1) * 8;
                                    const int base = (l * 2 + d) * S5G + g, pw = d == 0 ? TCH - 1 - jj : jj; ri[u] = n & 1;
                                    ap[u] = APOW[((size_t)base * S5P + p) * 65 + pw]; const f32x4* bp = (const f32x4*)(BBAR + ((size_t)base * S5P + p) * S5H + hi0);
#pragma unroll
                                    for (int w = 0; w < 4; ++w) bq[u][w] = bp[w];
                                    dsto[u] = ((size_t)lg * 256 + n) * KU + k8 * 8; } }
#pragma unroll
                            for (int u = 0; u < 4; ++u) { float o[8];
#pragma unroll
                                for (int w = 0; w < 4; ++w) { const f32x4 b2 = bq[u][w];
                                    o[2 * w] = ri[u] ? (ap[u].x * b2.y + ap[u].y * b2.x) : (ap[u].x * b2.x - ap[u].y * b2.y);
                                    o[2 * w + 1] = ri[u] ? (ap[u].x * b2.w + ap[u].y * b2.z) : (ap[u].x * b2.z - ap[u].y * b2.w); }
                                *(u32x4v*)(SM + dsto[u]) = pack8(o); }
                        } }
}
__device__ __forceinline__ const void* ldptr(LAS unsigned char* ldsl, int i) {
    const unsigned long long v = *(volatile LAS unsigned long long*)(ldsl + PTR_OFF + 8 * i);
    const unsigned lo = __builtin_amdgcn_readfirstlane((unsigned)v), hi = __builtin_amdgcn_readfirstlane((unsigned)(v >> 32));
    return (const void*)(const GAS void*)(((unsigned long long)hi << 32) | lo);
}
struct Args { const float* in[27]; float* out; unsigned char* ws; int ph_lo, ph_hi; };
__global__ void __launch_bounds__(NWAVES * 64, 2) mega_fwd(Args args) {
    extern __shared__ __attribute__((aligned(16))) unsigned char lds[];
    LAS unsigned char* const ldsl = (LAS unsigned char*)lds;
    const int tid = threadIdx.x;
#define PH_IDS int tid_l = threadIdx.x; asm volatile("" : "+v"(tid_l)); const int tid = tid_l, lane = tid & 63, wave = __builtin_amdgcn_readfirstlane(tid >> 6); \
    int G_l = gridDim.x, bx_l = blockIdx.x; asm volatile("" : "+s"(G_l), "+s"(bx_l)); const int G = G_l, bx = bx_l, vcu = (G % 8 == 0) ? (bx % 8) * (G / 8) + bx / 8 : bx; \
    const int gw = vcu * NWAVES + wave, NGW = G * NWAVES; (void)lane; (void)gw; (void)NGW; (void)vcu; (void)bx; (void)tid;
    for (int u = tid; u < (LDS_BYTES - LDSCTL_OFF) / 4; u += NWAVES * 64) ((LAS unsigned*)(ldsl + LDSCTL_OFF))[u] = 0u;
    __syncthreads();
    if (tid < 27) ((LAS unsigned long long*)(ldsl + PTR_OFF))[tid] = (unsigned long long)args.in[tid];
    if (tid == 27) ((LAS unsigned long long*)(ldsl + PTR_OFF))[27] = (unsigned long long)args.out;
    if (tid == 28) ((LAS unsigned long long*)(ldsl + PTR_OFF))[28] = (unsigned long long)args.ws;
    __syncthreads();
#define INP(i) ((const float*)ldptr(ldsl, (i)))
#define WSP() ((unsigned char*)ldptr(ldsl, 28))
#define WS_F32(off) ((float*)(ws + (off)))
#define WS_BF(off) ((bf16_t*)(ws + (off)))
    XcdBarrier bar; bar.bar = (unsigned*)(args.ws + WS_CTL) + CW_BAR; bar.x = 0; bar.st = nullptr;
    if (MK_N_LAUNCHES == 1) bar = xcd_barrier_post((unsigned*)(args.ws + WS_CTL) + CW_BAR, (volatile LAS unsigned*)(ldsl + MISC_OFF) + 8);
    const int lo = args.ph_lo, hi = args.ph_hi; int ph = 0;
#define PH_ON (ph >= lo && ph < hi)
#define PH_END do { if (ph >= lo && ph + 1 < hi) xcd_barrier(bar); asm volatile("" ::: "memory"); ++ph; } while (0)
    if (PH_ON) for (int rep = 0; rep < PROBE_REPS(ph); ++rep) { PH_IDS (void)rep;
        unsigned char* const ws = WSP();
        {   const float* const c_in = INP(1); const float* const cctx_in = INP(3); const float* const ada_w = INP(4); const float* const ada_b = INP(5); float* const MODV = WS_F32(WS_MODV);
            LAS float* sl = (LAS float*)ldsl;
            LAS float* part = (LAS float*)(ldsl + 40960);
            for (int i = tid; i < 5 * DM; i += NWAVES * 64) { const int m = i / DM, k = i % DM; const float v = m < 4 ? c_in[m * DM + k] : cctx_in[k]; sl[i] = v / (1.f + expf(-v)); }
            __syncthreads();
            for (int it = vcu; it < 2 * 288; it += G) {
                const int layer = it / 288, n0 = (it % 288) * 64, kb = wave * 256;
                const float* W = ada_w + (size_t)layer * DM * MODW + (size_t)kb * MODW + n0 + lane;
                float a0 = 0.f, a1 = 0.f, a2 = 0.f, a3 = 0.f, a4 = 0.f;
#pragma unroll 4
                for (int kk = 0; kk < 256; kk += 4) {
                    const float w0 = W[(size_t)(kk + 0) * MODW], w1 = W[(size_t)(kk + 1) * MODW], w2 = W[(size_t)(kk + 2) * MODW], w3 = W[(size_t)(kk + 3) * MODW];
                    const f32x4 s0 = *(const LAS f32x4*)(sl + 0 * DM + kb + kk), s1 = *(const LAS f32x4*)(sl + 1 * DM + kb + kk), s2 = *(const LAS f32x4*)(sl + 2 * DM + kb + kk),
                                s3 = *(const LAS f32x4*)(sl + 3 * DM + kb + kk), s4 = *(const LAS f32x4*)(sl + 4 * DM + kb + kk);
                    a0 += s0.x * w0 + s0.y * w1 + s0.z * w2 + s0.w * w3; a1 += s1.x * w0 + s1.y * w1 + s1.z * w2 + s1.w * w3; a2 += s2.x * w0 + s2.y * w1 + s2.z * w2 + s2.w * w3;
                    a3 += s3.x * w0 + s3.y * w1 + s3.z * w2 + s3.w * w3; a4 += s4.x * w0 + s4.y * w1 + s4.z * w2 + s4.w * w3;
                }
                part[(wave * 5 + 0) * 64 + lane] = a0; part[(wave * 5 + 1) * 64 + lane] = a1; part[(wave * 5 + 2) * 64 + lane] = a2; part[(wave * 5 + 3) * 64 + lane] = a3; part[(wave * 5 + 4) * 64 + lane] = a4;
                __syncthreads();
                if (tid < 320) { const int m = tid >> 6, l = tid & 63; float s = 0.f;
#pragma unroll
                    for (int w = 0; w < 8; ++w) s += part[(w * 5 + m) * 64 + l];
                    MODV[(size_t)(layer * 5 + m) * MODW + n0 + l] = s + ada_b[layer * MODW + n0 + l]; }
                __syncthreads();
            }
        }
        __syncthreads();
        {   LAS float* scr = (LAS float*)(ldsl + wave * 16384);
            bf16_t* const WGU = WS_BF(WS_WGU); bf16_t* const WD = WS_BF(WS_WD); bf16_t* const WIN = WS_BF(WS_WIN); bf16_t* const WOUT = WS_BF(WS_WOUT); bf16_t* const GLUW = WS_BF(WS_GLU);
            constexpr int I_F = 5632, I_FFN = 3 * I_F * 4, I_IN = 3584, I_OUT = 2048, I_GLU = 128, I_L = I_IN + I_OUT + I_GLU, NITEMS = I_FFN + 2 * I_L;
            const int n3 = (2 * 288 > 2 * G) ? 2 * 288 - 2 * G : 0, vw = vcu < n3 ? (wave < 7 ? vcu * 7 + wave : -1) : n3 * 7 + (vcu - n3) * 8 + wave, NVW = n3 * 7 + (G - n3) * 8;
            for (int it = vw; it < NITEMS && it >= 0; it += NVW) {
                if (it < I_FFN) { const int fi = it / (3 * I_F), rem = it % (3 * I_F), kind = rem / I_F, item = rem % I_F;
                    if (kind < 2) { const int nblk = FF / 32, kbk = item / nblk, nb = item % nblk, n0 = 32 * nb;
                        transpose_item(INP(7 + kind) + (size_t)fi * DM * FF, DM, FF, WGU + (size_t)fi * 2 * FF * DM, 64 * kbk, n0, (n0 / 128) * 256 + (n0 % 128) + kind * 128, scr, lane); }
                    else { const int nblk = DM / 32, kbk = item / nblk, nb = item % nblk;
                        transpose_item(INP(9) + (size_t)fi * FF * DM, FF, DM, WD + (size_t)fi * DM * FF, 64 * kbk, 32 * nb, 32 * nb, scr, lane); } }
                else { const int it2 = it - I_FFN, l = it2 / I_L, rem = it2 % I_L;
                    if (rem < I_IN) { const int nblk = INC / 32, kbk = rem / nblk, nb = rem % nblk;
                        transpose_item(INP(10) + (size_t)l * DM * INC, DM, INC, WIN + (size_t)l * INC * DM, 64 * kbk, 32 * nb, 32 * nb, scr, lane); }
                    else if (rem < I_IN + I_OUT) { const int r2 = rem - I_IN, nblk = DM / 32, kbk = r2 / nblk, nb = r2 % nblk;
                        transpose_item(INP(11) + (size_t)l * DM * DM, DM, DM, WOUT + (size_t)l * DM * DM, 64 * kbk, 32 * nb, 32 * nb, scr, lane); }
                    else { const int r2 = rem - I_IN - I_OUT, nblk = 512 / 32, kbk = r2 / nblk, nb = r2 % nblk;
                        transpose_item(INP(20) + (size_t)l * 512 * 512, 512, 512, GLUW + (size_t)l * 512 * 512, 64 * kbk, 32 * nb, 32 * nb, scr, lane); } }
            }
        }
        {   const float* const ctx_in = INP(2); float* const XS = WS_F32(WS_XS);
            for (int i = bx * (NWAVES * 64) + tid; i < NB * CTXL * (DM / 4); i += G * (NWAVES * 64)) {
                const int r = i / (DM / 4), c4 = i % (DM / 4), b = r / CTXL, s_ = r % CTXL;
                ((f32x4*)(XS + (size_t)(b * SPB + s_) * DM))[c4] = ((const f32x4*)ctx_in)[i]; }
        }
        {   f32x2v* const ROPE = (f32x2v*)(ws + WS_ROPE);
            for (int e = bx * (NWAVES * 64) + tid; e < 64 * 48; e += G * (NWAVES * 64)) { const int pos = e / 48, i = e % 48;
                const float freq = i < 16 ? exp2f(-(float)i * (13.287712379549449f / 16.f)) : exp2f(-(float)(i - 16) * (13.287712379549449f / 32.f));
                const float ang = (float)pos * freq; ROPE[e] = (f32x2v){cosf(ang), sinf(ang)}; } }
        {   const float* const p_lre = INP(12); const float* const p_lim = INP(13); const float* const p_ldt = INP(14); const float* const p_bre = INP(15); const float* const p_bim = INP(16);
            f32x2v* const APOW = (f32x2v*)(ws + WS_APOW); f32x2v* const BBAR = (f32x2v*)(ws + WS_BBAR);
        for (int idx = bx * (NWAVES * 64) + tid; idx < 2 * 2 * S5G * S5P * 65; idx += G * (NWAVES * 64)) { const int e = idx / 65, k = idx % 65;
            const float lre = p_lre[e], lim = p_lim[e], dt = expf(p_ldt[e / S5P]);
            const float xr = lre * dt; const double trev = (double)lim * (double)dt * 0.15915494309189535;
            const double tk = trev * (double)k; const float ang = (float)((tk - floor(tk)) * 6.283185307179586); const float mg = expf(xr * (float)k);
            APOW[idx] = (f32x2v){mg * cosf(ang), mg * sinf(ang)}; }
        for (int idx = bx * (NWAVES * 64) + tid; idx < 2 * 2 * S5G * S5P * S5H; idx += G * (NWAVES * 64)) { const int e = idx / S5H;
            const float lre = p_lre[e], lim = p_lim[e], dt = expf(p_ldt[e / S5P]);
            const float xr = lre * dt; const double trev = (double)lim * (double)dt * 0.15915494309189535;
            const float y = (float)((trev - floor(trev)) * 6.283185307179586);
            const float er = expm1f(xr), cy = cosf(y), sy = sinf(y), shf = sinf(0.5f * y);
            const float nr = er * cy - 2.f * shf * shf, ni = (er + 1.f) * sy, den = 1.f / (lre * lre + lim * lim);
            const float qr = (nr * lre + ni * lim) * den, qi = (ni * lre - nr * lim) * den;
            const float br = p_bre[idx], bi = p_bim[idx];
            BBAR[idx] = (f32x2v){qr * br - qi * bi, qr * bi + qi * br}; }
        }
    }
    PH_END;

    for (int fi = 0; fi < 4; ++fi) {
        const int layer = fi >> 1, which = fi & 1;
        if (PH_ON) for (int rep = 0; rep < PROBE_REPS(ph); ++rep) { PH_IDS (void)rep;
            unsigned char* const ws = WSP(); const float* const modl = WS_F32(WS_MODV) + (size_t)layer * 5 * MODW;
            {
                const bool fix = (fi == 1 || fi == 2) && rep == 0; const float* const pg = WS_F32(WS_MODV) + (size_t)4 * MODW + (fi == 1 ? 5 : 8) * DM;
                norm_mod_rows(WS_F32(WS_XS), WS_BF(WS_H), INP(6) + (size_t)(layer * 3 + which * 2) * DM, modl, which * 2, gw, NGW, lane, tid, (LAS float*)ldsl, fix ? WS_F32(WS_PART) : nullptr, pg, fi == 1 ? 1.f : 0.5f, fi == 3, fi == 0 ? INP(0) : nullptr); }
            if (fi == 0) {
                const float* const p_cre = INP(17); const float* const p_cim = INP(18); const f32x2v* const APOW = (const f32x2v*)(ws + WS_APOW); const f32x2v* const BBAR = (const f32x2v*)(ws + WS_BBAR); float* const KTAB = WS_F32(WS_KTAB);
                for (int e = bx * (NWAVES * 64) + tid; e < 2 * S5G * 2 * (TCH / 8) * 256; e += G * (NWAVES * 64)) {
                    const int hi_ = e & 15, ho = (e >> 4) & 15, kg = (e >> 8) % (TCH / 8), d = ((e >> 8) / (TCH / 8)) & 1, lg = (e >> 8) / (TCH / 8) / 2, l = lg / S5G, g = lg % S5G;
                    const int base = (l * 2 + d) * S5G + g;
                    const float* cre = p_cre + ((size_t)base * S5H + ho) * S5P; const float* cim = p_cim + ((size_t)base * S5H + ho) * S5P;
                    float acc[8] = {0.f, 0.f, 0.f, 0.f, 0.f, 0.f, 0.f, 0.f};
#pragma unroll 4
                    for (int p = 0; p < S5P; ++p) { const f32x2v bb = BBAR[((size_t)base * S5P + p) * S5H + hi_]; const float cr = cre[p], ci = cim[p];
                        const float wr_ = cr * bb.x - ci * bb.y, wi_ = cr * bb.y + ci * bb.x; const f32x2v* ap = APOW + ((size_t)base * S5P + p) * 65 + 8 * kg;
#pragma unroll
                        for (int q = 0; q < 8; ++q) { const f32x2v a = ap[q]; acc[q] += wr_ * a.x - wi_ * a.y; } }
                    if (d == 0 && kg == 0) { const int base1 = (l * 2 + 1) * S5G + g; const float* cre1 = p_cre + ((size_t)base1 * S5H + ho) * S5P; const float* cim1 = p_cim + ((size_t)base1 * S5H + ho) * S5P;
#pragma unroll 8
                        for (int p = 0; p < S5P; ++p) { const f32x2v bb = BBAR[((size_t)base1 * S5P + p) * S5H + hi_]; acc[0] += cre1[p] * bb.x - cim1[p] * bb.y; } }
#pragma unroll
                    for (int q = 0; q < 8; ++q) { const int k = 8 * kg + q; if (d == 1 && k == 0) continue;
                        KTAB[((size_t)lg * NLAG + (TCH - 1) + (d == 0 ? k : -k)) * 256 + ho * 16 + hi_] = acc[q]; }
                }
            }
        }
        PH_END;
        if (PH_ON) for (int rep = 0; rep < PROBE_REPS(ph); ++rep) { PH_IDS (void)rep;
            unsigned char* const ws = WSP();
            pg8::Gemm g{WS_BF(WS_H), WS_BF(WS_WGU) + (size_t)fi * 2 * FF * DM, R, 2 * FF, DM, DM, DM}; pg8::FlexOrder S; S.init(fi == 3, 2 * FF, G, bx);
            pg8::EpiGU E{WS_BF(WS_HACT)};
            pg8::gemm_phase<pg8::EpiGU, pg8::FlexOrder, true, true>(ldsl, g, S, E);
            if (fi == 0 && G == 256 && bx >= 176 && rep == 0) s5_tables(ws, INP(17), INP(18), 1, 0, (bx - 176) * (NWAVES * 64) + tid, 80 * (NWAVES * 64));
        }
        PH_END;
        if (PH_ON) for (int rep = 0; rep < PROBE_REPS(ph); ++rep) { PH_IDS (void)rep;
            unsigned char* const ws = WSP(); const float* const modl = WS_F32(WS_MODV) + (size_t)layer * 5 * MODW;
            if (fi < 3) {
                pg8::Gemm g{WS_BF(WS_HACT), WS_BF(WS_WD) + (size_t)fi * DM * FF, R, DM, FF / 4, FF, FF}; pg8::CtxSplitOrder S{G, bx, (FF / 4) * 2};
                pg8::EpiPart E{WS_F32(WS_PART)};
                pg8::gemm_phase<pg8::EpiPart, pg8::CtxSplitOrder, true, true>(ldsl, g, S, E);
                if (G == 256 && bx >= 128 && rep == 0) s5_tables(ws, INP(17), INP(18), fi == 0 ? 6 : fi == 1 ? 3 : 4, fi == 0 ? 0 : 1, (bx - 128) * (NWAVES * 64) + tid, 128 * (NWAVES * 64)); }
            pg8::Gemm g{WS_BF(WS_HACT), WS_BF(WS_WD) + (size_t)fi * DM * FF, R, DM, FF, FF, FF}; pg8::FlexOrder S; S.init(true, DM, G, bx);
            if (fi == 0) { pg8::EpiResidX E{WS_F32(WS_XS), modl + (size_t)2 * DM, INP(0)};
                pg8::gemm_phase<pg8::EpiResidX, pg8::FlexOrder, true, true>(ldsl, g, S, E); }
            else { pg8::EpiResid E{WS_F32(WS_XS), modl + (size_t)(which * 6 + 2) * DM, rep ? 0.f : 0.5f};
                pg8::gemm_phase<pg8::EpiResid, pg8::FlexOrder, true, true>(ldsl, g, S, E); }
        }
        PH_END;
        if (which == 0) {
            if (PH_ON) for (int rep = 0; rep < PROBE_REPS(ph); ++rep) { PH_IDS (void)rep;
                unsigned char* const ws = WSP(); const float* const modl = WS_F32(WS_MODV) + (size_t)layer * 5 * MODW;
                norm_mod_rows(WS_F32(WS_XS), WS_BF(WS_H), INP(6) + (size_t)(layer * 3 + 1) * DM, modl, 1, gw, NGW, lane, tid, (LAS float*)ldsl, rep == 0 ? WS_F32(WS_PART) : nullptr, modl + (size_t)4 * MODW + 2 * DM, 0.5f, false, nullptr);
                if (layer == 0) { if (G == 256) {   }
                    else { s5_tables(ws, INP(17), INP(18), 7, 0, bx * (NWAVES * 64) + tid, G * (NWAVES * 64)); s5_tables(ws, INP(17), INP(18), 7, 1, bx * (NWAVES * 64) + tid, G * (NWAVES * 64)); } }
            }
            PH_END;
            if (PH_ON) for (int rep = 0; rep < PROBE_REPS(ph); ++rep) { PH_IDS (void)rep;
                unsigned char* const ws = WSP();
                pg8::Gemm g{WS_BF(WS_H), WS_BF(WS_WIN) + (size_t)layer * INC * DM, R, INC, DM, DM, DM}; pg8::StaticOrder S; S.init(R, INC, G, bx);
                pg8::EpiWin E{WS_BF(WS_P), WS_BF(WS_UG), WS_BF(WS_VA)};
                pg8::gemm_phase<pg8::EpiWin, pg8::StaticOrder, true, true>(ldsl, g, S, E);
            }
            PH_END;
            if (PH_ON) for (int rep = 0; rep < PROBE_REPS(ph); ++rep) { PH_IDS (void)rep;
                unsigned char* const ws = WSP();
                {   pg8::Gemm g{WS_BF(WS_UG), WS_BF(WS_SM) + (size_t)layer * S5G * 256 * KU, S5G * RCP, S5G * 256, KU, KS5, KU}; pg8::S5StateOrder S{G, bx};
                    pg8::EpiS5State E{WS_F32(WS_SST)};
                    pg8::gemm_phase<pg8::EpiS5State, pg8::S5StateOrder, true, true>(ldsl, g, S, E); }
                const float* kg = INP(25) + layer * 128;
                const bf16_t* const PB = WS_BF(WS_P); bf16_t* const KA = WS_BF(WS_KA); const f32x2v* const ROPE = (const f32x2v*)(ws + WS_ROPE);
                constexpr int NSU = S5G * RCT; const bool spare = G > 2 * NSU;
                for (int r = spare ? (bx - NSU) * NWAVES + wave : gw; r < R && r >= 0; r += spare ? (G - NSU) * NWAVES : NGW) {
                    const int b = r / SPB, s = r % SPB; const bool lat = s >= CTXL; const int t = lat ? s - CTXL : 0; const f32x2v* const trow = ROPE + (t >> 6) * 48; const f32x2v* const tcol = ROPE + (t & 63) * 48;
                    const bf16_t* pr = PB + (size_t)r * INC; bf16_t* ka = KA + ((size_t)(b * 6) * SPB + s) * 128;
                    const int li8 = lane & 7, li16 = lane & 15; float f[8];
                    {
                        unpack8(*(const u32x4v*)(pr + 1024 + 8 * lane), f);
                        if (lat) rope8<2>(f, (li8 & 2) == 0, (li8 < 4 ? trow : tcol) + 8 * (li8 & 1));
                        *(u32x4v*)(ka + (size_t)(lane >> 4) * SPB * 128 + 8 * (lane & 15)) = pack8(f); }
                    {
                        const int lk = lane & 31;
                        unpack8(*(const u32x4v*)(pr + 3072 + 8 * lk), f);
                        float ss = 0.f;
#pragma unroll
                        for (int e = 0; e < 8; ++e) ss += f[e] * f[e];
                        ss += __shfl_xor(ss, 1); ss += __shfl_xor(ss, 2); ss += __shfl_xor(ss, 4); ss += __shfl_xor(ss, 8);
                        const float rstd = 1.f / sqrtf(ss * (1.f / 128.f) + EPS);
#pragma unroll
                        for (int e = 0; e < 8; ++e) f[e] = f[e] * rstd * kg[8 * li16 + e];
                        if (lat) rope8<4>(f, (li16 & 4) == 0, (li16 < 8 ? trow : tcol) + 16 + 8 * (li16 & 3));
                        if (lane < 32) *(u32x4v*)(ka + (size_t)(4 + (lk >> 4)) * SPB * 128 + 8 * (lk & 15)) = pack8(f); }
                }
            }
            PH_END;
            if (PH_ON) for (int rep = 0; rep < PROBE_REPS(ph); ++rep) { PH_IDS (void)rep;
                unsigned char* const ws = WSP();
                {
                    static_assert(NCH / 17 == 8, "the two-level scan is laid out for 8 segments of 17 chunks");
                    const f32x2v* const APOW = (const f32x2v*)(ws + WS_APOW); const float* const SST = WS_F32(WS_SST); bf16_t* const UG = WS_BF(WS_UG);
                    for (int item = gw; item < NB * S5G * 2 * 8; item += NGW) {
                        const int oct = item & 7, d = (item >> 3) & 1, g = (item >> 4) & 31, b = item >> 9, seg = lane >> 3, p = oct * 8 + (lane & 7);
                        const f32x2v aT = APOW[((size_t)((layer * 2 + d) * S5G + g) * S5P + p) * 65 + TCH];
                        f32x2v sv[17];
#pragma unroll
                        for (int q = 0; q < 17; ++q) { const int idx = seg * 17 + q, c = d == 0 ? idx : (idx < NCC ? NCC - 1 - idx : NCH + NCC - 1 - idx);
                            sv[q] = *(const f32x2v*)(SST + (size_t)(g * RCP + b * NCH + c) * 256 + d * 128 + p * 2); }
                        float lr[17], li[17]; float rr = 0.f, ri_ = 0.f;
#pragma unroll
                        for (int q = 0; q < 17; ++q) { lr[q] = rr; li[q] = ri_; const float nr = aT.x * rr - aT.y * ri_ + sv[q].x, ni = aT.x * ri_ + aT.y * rr + sv[q].y; rr = nr; ri_ = ni; }
                        float ar = 1.f, ai = 0.f;
#pragma unroll
                        for (int q = 0; q < 17; ++q) { const float nr = ar * aT.x - ai * aT.y, ni = ar * aT.y + ai * aT.x; ar = nr; ai = ni; }
                        float cr = 0.f, ci = 0.f;
#pragma unroll
                        for (int sgi = 0; sgi < 7; ++sgi) { const float tr = __shfl(rr, sgi * 8 + (lane & 7)), ti = __shfl(ri_, sgi * 8 + (lane & 7));
                            if (sgi < seg) { const float nr = ar * cr - ai * ci + tr, ni = ar * ci + ai * cr + ti; cr = nr; ci = ni; } }
                        float pr = 1.f, pi = 0.f;
#pragma unroll
                        for (int q = 0; q < 17; ++q) { const int idx = seg * 17 + q, c = d == 0 ? idx : (idx < NCC ? NCC - 1 - idx : NCH + NCC - 1 - idx);
                            const float hr = lr[q] + pr * cr - pi * ci, hi_ = li[q] + pr * ci + pi * cr;
                            *(unsigned*)(UG + (size_t)(g * RCP + b * NCH + c) * KS5 + KU + d * 128 + p * 2) = cvtpk2(hr, hi_);
                            const float nr = pr * aT.x - pi * aT.y, ni = pr * aT.y + pi * aT.x; pr = nr; pi = ni; }
                    }
                }
                const bf16_t* const KA = WS_BF(WS_KA); const bf16_t* const PB = WS_BF(WS_P); const float* const qgf = INP(24) + layer * 128; const float* const ropef = (const float*)(ws + WS_ROPE); const bf16_t* const VA = WS_BF(WS_VA); bf16_t* const OD = WS_BF(WS_OD); bf16_t* const MIX = WS_BF(WS_MIX);
                const int nunits = 1024 + (layer == 0 ? 64 : 0);
                for (int i = 0;; ++i) {
                    const int U = i * G + vcu; if (U >= nunits) break;
                    int b, slot, qrow0, seq;
                    if (U < 1024) { b = U >> 8; slot = ((U >> 4) + 8 * (b & 1)) & 15; qrow0 = b * SPB + CTXL + (U & 15) * 256; seq = SPB; }
                    else { const int U2 = U - 1024; b = U2 >> 4; slot = U2 & 15; qrow0 = b * SPB; seq = CTXL; }
                    const size_t kvoff = ((size_t)(b * 6 + (slot < 8 ? (slot >> 1) : 4 + ((slot - 8) >> 2))) * SPB) * 128;

                    __syncthreads();
                    const int tpos0 = U < 1024 ? (U & 15) * 256 : -1;
                    if (slot < 8)
                        at128::attn_dma_body<4, INC, 128, 128, 1024, 1024>((const at128::bf16*)(PB + (size_t)qrow0 * INC + 512 + slot * 64), (const at128::bf16*)(KA + kvoff),
                            (const at128::bf16*)(VA + kvoff), nullptr, (at128::bf16*)(OD + (size_t)qrow0 * 1024 + slot * 128), seq, (char*)lds, (slot & 1) * 128, nullptr, ropef, tpos0);
                    else
                        at128::attn_dma_body<8, INC, 128, 128, 1024, DM>((const at128::bf16*)(PB + (size_t)qrow0 * INC + 2048 + (slot - 8) * 128), (const at128::bf16*)(KA + kvoff),
                            (const at128::bf16*)(VA + kvoff), nullptr, (at128::bf16*)(MIX + (size_t)qrow0 * DM + 1024 + (slot - 8) * 128), seq, (char*)lds, 0, qgf, ropef, tpos0);
                }
                __syncthreads();
            }
            PH_END;
            if (PH_ON) for (int rep = 0; rep < PROBE_REPS(ph); ++rep) { PH_IDS (void)rep;
                unsigned char* const ws = WSP();
                {   pg8::Gemm g{WS_BF(WS_UG), WS_BF(WS_TZE) + (size_t)layer * S5G * KU * KS5, S5G * RCP, S5G * KU, KS5, KS5, KS5}; pg8::S5OutOrder S{G, bx};
                    pg8::EpiS5Out E{WS_BF(WS_UG), INP(19) + layer * 512, WS_BF(WS_YG)};
                    pg8::gemm_phase<pg8::EpiS5Out, pg8::S5OutOrder, true, true>(ldsl, g, S, E); }
                const float* lv = INP(22) + layer * 256; const bf16_t* const OD = WS_BF(WS_OD); bf16_t* const MIX = WS_BF(WS_MIX); const float lam_init = layer == 0 ? 0.2f : 0.35550906759f;
                const float lam = expf(wave_sum(lv[lane] * lv[64 + lane])) - expf(wave_sum(lv[128 + lane] * lv[192 + lane])) + lam_init;
                const float* sg = INP(23) + layer * 128; const int li16 = lane & 15, hh = lane >> 4;
                const bool deal = (G == 256); const bool busy = bx < 192;
                const int w1 = deal ? (busy ? bx * NWAVES + wave : (bx - 192) * NWAVES + wave) : gw;
                const int rbase = deal ? (busy ? 0 : 192 * NWAVES * 2) : 0, rstep = deal ? (busy ? 192 * NWAVES : 64 * NWAVES) : NGW, rend = deal ? (busy ? 192 * NWAVES * 2 : R) : R;
                for (int r0 = rbase + w1; r0 < rend; r0 += 4 * rstep) {
                    u32x4v q1[4], q2[4]; int rr[4];
#pragma unroll
                    for (int u = 0; u < 4; ++u) { const int r = r0 + u * rstep; rr[u] = r < rend ? r : r0;
                        const bf16_t* o1 = OD + (size_t)rr[u] * 1024 + (2 * hh) * 128 + 8 * li16; q1[u] = *(const u32x4v*)o1; q2[u] = *(const u32x4v*)(o1 + 128); }
#pragma unroll
                    for (int u = 0; u < 4; ++u) { const int r = rr[u];
                        if (layer == 1 && (r % SPB) < CTXL) continue;
                        float f[8], f2[8]; unpack8(q1[u], f); unpack8(q2[u], f2);
#pragma unroll
                        for (int e = 0; e < 8; ++e) f[e] -= lam * f2[e];
                        float ss = 0.f;
#pragma unroll
                        for (int e = 0; e < 8; ++e) ss += f[e] * f[e];
                        ss += __shfl_xor(ss, 1); ss += __shfl_xor(ss, 2); ss += __shfl_xor(ss, 4); ss += __shfl_xor(ss, 8);
                        const float rstd = (1.f - lam_init) / sqrtf(ss * (1.f / 128.f) + EPS);
#pragma unroll
                        for (int e = 0; e < 8; ++e) f[e] = f[e] * rstd * sg[8 * li16 + e];
                        *(u32x4v*)(MIX + (size_t)r * DM + 512 + hh * 128 + 8 * li16) = pack8(f);
                    }
                }
            }
            PH_END;
            if (PH_ON) for (int rep = 0; rep < PROBE_REPS(ph); ++rep) { PH_IDS (void)rep;
                unsigned char* const ws = WSP();
                pg8::Gemm g{WS_BF(WS_YG), WS_BF(WS_GLU) + (size_t)layer * 512 * 512, R, 512, 512, 512, 512}; pg8::StaticOrder S; S.init(R, 512, G, bx);
                pg8::EpiGLU E{WS_BF(WS_YG), INP(21) + layer * 512, WS_BF(WS_MIX)};
                pg8::gemm_phase<pg8::EpiGLU, pg8::StaticOrder, true, true>(ldsl, g, S, E);
            }
            PH_END;
            if (PH_ON) for (int rep = 0; rep < PROBE_REPS(ph); ++rep) { PH_IDS (void)rep;
                unsigned char* const ws = WSP(); const float* const modl = WS_F32(WS_MODV) + (size_t)layer * 5 * MODW;
                if (layer == 0) {
                    pg8::Gemm g{WS_BF(WS_MIX), WS_BF(WS_WOUT), R, DM, DM / 4, DM, DM}; pg8::CtxSplitOrder S{G, bx, (DM / 4) * 2};
                    pg8::EpiPart E{WS_F32(WS_PART)};
                    pg8::gemm_phase<pg8::EpiPart, pg8::CtxSplitOrder, true, true>(ldsl, g, S, E); }
                pg8::Gemm g{WS_BF(WS_MIX), WS_BF(WS_WOUT) + (size_t)layer * DM * DM, R, DM, DM, DM, DM}; pg8::FlexOrder S; S.init(true, DM, G, bx);
                pg8::EpiResid E{WS_F32(WS_XS), modl + (size_t)5 * DM, rep ? 0.f : 1.0f};
                pg8::gemm_phase<pg8::EpiResid, pg8::FlexOrder, true, true>(ldsl, g, S, E);
            }
            PH_END;
        }
    }
    if (PH_ON) for (int rep = 0; rep < PROBE_REPS(ph); ++rep) { PH_IDS (void)rep;
        unsigned char* const ws = WSP(); const float* fg = INP(26); const float* const XS = WS_F32(WS_XS); float* const outp = (float*)ldptr(ldsl, 27);
        for (int q0 = gw; q0 < NB * SEQL; q0 += 2 * NGW) {
            f32x4 v[2][8]; int qq[2];
#pragma unroll
            for (int u = 0; u < 2; ++u) { const int q = q0 + u * NGW < NB * SEQL ? q0 + u * NGW : q0; qq[u] = q; const int b = q / SEQL, t = q % SEQL; const f32x4* xr = (const f32x4*)(XS + (size_t)(b * SPB + CTXL + t) * DM) + lane;
#pragma unroll
                for (int j = 0; j < 8; ++j) v[u][j] = xr[64 * j]; }
#pragma unroll
            for (int u = 0; u < 2; ++u) { if (u == 1 && qq[1] == q0) continue;
                float ss = 0.f;
#pragma unroll
                for (int j = 0; j < 8; ++j) ss += (v[u][j].x * v[u][j].x + v[u][j].y * v[u][j].y) + (v[u][j].z * v[u][j].z + v[u][j].w * v[u][j].w);
                const float rstd = 1.f / sqrtf(wave_sum(ss) * (1.f / DM) + EPS);
                f32x4* orow = (f32x4*)(outp + (size_t)qq[u] * DM) + lane;
#pragma unroll
                for (int j = 0; j < 8; ++j) orow[64 * j] = v[u][j] * rstd * *(const f32x4*)(fg + 4 * (lane + 64 * j)); }
        }
    }
#undef PH_ON
#undef PH_END
}

extern "C" void kernel_launch(void* const* d_in, const int* in_sizes, int n_in, void* d_out, int out_size, void* d_ws, size_t ws_size, hipStream_t stream) {
    static int grid = 0;
    if (grid == 0) {
        if (n_in != 27 || in_sizes[0] != NB * SEQL * DM || out_size != NB * SEQL * DM || ws_size < WS_END) {
            fprintf(stderr, "kernel_launch: shape mismatch: n_in %d in0 %d out %d ws %zu (need %zu)\n", n_in, n_in > 0 ? in_sizes[0] : -1, out_size, ws_size, (size_t)WS_END); grid = -1; return; }
        int dev = 0, cus = 0, per_cu = 0;
        if (hipGetDevice(&dev) != hipSuccess || hipDeviceGetAttribute(&cus, hipDeviceAttributeMultiprocessorCount, dev) != hipSuccess) { fprintf(stderr, "kernel_launch: device query failed\n"); grid = -1; return; }
        if (hipFuncSetAttribute((const void*)mega_fwd, hipFuncAttributeMaxDynamicSharedMemorySize, LDS_BYTES) != hipSuccess) { fprintf(stderr, "kernel_launch: hipFuncSetAttribute failed\n"); grid = -1; return; }
        if (hipOccupancyMaxActiveBlocksPerMultiprocessor(&per_cu, (const void*)mega_fwd, NWAVES * 64, LDS_BYTES) != hipSuccess || per_cu < 1)
            fprintf(stderr, "kernel_launch: note: occupancy query reports %d workgroups per CU\n", per_cu);
        (void)hipGetLastError();
        grid = cus;
    }
    if (grid < 0) return;
    if (hipMemsetAsync((char*)d_ws + WS_CTL, 0, CTL_ZERO_BYTES, stream) != hipSuccess) { fprintf(stderr, "kernel_launch: memset failed\n"); return; }
    Args a{};
    for (int i = 0; i < 27; ++i) a.in[i] = (const float*)d_in[i];
    a.out = (float*)d_out; a.ws = (unsigned char*)d_ws;
#if MK_N_LAUNCHES == 1
    a.ph_lo = 0; a.ph_hi = NPH;
    hipLaunchKernelGGL(mega_fwd, dim3(grid), dim3(NWAVES * 64), LDS_BYTES, stream, a);
#else
    for (int k = 0; k < NPH; ++k) { a.ph_lo = k; a.ph_hi = k + 1; hipLaunchKernelGGL(mega_fwd, dim3(grid), dim3(NWAVES * 64), LDS_BYTES, stream, a); }
#endif
    const hipError_t le = hipPeekAtLastError();
    if (le != hipSuccess) fprintf(stderr, "kernel_launch: launch failed: %s\n", hipGetErrorName(le));
}
```

```cpp
#include <hip/hip_runtime.h>
#include <hip/hip_bf16.h>
#include <cstdio>
#include <cstdint>
#include <cmath>
namespace pg8 {
#define PG8_LAS __attribute__((address_space(3)))
typedef unsigned short bf16_t;
typedef short bf16x8 __attribute__((ext_vector_type(8)));
typedef float f32x4 __attribute__((ext_vector_type(4)));
typedef unsigned u32x4 __attribute__((ext_vector_type(4)));
constexpr int BM = 256, BK = 64, HALF = 128, HTB = HALF * BK * 2  , STAGE_BYTES = 8 * HTB, NXCD = 8, WGM = 8;

__host__ __device__ __forceinline__ int lds_byte(int r, int c) { const int st = (r >> 4) * 2 + (c >> 5), rr = r & 15, cc = c & 31, ob = rr * 64 + cc * 2; return st * 1024 + (ob ^ (((ob >> 9) & 1) << 5)); }
__host__ __device__ __forceinline__ void stage_rc(int b, int& R, int& C) { const int st = b / 1024, sb = b % 1024, swz = sb ^ (((sb >> 9) & 1) << 5); R = (st >> 1) * 16 + swz / 64; C = (st & 1) * 32 + (swz % 64) / 2; }
__host__ __device__ __forceinline__ int perm32(int rho) { const int n = rho >> 4, i = rho & 15; return 8 * (i >> 2) + 4 * n + (i & 3); }

struct Unit { int pm, pn, kofs, ks; };
struct Gemm { const bf16_t* A; const bf16_t* Bt; int M, N, K, lda, ldb; };

struct StaticOrder {
    int nM, nN, nwg, G, c;
    __host__ __device__ void init(int M, int N, int G_, int c_) { nM = M / BM; nN = N / BM; nwg = nM * nN; G = G_; c = c_; }
    __host__ __device__ bool next(int i, Unit& u) const {
        const long L = (long)i * G + c; if (L >= nwg) return false;
        int wgid = (int)L; { const int q = nwg / NXCD, r = nwg % NXCD, xcd = wgid % NXCD, off = wgid / NXCD; wgid = (xcd < r ? xcd * (q + 1) : r * (q + 1) + (xcd - r) * q) + off; }
        const int nig = WGM * nN, gid = wgid / nig, fm = gid * WGM, gsz = (nM - fm) < WGM ? (nM - fm) : WGM;
        u.pm = fm + ((wgid % nig) % gsz); u.pn = (wgid % nig) / gsz; u.kofs = 0; u.ks = 0; return true;
    }
    __device__ __forceinline__ void a_ready(const Unit&) const {}
    __device__ __forceinline__ void done(const Unit&) const {}
};

__device__ __forceinline__ unsigned cvt_pk_bf16(float lo, float hi) { unsigned r; asm volatile("v_cvt_pk_bf16_f32 %0, %1, %2" : "=v"(r) : "v"(lo), "v"(hi)); return r; }
typedef float f32x2 __attribute__((ext_vector_type(2)));
__device__ __forceinline__ f32x2 gelu_pk(f32x2 v) {
    const f32x2 av = __builtin_elementwise_abs(v), d = av * 0.2316418882f + 1.0f;
    f32x2 t; t.x = __builtin_amdgcn_rcpf(d.x); t.y = __builtin_amdgcn_rcpf(d.y);
    f32x2 q = t * 0.5307027145f + (-0.7265760135f); q = q * t + 0.7107068705f; q = q * t + (-0.142248368f); q = q * t + 0.127414796f; q = q * t;
    const f32x2 s = (v * v) * (-0.72134752044f);
    f32x2 e; e.x = __builtin_amdgcn_exp2f(s.x); e.y = __builtin_amdgcn_exp2f(s.y);
    const f32x2 m = v * (q * e), r = v - m;
    f32x2 o; o.x = v.x < 0.f ? m.x : r.x; o.y = v.y < 0.f ? m.y : r.y; return o;
}

template <int ACT  > struct EpiBf16 {
    static constexpr bool PERM = true, AFTER_DRAIN = false; static_assert(ACT == 0 || ACT == 1, "EpiBf16: ACT is 0 (none) or 1 (gelu_pk)");
    bf16_t* O; int ldc; const float* bias; int split_cols; size_t split_stride; float scale0;
    __device__ __forceinline__ void operator()(const f32x4 (&acc)[2][2][4][2], const Unit& u, int wr, int wc, int fr, int fq) const {
        const int row0 = u.pm * BM + wr * 64 + fr; int colt = u.pn * BM; bf16_t* base = O;
        float sc = 1.f; if (split_cols) { const int t = colt / split_cols; base += (size_t)t * split_stride; colt -= t * split_cols; if (t == 0) sc = scale0; }
        const int col0 = colt + wc * 32 + 8 * fq, bcol0 = u.pn * BM + wc * 32 + 8 * fq;
        f32x4 bv[2][2];
#pragma unroll
        for (int bj = 0; bj < 2; ++bj)
#pragma unroll
            for (int n = 0; n < 2; ++n) bv[bj][n] = bias ? *(const f32x4*)(bias + bcol0 + bj * HALF + 4 * n) : (f32x4){0.f, 0.f, 0.f, 0.f};
#pragma unroll
        for (int ai = 0; ai < 2; ++ai)
#pragma unroll
            for (int m = 0; m < 4; ++m) { bf16_t* rowp = base + (size_t)(row0 + ai * HALF + m * 16) * ldc + col0;
#pragma unroll
                for (int bj = 0; bj < 2; ++bj) { f32x4 v0 = acc[ai][bj][m][0] + bv[bj][0], v1 = acc[ai][bj][m][1] + bv[bj][1];
                    if (ACT == 1) { f32x2 a = gelu_pk((f32x2){v0[0], v0[1]}), b = gelu_pk((f32x2){v0[2], v0[3]}), c = gelu_pk((f32x2){v1[0], v1[1]}), d = gelu_pk((f32x2){v1[2], v1[3]});
                        v0 = (f32x4){a.x, a.y, b.x, b.y}; v1 = (f32x4){c.x, c.y, d.x, d.y}; }
                    v0 = v0 * sc; v1 = v1 * sc; u32x4 w; w.x = cvt_pk_bf16(v0[0], v0[1]); w.y = cvt_pk_bf16(v0[2], v0[3]); w.z = cvt_pk_bf16(v1[0], v1[1]); w.w = cvt_pk_bf16(v1[2], v1[3]);
                    *(u32x4*)(rowp + bj * HALF) = w; } }
    }
};


template <class Epi, class Sched, bool ALIGN_EPI = false, bool SP2 = false>
__device__ __forceinline__ void gemm_phase(PG8_LAS unsigned char* lds, const Gemm g, const Sched& S, const Epi& E) {
    int tid_l = threadIdx.x; asm volatile("" : "+v"(tid_l));
    const int tid = tid_l, wid = __builtin_amdgcn_readfirstlane(tid >> 6), lane = tid & 63, wr = wid >> 2, wc = wid & 3, fr = lane & 15, fq = lane >> 4;
    const int K = g.K, nt = K / BK;
    unsigned voffA[2], voffB[2];
#pragma unroll
    for (int i = 0; i < 2; ++i) { int R, C; stage_rc(tid * 16 + i * 8192, R, C); const int Rb = Epi::PERM ? ((R & ~31) + perm32(R & 31)) : R;
        voffA[i] = (unsigned)(R * g.lda + C) * 2u; voffB[i] = (unsigned)(Rb * g.ldb + C) * 2u; }
    const size_t kstep = (size_t)(BK * 2);
    const size_t hstepA = (size_t)HALF * g.lda * 2, hstepB = (size_t)HALF * g.ldb * 2;
    const size_t tstepA = 2 * hstepA, tstepB = 2 * hstepB;
    const unsigned ldsw = (unsigned)wid * 1024u;
    const int aoff = lds_byte(wr * 64 + fr, fq * 8), boff = lds_byte(wc * 32 + fr, fq * 8);
#define PG8_SA(b, h) (((b) * 2 + (h)) * HTB)
#define PG8_SB(b, h) ((4 + (b) * 2 + (h)) * HTB)
#define PG8_STAGE(bufoff, gbase, voff) do { _Pragma("unroll") for (int _i = 0; _i < 2; ++_i) \
        __builtin_amdgcn_global_load_lds((const unsigned*)((const char*)(gbase) + (voff)[_i]), (PG8_LAS unsigned*)(lds + (bufoff) + ldsw + _i * 8192), 16, 0, 0); } while (0)
#define PG8_LDA(dst, b, h) do { _Pragma("unroll") for (int m = 0; m < 4; ++m) _Pragma("unroll") for (int k = 0; k < 2; ++k) dst[m][k] = *(const PG8_LAS bf16x8*)(lds + PG8_SA(b, h) + aoff + m * 2048 + k * 1024); } while (0)
#define PG8_LDB(dst, b, h) do { _Pragma("unroll") for (int n = 0; n < 2; ++n) _Pragma("unroll") for (int k = 0; k < 2; ++k) dst[n][k] = *(const PG8_LAS bf16x8*)(lds + PG8_SB(b, h) + boff + n * 2048 + k * 1024); } while (0)
#define PG8_MMA(ai, bj, At, Bt) do { __builtin_amdgcn_s_setprio(1); _Pragma("unroll") for (int m = 0; m < 4; ++m) _Pragma("unroll") for (int n = 0; n < 2; ++n) _Pragma("unroll") for (int k = 0; k < 2; ++k) \
        acc[ai][bj][m][n] = __builtin_amdgcn_mfma_f32_16x16x32_bf16(Bt[n][k], At[m][k], acc[ai][bj][m][n], 0, 0, 0); __builtin_amdgcn_s_setprio(0); } while (0)
#define PG8_WAIT_V(n) asm volatile("s_waitcnt vmcnt(" #n ")" ::: "memory")
#define PG8_WAIT_L(n) asm volatile("s_waitcnt lgkmcnt(" #n ")" ::: "memory")
#define PG8_BAR __builtin_amdgcn_s_barrier()
#define PG8_SCHED __builtin_amdgcn_sched_barrier(0)
    Unit cur, nxt; int ui = 0;
    if (!S.next(0, cur)) return;
    f32x4 acc[2][2][4][2];
#pragma unroll
    for (int a = 0; a < 2; ++a)
#pragma unroll
        for (int b = 0; b < 2; ++b)
#pragma unroll
            for (int m = 0; m < 4; ++m)
#pragma unroll
                for (int n = 0; n < 2; ++n) acc[a][b][m][n] = (f32x4){0.f, 0.f, 0.f, 0.f};
    bf16x8 At[4][2], B0[2][2], B1[2][2];
    const char* cA = (const char*)g.A + (size_t)cur.pm * tstepA + cur.kofs; const char* cB = (const char*)g.Bt + (size_t)cur.pn * tstepB + cur.kofs;
    S.a_ready(cur);
    if constexpr (SP2) {
        PG8_STAGE(PG8_SB(0, 0), cB, voffB); PG8_STAGE(PG8_SB(0, 1), cB + hstepB, voffB); PG8_STAGE(PG8_SA(0, 0), cA, voffA); PG8_STAGE(PG8_SA(0, 1), cA + hstepA, voffA);
        if (wr == 1) PG8_BAR;
        PG8_WAIT_V(2); PG8_BAR;
        PG8_STAGE(PG8_SB(1, 0), cB + kstep, voffB); PG8_STAGE(PG8_SA(1, 0), cA + kstep, voffA); PG8_STAGE(PG8_SB(1, 1), cB + hstepB + kstep, voffB);
        PG8_WAIT_V(6); PG8_BAR;
    } else {
        PG8_STAGE(PG8_SB(0, 0), cB, voffB); PG8_STAGE(PG8_SA(0, 0), cA, voffA); PG8_STAGE(PG8_SB(0, 1), cB + hstepB, voffB); PG8_STAGE(PG8_SA(0, 1), cA + hstepA, voffA);
        if (wr == 1) PG8_BAR;
        PG8_WAIT_V(4); PG8_BAR;
        PG8_STAGE(PG8_SB(1, 0), cB + kstep, voffB); PG8_STAGE(PG8_SA(1, 0), cA + kstep, voffA); PG8_STAGE(PG8_SB(1, 1), cB + hstepB + kstep, voffB);
        PG8_WAIT_V(6); PG8_BAR;
    }
    for (;;) {
        const bool has_next = S.next(ui + 1, nxt);
        const char* nA = has_next ? (const char*)g.A + (size_t)nxt.pm * tstepA + nxt.kofs : cA; const char* nB = has_next ? (const char*)g.Bt + (size_t)nxt.pn * tstepB + nxt.kofs : cB;
        for (int t = 0; t < nt; t += 2) {
            const bool last = (t == nt - 2);
            const char* a1 = cA + (size_t)(t + 1) * kstep;
            const char* a2 = last ? nA : cA + (size_t)(t + 2) * kstep; const char* b2 = last ? nB : cB + (size_t)(t + 2) * kstep;
            const char* a3 = a2 + kstep; const char* b3 = b2 + kstep;
            if (last && has_next) S.a_ready(nxt);
            if constexpr (SP2) {
            PG8_LDB(B0, 0, 0); PG8_LDB(B1, 0, 1); PG8_SCHED; PG8_LDA(At, 0, 0); PG8_STAGE(PG8_SA(1, 1), a1 + hstepA, voffA);
            PG8_WAIT_V(8); PG8_WAIT_L(0); PG8_BAR; PG8_MMA(0, 0, At, B0); PG8_MMA(0, 1, At, B1); PG8_BAR; PG8_SCHED;
            PG8_LDA(At, 0, 1); PG8_STAGE(PG8_SB(0, 0), b2, voffB); PG8_STAGE(PG8_SB(0, 1), b2 + hstepB, voffB); PG8_STAGE(PG8_SA(0, 0), a2, voffA);
            PG8_WAIT_V(8); PG8_WAIT_L(0); PG8_BAR; PG8_MMA(1, 0, At, B0); PG8_MMA(1, 1, At, B1); PG8_BAR; PG8_SCHED;
            PG8_LDB(B0, 1, 0); PG8_LDB(B1, 1, 1); PG8_SCHED; PG8_LDA(At, 1, 0); PG8_STAGE(PG8_SA(0, 1), a2 + hstepA, voffA);
            PG8_WAIT_V(8); PG8_WAIT_L(0); PG8_BAR; PG8_MMA(0, 0, At, B0); PG8_MMA(0, 1, At, B1); PG8_BAR; PG8_SCHED;
            PG8_LDA(At, 1, 1); PG8_STAGE(PG8_SB(1, 0), b3, voffB); PG8_STAGE(PG8_SB(1, 1), b3 + hstepB, voffB); PG8_STAGE(PG8_SA(1, 0), a3, voffA);
            PG8_WAIT_V(8); PG8_WAIT_L(0); PG8_BAR; PG8_MMA(1, 0, At, B0); PG8_MMA(1, 1, At, B1); PG8_BAR; PG8_SCHED;
            } else {
            PG8_LDB(B0, 0, 0); PG8_SCHED; PG8_LDA(At, 0, 0); PG8_STAGE(PG8_SA(1, 1), a1 + hstepA, voffA);
            PG8_WAIT_L(8); PG8_BAR; PG8_WAIT_L(0); PG8_MMA(0, 0, At, B0); PG8_BAR; PG8_SCHED;
            PG8_LDB(B1, 0, 1); PG8_STAGE(PG8_SB(0, 0), b2, voffB);
            PG8_BAR; PG8_WAIT_L(0); PG8_MMA(0, 1, At, B1); PG8_BAR;
            PG8_LDA(At, 0, 1); PG8_STAGE(PG8_SA(0, 0), a2, voffA);
            PG8_BAR; PG8_WAIT_L(0); PG8_MMA(1, 0, At, B0); PG8_BAR; PG8_SCHED;
            PG8_STAGE(PG8_SB(0, 1), b2 + hstepB, voffB);
            PG8_WAIT_V(6); PG8_BAR; PG8_MMA(1, 1, At, B1); PG8_BAR;
            PG8_LDB(B0, 1, 0); PG8_SCHED; PG8_LDA(At, 1, 0); PG8_STAGE(PG8_SA(0, 1), a2 + hstepA, voffA);
            PG8_WAIT_L(8); PG8_BAR; PG8_WAIT_L(0); PG8_MMA(0, 0, At, B0); PG8_BAR; PG8_SCHED;
            PG8_LDB(B1, 1, 1); PG8_STAGE(PG8_SB(1, 0), b3, voffB);
            PG8_BAR; PG8_WAIT_L(0); PG8_MMA(0, 1, At, B1); PG8_BAR;
            PG8_LDA(At, 1, 1); PG8_STAGE(PG8_SA(1, 0), a3, voffA);
            PG8_BAR; PG8_WAIT_L(0); PG8_MMA(1, 0, At, B0); PG8_BAR; PG8_SCHED;
            PG8_STAGE(PG8_SB(1, 1), b3 + hstepB, voffB);
            PG8_WAIT_V(6); PG8_BAR; PG8_MMA(1, 1, At, B1); PG8_BAR;
            }
        }
        if constexpr (ALIGN_EPI) { if (wr == 0) PG8_BAR; }
        if constexpr (!Epi::AFTER_DRAIN) { E(acc, cur, wr, wc, fr, fq); S.done(cur); }
        if (!has_next) break;
#pragma unroll
        for (int a = 0; a < 2; ++a)
#pragma unroll
            for (int b = 0; b < 2; ++b)
#pragma unroll
                for (int m = 0; m < 4; ++m)
#pragma unroll
                    for (int n = 0; n < 2; ++n) acc[a][b][m][n] = (f32x4){0.f, 0.f, 0.f, 0.f};
        cur = nxt; cA = nA; cB = nB; ++ui;
        if constexpr (ALIGN_EPI) { if (wr == 1) PG8_BAR; }
    }
    PG8_WAIT_V(0);
    if constexpr (!ALIGN_EPI) { if (wr == 0) PG8_BAR; }
    PG8_BAR;
    if constexpr (Epi::AFTER_DRAIN) { E.fused(acc, cur, wr, wc, fr, fq, lds, wid, lane); S.done(cur); }
#undef PG8_SA
#undef PG8_SB
#undef PG8_STAGE
#undef PG8_LDA
#undef PG8_LDB
#undef PG8_MMA
#undef PG8_WAIT_V
#undef PG8_WAIT_L
#undef PG8_BAR
#undef PG8_SCHED
}
}

namespace at128 {
using bf16 = __hip_bfloat16;
constexpr int D = 128, NW = 8, QBLK = 32, KVBLK = 64, SDEPTH = 2;
constexpr float SCALE = 0.088388347648318440f, THR = 8.f;
constexpr size_t SHM_V = KVBLK * D * 2, SHM_K = KVBLK * D * 2, SHM_ATTN = 2 * SHM_V + 2 * SHM_K + NW * 64 * 4;
constexpr int DMA_SCRATCH_OFF = 131072 + 4096;
using bf16x8 = __attribute__((ext_vector_type(8))) short;
using s16x4  = __attribute__((ext_vector_type(4))) short;
using f32x16 = __attribute__((ext_vector_type(16))) float;
using f32x8  = __attribute__((ext_vector_type(8))) float;
using u32x4  = __attribute__((ext_vector_type(4))) unsigned;
#define KSWZ(row, colB) ((row) * 256 + ((colB) ^ (((row) & 7) << 4)))
#define SBAR() __builtin_amdgcn_sched_barrier(0)
__device__ __forceinline__ int crow(int r, int hi) { return (r & 3) + 8 * (r >> 2) + 4 * hi; }
__device__ __forceinline__ unsigned cvtpk(float lo, float hi) {
  unsigned r; asm volatile("v_cvt_pk_bf16_f32 %0, %1, %2" : "=v"(r) : "v"(lo), "v"(hi)); return r;
}
template <typename TIn> struct Stage;
template <> struct Stage<bf16>  { using T = bf16x8;
  __device__ static __forceinline__ T ld8(const bf16* p) { return *reinterpret_cast<const bf16x8*>(p); }
  __device__ static __forceinline__ bf16x8 tobf(T x) { return x; } };
template <> struct Stage<float> { using T = f32x8;
  __device__ static __forceinline__ T ld8(const float* p) { return *reinterpret_cast<const f32x8*>(p); }
  __device__ static __forceinline__ bf16x8 tobf(T x) {
    u32x4 w = {cvtpk(x[0], x[1]), cvtpk(x[2], x[3]), cvtpk(x[4], x[5]), cvtpk(x[6], x[7])}; return *reinterpret_cast<bf16x8*>(&w); } };

__device__ __forceinline__ void partialSM(f32x16& p0, f32x16& p1, float& m_reg, float& mn, float& alpha) {
  constexpr float C = SCALE * 1.4426950408889634f;
  float pmax = p0[0]; for (int r = 1; r < 16; ++r) pmax = fmaxf(pmax, p0[r]); for (int r = 0; r < 16; ++r) pmax = fmaxf(pmax, p1[r]);
  { auto rr = __builtin_amdgcn_permlane32_swap(__float_as_uint(pmax), __float_as_uint(pmax), false, false);
    pmax = fmaxf(__uint_as_float(rr[0]), __uint_as_float(rr[1])); }
  if (__builtin_expect(__all(pmax - m_reg <= THR / SCALE), 1)) { mn = m_reg; alpha = 1.f; }
  else { mn = fmaxf(m_reg, pmax); alpha = __builtin_amdgcn_exp2f((m_reg - mn) * C); m_reg = mn; }
  float mnC = -mn * C;
  for (int r = 0; r < 16; ++r) p0[r] = fmaf(p0[r], C, mnC); for (int r = 0; r < 16; ++r) p1[r] = fmaf(p1[r], C, mnC);
  for (int r = 0; r < 16; ++r) p0[r] = __builtin_amdgcn_exp2f(p0[r]);
}
__device__ __forceinline__ void finishSM(f32x16& p0, f32x16& p1, float alpha, float& l_reg, bf16x8& pa0, bf16x8& pa1, bf16x8& pa2, bf16x8& pa3) {
  for (int r = 0; r < 16; ++r) p1[r] = __builtin_amdgcn_exp2f(p1[r]);
  float ps = 0; for (int r = 0; r < 16; ++r) ps += p0[r]; for (int r = 0; r < 16; ++r) ps += p1[r];
  { auto rr = __builtin_amdgcn_permlane32_swap(__float_as_uint(ps), __float_as_uint(ps), false, false);
    ps = __uint_as_float(rr[0]) + __uint_as_float(rr[1]); }
  l_reg = l_reg * alpha + ps;
#define PK4(P, BASE, OUT) do { unsigned a0 = cvtpk(P[BASE + 0], P[BASE + 1]), a1 = cvtpk(P[BASE + 2], P[BASE + 3]);   \
    unsigned b0 = cvtpk(P[BASE + 4], P[BASE + 5]), b1 = cvtpk(P[BASE + 6], P[BASE + 7]);                              \
    auto r0 = __builtin_amdgcn_permlane32_swap(a0, b0, false, false); auto r1 = __builtin_amdgcn_permlane32_swap(a1, b1, false, false); \
    u32x4 w = {r0[0], r1[0], r0[1], r1[1]}; OUT = *reinterpret_cast<bf16x8*>(&w); } while (0)
  PK4(p0, 0, pa0); PK4(p0, 8, pa1); PK4(p1, 0, pa2); PK4(p1, 8, pa3);
#undef PK4
}
template <int ND> __device__ __forceinline__ void qkt(f32x16& p0, f32x16& p1, const bf16* Ks, const bf16x8* qr, int r32, int hi, int kcb) {
  p0 = f32x16{}; p1 = f32x16{};
  const char* Kb = (const char*)Ks + kcb;
#pragma unroll
  for (int d0 = 0; d0 < ND; ++d0) { int cb = (d0 * 16 + hi * 8) * 2;
    bf16x8 b0 = *reinterpret_cast<const bf16x8*>(Kb + KSWZ(r32, cb));
    bf16x8 b1 = *reinterpret_cast<const bf16x8*>(Kb + KSWZ(32 + r32, cb));
    p0 = __builtin_amdgcn_mfma_f32_32x32x16_bf16(b0, qr[d0], p0, 0, 0, 0);
    p1 = __builtin_amdgcn_mfma_f32_32x32x16_bf16(b1, qr[d0], p1, 0, 0, 0); }
}
__device__ __forceinline__ int v_st(int k, int c) { const int kk = (k & ~0xC) | ((k & 4) << 1) | ((k & 8) >> 1); return ((kk >> 3) * 4 + (c >> 5)) * 512 + ((kk & 7) * 32 + (c & 31)) * 2; }
__device__ __forceinline__ int v_rd_base(int lane) { return ((lane & 3) << 3) | (((lane >> 2) & 3) << 6) | (((lane >> 4) & 1) << 5) | (((lane >> 5) & 1) << 8); }
constexpr int v_rd_off(int d0, int ks, int half) { return d0 * 512 + ks * 4096 + half * 2048; }
template <int OFF> __device__ __forceinline__ s16x4 tr_read(int vb) {
  s16x4 r; asm volatile("ds_read_b64_tr_b16 %0, %1 offset:%2" : "=&v"(r) : "v"(vb), "i"(OFF) : "memory"); return r;
}
template <int D0> __device__ __forceinline__ void pv_one(f32x16& od, int vb, bf16x8 pa0, bf16x8 pa1, bf16x8 pa2, bf16x8 pa3) {
  const s16x4 l0 = tr_read<v_rd_off(D0, 0, 0)>(vb), h0 = tr_read<v_rd_off(D0, 0, 1)>(vb), l1 = tr_read<v_rd_off(D0, 1, 0)>(vb), h1 = tr_read<v_rd_off(D0, 1, 1)>(vb);
  const s16x4 l2 = tr_read<v_rd_off(D0, 2, 0)>(vb), h2 = tr_read<v_rd_off(D0, 2, 1)>(vb), l3 = tr_read<v_rd_off(D0, 3, 0)>(vb), h3 = tr_read<v_rd_off(D0, 3, 1)>(vb);
  asm volatile("s_waitcnt lgkmcnt(0)" ::: "memory"); SBAR();
#define PK(L, H) (bf16x8){L[0], L[1], L[2], L[3], H[0], H[1], H[2], H[3]}
  od = __builtin_amdgcn_mfma_f32_32x32x16_bf16(pa0, PK(l0, h0), od, 0, 0, 0);
  od = __builtin_amdgcn_mfma_f32_32x32x16_bf16(pa1, PK(l1, h1), od, 0, 0, 0);
  od = __builtin_amdgcn_mfma_f32_32x32x16_bf16(pa2, PK(l2, h2), od, 0, 0, 0);
  od = __builtin_amdgcn_mfma_f32_32x32x16_bf16(pa3, PK(l3, h3), od, 0, 0, 0);
#undef PK
}
template <int KS> __device__ __forceinline__ void pv_ks(f32x16* o, int vb, bf16x8 pa) {
  const s16x4 l0 = tr_read<v_rd_off(0, KS, 0)>(vb), h0 = tr_read<v_rd_off(0, KS, 1)>(vb), l1 = tr_read<v_rd_off(1, KS, 0)>(vb), h1 = tr_read<v_rd_off(1, KS, 1)>(vb);
  const s16x4 l2 = tr_read<v_rd_off(2, KS, 0)>(vb), h2 = tr_read<v_rd_off(2, KS, 1)>(vb), l3 = tr_read<v_rd_off(3, KS, 0)>(vb), h3 = tr_read<v_rd_off(3, KS, 1)>(vb);
  asm volatile("s_waitcnt lgkmcnt(0)" ::: "memory"); SBAR();
#define PK(L, H) (bf16x8){L[0], L[1], L[2], L[3], H[0], H[1], H[2], H[3]}
  o[0] = __builtin_amdgcn_mfma_f32_32x32x16_bf16(pa, PK(l0, h0), o[0], 0, 0, 0);
  o[1] = __builtin_amdgcn_mfma_f32_32x32x16_bf16(pa, PK(l1, h1), o[1], 0, 0, 0);
  o[2] = __builtin_amdgcn_mfma_f32_32x32x16_bf16(pa, PK(l2, h2), o[2], 0, 0, 0);
  o[3] = __builtin_amdgcn_mfma_f32_32x32x16_bf16(pa, PK(l3, h3), o[3], 0, 0, 0);
#undef PK
}
__device__ __forceinline__ void pv_d0(f32x16* o, int vb, bf16x8 pa0, bf16x8 pa1, bf16x8 pa2, bf16x8 pa3) {
  pv_ks<0>(o, vb, pa0); pv_ks<1>(o, vb, pa1); pv_ks<2>(o, vb, pa2); pv_ks<3>(o, vb, pa3);
}
template <int ND, int LDQ, int LDK, int LDV, int LDOF, int LDOB>
__device__ __forceinline__ void attn_dense_body(const bf16* __restrict__ Qb, const bf16* __restrict__ Kh, const bf16* __restrict__ Vh,
                                                float* __restrict__ Of, bf16* __restrict__ Ob16, int seq, char* lds, int kcb,
                                                const float* __restrict__ qgain, const float* __restrict__ rope, int tpos0) {
  using TQ = bf16; using St = Stage<bf16>; using SQ = Stage<TQ>;
  int tid_l = threadIdx.x; asm volatile("" : "+v"(tid_l));
  const int tid = tid_l, wid = tid >> 6, lane = tid & 63, r32 = lane & 31, hi = lane >> 5;
  bf16* V_lds = (bf16*)lds; bf16* K_lds = (bf16*)(lds + 2 * SHM_V);
  float* ws = (float*)(lds + 2 * SHM_V + 2 * SHM_K) + wid * 64; float* li_l = ws; float* al_l = ws + 32;
  float m_reg = -1e30f, l_reg = 0; f32x16 o[4] = {}; bf16x8 qr[ND];
  const TQ* Qw = Qb + (long)(wid * QBLK + r32) * LDQ + hi * 8;
  {
    float f[ND][8];
#pragma unroll
    for (int d0 = 0; d0 < ND; ++d0) { const u32x4 w = *reinterpret_cast<const u32x4*>(Qw + d0 * 16);
      f[d0][0] = __uint_as_float(w[0] << 16); f[d0][1] = __uint_as_float(w[0] & 0xffff0000u); f[d0][2] = __uint_as_float(w[1] << 16); f[d0][3] = __uint_as_float(w[1] & 0xffff0000u);
      f[d0][4] = __uint_as_float(w[2] << 16); f[d0][5] = __uint_as_float(w[2] & 0xffff0000u); f[d0][6] = __uint_as_float(w[3] << 16); f[d0][7] = __uint_as_float(w[3] & 0xffff0000u); }
    if constexpr (ND == 8) {
      float ss = 0.f;
#pragma unroll
      for (int d0 = 0; d0 < ND; ++d0)
#pragma unroll
        for (int e = 0; e < 8; ++e) ss += f[d0][e] * f[d0][e];
      ss += __shfl_xor(ss, 32);
      const float rstd = 1.f / sqrtf(ss * (1.f / 128.f) + 1e-6f);
#pragma unroll
      for (int d0 = 0; d0 < ND; ++d0) { const float* gp = qgain + d0 * 16 + hi * 8;
#pragma unroll
        for (int e = 0; e < 8; ++e) f[d0][e] = f[d0][e] * rstd * gp[e]; }
    }
    if (tpos0 >= 0) { const int t = tpos0 + wid * QBLK + r32; constexpr int Q4 = ND / 4, TOFF = ND == 8 ? 16 : 0;
#pragma unroll
      for (int hf = 0; hf < 2; ++hf) { const float* tb = rope + (size_t)((hf == 0 ? (t >> 6) : (t & 63)) * 48 + TOFF + hi * 8) * 2;
#pragma unroll
        for (int q = 0; q < Q4; ++q)
#pragma unroll
          for (int e = 0; e < 8; ++e) { const float cs = tb[(q * 16 + e) * 2], sn = tb[(q * 16 + e) * 2 + 1]; const int da = hf * 2 * Q4 + q, db = da + Q4;
            const float x1 = f[da][e], x2 = f[db][e]; f[da][e] = x1 * cs - x2 * sn; f[db][e] = x1 * sn + x2 * cs; } }
    }
    constexpr float QS = ND == 8 ? 1.f : 1.4142135623730951f;
#pragma unroll
    for (int d0 = 0; d0 < ND; ++d0) { u32x4 w = {cvtpk(f[d0][0] * QS, f[d0][1] * QS), cvtpk(f[d0][2] * QS, f[d0][3] * QS), cvtpk(f[d0][4] * QS, f[d0][5] * QS), cvtpk(f[d0][6] * QS, f[d0][7] * QS)};
      qr[d0] = *reinterpret_cast<bf16x8*>(&w); }
  }
  const int sr = tid >> 4, sc = (tid & 15) * 8, vst0 = v_st(sr, sc), vst1 = v_st(32 + sr, sc);
  const int vb0 = (int)(uintptr_t)V_lds + v_rd_base(lane);
  struct { typename St::T vs0, vs1, ks0, ks1; } sr_[SDEPTH];
#define SLOAD(i, k0) do { sr_[i].vs0 = St::ld8(&Vh[(long)((k0) + sr) * LDV + sc]); sr_[i].vs1 = St::ld8(&Vh[(long)((k0) + 32 + sr) * LDV + sc]); \
    sr_[i].ks0 = St::ld8(&Kh[(long)((k0) + sr) * LDK + sc]); sr_[i].ks1 = St::ld8(&Kh[(long)((k0) + 32 + sr) * LDK + sc]); } while (0)
#define SWRITE(b, i) do { *(bf16x8*)((char*)V_lds + (b) * SHM_V + vst0) = St::tobf(sr_[i].vs0);          \
    *(bf16x8*)((char*)V_lds + (b) * SHM_V + vst1) = St::tobf(sr_[i].vs1); int kc = sc * 2;               \
    *(bf16x8*)((char*)K_lds + (b) * SHM_K + KSWZ(sr, kc)) = St::tobf(sr_[i].ks0);                       \
    *(bf16x8*)((char*)K_lds + (b) * SHM_K + KSWZ(32 + sr, kc)) = St::tobf(sr_[i].ks1); } while (0)
#define SWAIT() do { if constexpr (SDEPTH == 2) asm volatile("s_waitcnt vmcnt(4)" ::: "memory"); else asm volatile("s_waitcnt vmcnt(0)" ::: "memory"); } while (0)
#define RESC(a) do { if (__any((a) < 1.f)) { if (hi == 0) al_l[r32] = (a); asm volatile("s_waitcnt lgkmcnt(0)" ::: "memory"); \
    for (int d = 0; d < 4; ++d) for (int r = 0; r < 16; ++r) o[d][r] *= al_l[crow(r, hi)]; } } while (0)
  f32x16 pA0, pA1, pB0, pB1; float mnA, mnB, alA, alB; bf16x8 pa0, pa1, pa2, pa3; const int NT = seq / KVBLK;
  constexpr int SE = 0, SO = SDEPTH - 1;
  SLOAD(SE, 0); asm volatile("s_waitcnt vmcnt(0)" ::: "memory"); SWRITE(0, SE); __syncthreads();
  qkt<ND>(pA0, pA1, K_lds, qr, r32, hi, kcb); partialSM(pA0, pA1, m_reg, mnA, alA);
  SLOAD(SO, KVBLK); if constexpr (SDEPTH == 2) { if (2 < NT) SLOAD(SE, 2 * KVBLK); }
  SWAIT(); SWRITE(1, SO); __syncthreads();
  for (int j = 1; j + 1 < NT; j += 2) {
    SBAR(); qkt<ND>(pB0, pB1, (bf16*)((char*)K_lds + SHM_K), qr, r32, hi, kcb);
    finishSM(pA0, pA1, alA, l_reg, pa0, pa1, pa2, pa3); SBAR();
    SLOAD(SO, (j + SDEPTH) * KVBLK); SBAR();
    pv_d0(o, vb0, pa0, pa1, pa2, pa3); partialSM(pB0, pB1, m_reg, mnB, alB);
    __syncthreads(); SWAIT(); SWRITE(0, SE);
    RESC(alB); __syncthreads();
    SBAR(); qkt<ND>(pA0, pA1, K_lds, qr, r32, hi, kcb);
    finishSM(pB0, pB1, alB, l_reg, pa0, pa1, pa2, pa3); SBAR();
    if (SDEPTH == 1 || j + 3 < NT) SLOAD(SE, (j + 1 + SDEPTH) * KVBLK); SBAR();
    pv_d0(o, vb0 + (int)SHM_V, pa0, pa1, pa2, pa3); partialSM(pA0, pA1, m_reg, mnA, alA);
    __syncthreads(); SWAIT(); SWRITE(1, SO);
    RESC(alA); __syncthreads();
  }
  SBAR(); qkt<ND>(pB0, pB1, (bf16*)((char*)K_lds + SHM_K), qr, r32, hi, kcb);
  finishSM(pA0, pA1, alA, l_reg, pa0, pa1, pa2, pa3); SBAR();
  pv_d0(o, vb0, pa0, pa1, pa2, pa3); partialSM(pB0, pB1, m_reg, mnB, alB);
  __syncthreads(); RESC(alB);
  finishSM(pB0, pB1, alB, l_reg, pa0, pa1, pa2, pa3); SBAR();
  pv_d0(o, vb0 + (int)SHM_V, pa0, pa1, pa2, pa3);
  if (hi == 0) li_l[r32] = l_reg; asm volatile("s_waitcnt lgkmcnt(0)" ::: "memory");
  float rli[16];
#pragma unroll
  for (int r = 0; r < 16; ++r) rli[r] = __builtin_amdgcn_rcpf(li_l[crow(r, hi)]);
  if (Of) { float* Ow = Of + (long)(wid * QBLK) * LDOF;
#pragma unroll
    for (int r = 0; r < 16; ++r) { int orow = crow(r, hi);
#pragma unroll
      for (int d0 = 0; d0 < 4; ++d0) Ow[(long)orow * LDOF + d0 * 32 + r32] = o[d0][r] * rli[r]; }
  } else { unsigned short* Ow = (unsigned short*)Ob16 + (long)(wid * QBLK) * LDOB;
#pragma unroll
    for (int r = 0; r < 16; ++r) { int orow = crow(r, hi);
#pragma unroll
      for (int d0 = 0; d0 < 4; ++d0) Ow[(long)orow * LDOB + d0 * 32 + r32] = (unsigned short)(cvtpk(o[d0][r] * rli[r], 0.f) & 0xffffu); }
  }
#undef SLOAD
#undef SWRITE
#undef SWAIT
#undef RESC
}

template <int ND, int LDQ, int LDK, int LDV, int LDOF, int LDOB>
__device__ __forceinline__ void attn_dma_body(const bf16* __restrict__ Qb, const bf16* __restrict__ Kh, const bf16* __restrict__ Vh,
                                                float* __restrict__ Of, bf16* __restrict__ Ob16, int seq, char* lds, int kcb,
                                                const float* __restrict__ qgain, const float* __restrict__ rope, int tpos0) {
  using TQ = bf16; using St = Stage<bf16>; using SQ = Stage<TQ>;
  int tid_l = threadIdx.x; asm volatile("" : "+v"(tid_l));
  const int tid = tid_l, wid = __builtin_amdgcn_readfirstlane(tid >> 6), lane = tid & 63, r32 = lane & 31, hi = lane >> 5;
  bf16* V_lds = (bf16*)lds; bf16* K_lds = (bf16*)(lds + 4 * SHM_V);
  float* ws = (float*)(lds + DMA_SCRATCH_OFF) + wid * 64; float* li_l = ws; float* al_l = ws + 32;
  float m_reg = -1e30f, l_reg = 0; f32x16 o[4] = {}; bf16x8 qr[ND];
  const TQ* Qw = Qb + (long)(wid * QBLK + r32) * LDQ + hi * 8;
  const int vb0 = (int)(uintptr_t)V_lds + v_rd_base(lane);
  unsigned koff[2], voff[2];
#pragma unroll
  for (int i = 0; i < 2; ++i) { const int g = (wid * 2 + i) * 64 + lane;
    { const int row = g >> 4, cg = g & 15; koff[i] = (unsigned)(row * LDK * 2 + ((cg ^ (row & 7)) << 4)); }
    { const int st = g >> 5, w = g & 31, kk = (st >> 2) * 8 + (w >> 2), c = (st & 3) * 32 + (w & 3) * 8, k = (kk & ~0xC) | ((kk & 4) << 1) | ((kk & 8) >> 1); voff[i] = (unsigned)(k * LDV * 2 + c * 2); } }
  const unsigned ldsV = (unsigned)(uintptr_t)V_lds + (unsigned)wid * 2048u, ldsK = (unsigned)(uintptr_t)K_lds + (unsigned)wid * 2048u;
#define DMA16(gsrc, ldsdst) do { unsigned keep_; asm volatile("s_mov_b32 %0, m0\n\ts_mov_b32 m0, %2\n\ts_nop 0\n\tglobal_load_lds_dwordx4 %1, off\n\ts_mov_b32 m0, %0" : "=&s"(keep_) : "v"(gsrc), "s"(ldsdst) : "memory"); } while (0)
#define ISSUE(t) do { const char* kt_ = (const char*)Kh + (size_t)(t) * (KVBLK * LDK * 2); const char* vt_ = (const char*)Vh + (size_t)(t) * (KVBLK * LDV * 2); const unsigned so_ = (unsigned)((t) & 3) * (unsigned)SHM_K; \
    DMA16(kt_ + koff[0], __builtin_amdgcn_readfirstlane(ldsK + so_)); DMA16(kt_ + koff[1], __builtin_amdgcn_readfirstlane(ldsK + so_ + 1024u)); \
    DMA16(vt_ + voff[0], __builtin_amdgcn_readfirstlane(ldsV + so_)); DMA16(vt_ + voff[1], __builtin_amdgcn_readfirstlane(ldsV + so_ + 1024u)); } while (0)
  ISSUE(0); ISSUE(1);
  {
    float f[ND][8];
#pragma unroll
    for (int d0 = 0; d0 < ND; ++d0) { const u32x4 w = *reinterpret_cast<const u32x4*>(Qw + d0 * 16);
      f[d0][0] = __uint_as_float(w[0] << 16); f[d0][1] = __uint_as_float(w[0] & 0xffff0000u); f[d0][2] = __uint_as_float(w[1] << 16); f[d0][3] = __uint_as_float(w[1] & 0xffff0000u);
      f[d0][4] = __uint_as_float(w[2] << 16); f[d0][5] = __uint_as_float(w[2] & 0xffff0000u); f[d0][6] = __uint_as_float(w[3] << 16); f[d0][7] = __uint_as_float(w[3] & 0xffff0000u); }
    if constexpr (ND == 8) {
      float ss = 0.f;
#pragma unroll
      for (int d0 = 0; d0 < ND; ++d0)
#pragma unroll
        for (int e = 0; e < 8; ++e) ss += f[d0][e] * f[d0][e];
      ss += __shfl_xor(ss, 32);
      const float rstd = 1.f / sqrtf(ss * (1.f / 128.f) + 1e-6f);
#pragma unroll
      for (int d0 = 0; d0 < ND; ++d0) { const float* gp = qgain + d0 * 16 + hi * 8;
#pragma unroll
        for (int e = 0; e < 8; ++e) f[d0][e] = f[d0][e] * rstd * gp[e]; }
    }
    if (tpos0 >= 0) { const int t = tpos0 + wid * QBLK + r32; constexpr int Q4 = ND / 4, TOFF = ND == 8 ? 16 : 0;
#pragma unroll
      for (int hf = 0; hf < 2; ++hf) { const float* tb = rope + (size_t)((hf == 0 ? (t >> 6) : (t & 63)) * 48 + TOFF + hi * 8) * 2;
#pragma unroll
        for (int q = 0; q < Q4; ++q)
#pragma unroll
          for (int e = 0; e < 8; ++e) { const float cs = tb[(q * 16 + e) * 2], sn = tb[(q * 16 + e) * 2 + 1]; const int da = hf * 2 * Q4 + q, db = da + Q4;
            const float x1 = f[da][e], x2 = f[db][e]; f[da][e] = x1 * cs - x2 * sn; f[db][e] = x1 * sn + x2 * cs; } }
    }
    constexpr float QS = ND == 8 ? 1.f : 1.4142135623730951f;
#pragma unroll
    for (int d0 = 0; d0 < ND; ++d0) { u32x4 w = {cvtpk(f[d0][0] * QS, f[d0][1] * QS), cvtpk(f[d0][2] * QS, f[d0][3] * QS), cvtpk(f[d0][4] * QS, f[d0][5] * QS), cvtpk(f[d0][6] * QS, f[d0][7] * QS)};
      qr[d0] = *reinterpret_cast<bf16x8*>(&w); }
  }
#define WAIT_BAR(N) asm volatile("s_waitcnt vmcnt(" #N ") lgkmcnt(0)\n\ts_barrier" ::: "memory")
#define RESC(a) do { if (__any((a) < 1.f)) { if (hi == 0) al_l[r32] = (a); asm volatile("s_waitcnt lgkmcnt(0)" ::: "memory"); \
    for (int d = 0; d < 4; ++d) for (int r = 0; r < 16; ++r) o[d][r] *= al_l[crow(r, hi)]; } } while (0)
  f32x16 pA0, pA1, pB0, pB1; float mnA, mnB, alA, alB; bf16x8 pa0, pa1, pa2, pa3; const int NT = seq / KVBLK;
#define STEP(PC0, PC1, mnC, alC, PP0, PP1, alP, t) do { if ((t) + 1 < NT) WAIT_BAR(4); else WAIT_BAR(0); \
    if ((t) + 2 < NT) ISSUE((t) + 2); \
    SBAR(); qkt<ND>(PC0, PC1, (bf16*)((char*)K_lds + ((t) & 3) * SHM_K), qr, r32, hi, kcb); \
    finishSM(PP0, PP1, alP, l_reg, pa0, pa1, pa2, pa3); SBAR(); \
    pv_d0(o, vb0 + (((t) - 1) & 3) * (int)SHM_V, pa0, pa1, pa2, pa3); partialSM(PC0, PC1, m_reg, mnC, alC); \
    RESC(alC); } while (0)
  WAIT_BAR(4);
  if (2 < NT) ISSUE(2);
  qkt<ND>(pA0, pA1, K_lds, qr, r32, hi, kcb); partialSM(pA0, pA1, m_reg, mnA, alA);
  for (int t0 = 0; t0 < NT; t0 += 4) {
    STEP(pB0, pB1, mnB, alB, pA0, pA1, alA, t0 + 1);
    STEP(pA0, pA1, mnA, alA, pB0, pB1, alB, t0 + 2);
    STEP(pB0, pB1, mnB, alB, pA0, pA1, alA, t0 + 3);
    if (t0 + 4 < NT) STEP(pA0, pA1, mnA, alA, pB0, pB1, alB, t0 + 4);
  }
  finishSM(pB0, pB1, alB, l_reg, pa0, pa1, pa2, pa3); SBAR();
  pv_d0(o, vb0 + 3 * (int)SHM_V, pa0, pa1, pa2, pa3);
  if (hi == 0) li_l[r32] = l_reg; asm volatile("s_waitcnt lgkmcnt(0)" ::: "memory");
  float rli[16];
#pragma unroll
  for (int r = 0; r < 16; ++r) rli[r] = __builtin_amdgcn_rcpf(li_l[crow(r, hi)]);
  if (Of) { float* Ow = Of + (long)(wid * QBLK) * LDOF;
#pragma unroll
    for (int r = 0; r < 16; ++r) { int orow = crow(r, hi);
#pragma unroll
      for (int d0 = 0; d0 < 4; ++d0) Ow[(long)orow * LDOF + d0 * 32 + r32] = o[d0][r] * rli[r]; }
  } else { unsigned short* Ow = (unsigned short*)Ob16 + (long)(wid * QBLK) * LDOB;
#pragma unroll
    for (int r = 0; r < 16; ++r) { int orow = crow(r, hi);
#pragma unroll
      for (int d0 = 0; d0 < 4; ++d0) Ow[(long)orow * LDOB + d0 * 32 + r32] = (unsigned short)(cvtpk(o[d0][r] * rli[r], 0.f) & 0xffffu); }
  }
#undef DMA16
#undef ISSUE
#undef WAIT_BAR
#undef STEP
#undef RESC
}

}
#define GAS __attribute__((address_space(1)))
#define LAS __attribute__((address_space(3)))
typedef unsigned short bf16_t;
typedef unsigned u32x4v __attribute__((ext_vector_type(4)));
typedef unsigned v4u __attribute__((ext_vector_type(4)));
typedef float f32x4 __attribute__((ext_vector_type(4)));
typedef short bf16x8 __attribute__((ext_vector_type(8)));
typedef GAS unsigned gu32;
typedef GAS unsigned long long gu64;
#define RLX_AGENT __ATOMIC_RELAXED, __HIP_MEMORY_SCOPE_AGENT
#define LDS_WAIT() asm volatile("s_waitcnt lgkmcnt(0)" ::: "memory")
#define VM_WAIT() asm volatile("s_waitcnt vmcnt(0)" ::: "memory")
__device__ __forceinline__ unsigned long long rt() { return __builtin_amdgcn_s_memrealtime(); }
__device__ __forceinline__ unsigned f2bf(float f) { unsigned u = __builtin_bit_cast(unsigned, f); return (u + 0x7fffu + ((u >> 16) & 1u)) >> 16; }
__device__ __forceinline__ unsigned pk2(float lo, float hi) { return f2bf(lo) | (f2bf(hi) << 16); }
#define XB_TMO      128
#define XB_XCNT(j)  (256  + 64 * (j))
#define XB_XSUB(j)  (1280 + 64 * (j))
#define XB_XGEN(j)  (2304 + 64 * (j))
#define XB_TOP      3328
#define XB_TOPGEN   3392
#define XCD_BAR_WORDS 3456
#define XB_SPIN_CAP (1u << 18)

__device__ __forceinline__ unsigned xb_ld(unsigned* p)              { return __hip_atomic_load(p, __ATOMIC_RELAXED, __HIP_MEMORY_SCOPE_AGENT); }
__device__ __forceinline__ unsigned xb_add(unsigned* p, unsigned v) { return __hip_atomic_fetch_add(p, v, __ATOMIC_RELAXED, __HIP_MEMORY_SCOPE_AGENT); }
__device__ __forceinline__ unsigned xb_xcc_id() { return (unsigned)__builtin_amdgcn_s_getreg((3 << 11) | 20) & 0xFu; }
#define XB_SPIN(cond, bar) do { unsigned _sp = 0; while (cond) { __builtin_amdgcn_s_sleep(1); \
    if ((++_sp & 255u) == 0u) { if (xb_ld(&(bar)[XB_TMO])) break; if (_sp > XB_SPIN_CAP) { atomicAdd(&(bar)[XB_TMO], 1u); break; } } } } while (0)

struct XcdBarrier {
    unsigned* bar; unsigned x;
    volatile LAS unsigned* st;
};

__device__ __forceinline__ XcdBarrier xcd_barrier_post(unsigned* bar, volatile LAS unsigned* st) {
    XcdBarrier b; b.bar = bar; b.x = xb_xcc_id(); b.st = st;
    if (threadIdx.x == 0) (void)xb_add(&bar[XB_XCNT(b.x)], 1u);
    return b;
}
__device__ __forceinline__ void xcd_barrier_complete(unsigned* bar, unsigned x, unsigned& nloc, unsigned& nx) {
    const unsigned G = gridDim.x * gridDim.y * gridDim.z;
    unsigned sum, cnt, mine, sp = 0u;
    for (;;) {
        sum = 0u; cnt = 0u; mine = 0u;
#pragma unroll
        for (unsigned j = 0; j < 16; ++j) { const unsigned c = xb_ld(&bar[XB_XCNT(j)]); sum += c; cnt += (c > 0u) ? 1u : 0u; mine = (j == x) ? c : mine; }
        if (sum == G) break;
        __builtin_amdgcn_s_sleep(1);
        if ((++sp & 255u) == 0u) { if (xb_ld(&bar[XB_TMO])) break; if (sp > XB_SPIN_CAP) { atomicAdd(&bar[XB_TMO], 1u); break; } }
    }
    nloc = mine > 0u ? mine : 1u; nx = cnt > 0u ? cnt : 1u;
}

__device__ __forceinline__ void xcd_barrier(const XcdBarrier& b) {
    asm volatile("s_waitcnt vmcnt(0)" ::: "memory");
    __syncthreads();
    if (threadIdx.x == 0) {
        unsigned* bar = b.bar;
        __builtin_amdgcn_s_waitcnt(0);
        unsigned nloc = b.st[0], nx = b.st[1];
        if (nloc == 0u) { xcd_barrier_complete(bar, b.x, nloc, nx); b.st[0] = nloc; b.st[1] = nx; }
        const unsigned old = xb_add(&bar[XB_XSUB(b.x)], 1u);
        const unsigned gen = old / nloc;
        if (old + 1u == (gen + 1u) * nloc) {
            __builtin_amdgcn_fence(__ATOMIC_RELEASE, "agent");
            asm volatile("s_waitcnt vmcnt(0)" ::: "memory");
            const unsigned og = xb_add(&bar[XB_TOP], 1u);
            const unsigned tg = og / nx;
            if (og + 1u == (tg + 1u) * nx) xb_add(&bar[XB_TOPGEN], 1u);
            else XB_SPIN(xb_ld(&bar[XB_TOPGEN]) == tg, bar);
            __builtin_amdgcn_fence(__ATOMIC_ACQUIRE, "agent");
            xb_add(&bar[XB_XGEN(b.x)], 1u);
            asm volatile("s_waitcnt vmcnt(0)" ::: "memory");
        } else {
            XB_SPIN(xb_ld(&bar[XB_XGEN(b.x)]) == gen, bar);
            __builtin_amdgcn_fence(__ATOMIC_ACQUIRE, "agent");
            asm volatile("s_waitcnt vmcnt(0)" ::: "memory");
        }
    }
    __syncthreads();
}


constexpr int DM = 2048, NB = 4, SEQL = 4096, CTXL = 256, SPB = 4352, R = NB * SPB, FF = 5632, INC = 3584, NMOD = 9, MODW = NMOD * DM;
constexpr int S5G = 32, S5P = 64, S5H = 16, TCH = 32;
constexpr int NCH = SPB / TCH, NCC = CTXL / TCH, RCV = NB * NCH, RCT = (RCV + 255) / 256, RCP = RCT * 256;
constexpr int KU = TCH * S5H, KS5 = KU + 256, NT5 = KU / 256, NLAG = 2 * TCH - 1;
static_assert(NCH % 17 == 0 && KU % 256 == 0, "S5 chunk geometry");
constexpr float EPS = 1e-6f;
constexpr int NWAVES = 8;
constexpr size_t MiB = 1u << 20;
constexpr size_t WS_CTL = 0, CTL_ZERO_BYTES = 1 * MiB;
constexpr size_t WS_MODV = 1 * MiB;
constexpr size_t WS_APOW = 2 * MiB;
constexpr size_t WS_BBAR = 7 * MiB;
constexpr size_t WS_ROPE = 6 * MiB + 512 * 1024;
constexpr size_t WS_KTAB = 8 * MiB;
constexpr size_t WS_WGU = 16 * MiB;
constexpr size_t WS_WD = 192 * MiB;
constexpr size_t WS_WIN = 280 * MiB;
constexpr size_t WS_WOUT = 308 * MiB;
constexpr size_t WS_GLU = 324 * MiB;
constexpr size_t WS_TZE = 326 * MiB;
constexpr size_t WS_SM = 486 * MiB;
constexpr size_t WS_XS = 518 * MiB;
constexpr size_t WS_H = 654 * MiB;
constexpr size_t WS_HACT = 722 * MiB;
constexpr size_t WS_P = 722 * MiB;
constexpr size_t WS_KA = 841 * MiB;
constexpr size_t WS_OD = 867 * MiB;
constexpr size_t WS_VA = 901 * MiB;
constexpr size_t WS_MIX = 935 * MiB;
constexpr size_t WS_UG = 1003 * MiB;
constexpr size_t WS_SST = 1043 * MiB;
constexpr size_t WS_YG = 1067 * MiB;
constexpr size_t WS_PART = 1084 * MiB;
constexpr size_t WS_END = 1116 * MiB;
static_assert((size_t)S5G * RCP * 256 * 4 <= 24 * MiB && (size_t)S5G * RCP * KS5 * 2 <= 40 * MiB && (size_t)2 * S5G * KU * KS5 * 2 <= 160 * MiB, "S5 buffers");
constexpr int CW_BAR = 4096;
constexpr int RING_BYTES = 131072, LDSCTL_OFF = RING_BYTES, MISC_OFF = LDSCTL_OFF + 320, PTR_OFF = MISC_OFF + 128, LDS_BYTES = 147456;
constexpr int NPH = 28;
#ifndef MK_N_LAUNCHES
#define MK_N_LAUNCHES 1
#endif
#ifndef PROBE_MASK
#define PROBE_MASK 0u
#endif
#define PROBE_REPS(ph) ((((unsigned)PROBE_MASK >> (ph)) & 1u) ? 2 : 1)

typedef float f32x2v __attribute__((ext_vector_type(2)));
__device__ __forceinline__ float wave_sum(float v) {
#pragma unroll
    for (int o = 1; o < 64; o <<= 1) v += __shfl_xor(v, o);
    return v;
}
__device__ __forceinline__ float bflo(unsigned w) { return __uint_as_float(w << 16); }
__device__ __forceinline__ float bfhi(unsigned w) { return __uint_as_float(w & 0xffff0000u); }
__device__ __forceinline__ unsigned cvtpk2(float lo, float hi) { unsigned r; asm volatile("v_cvt_pk_bf16_f32 %0, %1, %2" : "=v"(r) : "v"(lo), "v"(hi)); return r; }
__device__ __forceinline__ float sigmoidf_fast(float z) { return __builtin_amdgcn_rcpf(1.f + __builtin_amdgcn_exp2f(-1.4426950408889634f * z)); }

namespace pg8 {
struct EpiGU { static constexpr bool PERM = true, AFTER_DRAIN = false; bf16_t* O;
    __device__ __forceinline__ void operator()(const f32x4 (&acc)[2][2][4][2], const Unit& u, int wr, int wc, int fr, int fq) const {
        const int row0 = u.pm * BM + wr * 64 + fr, col0 = u.pn * HALF + wc * 32 + 8 * fq;
#pragma unroll
        for (int ai = 0; ai < 2; ++ai)
#pragma unroll
            for (int m = 0; m < 4; ++m) { bf16_t* rowp = O + (size_t)(row0 + ai * HALF + m * 16) * FF + col0;
                float o[8];
#pragma unroll
                for (int n = 0; n < 2; ++n)
#pragma unroll
                    for (int i = 0; i < 4; ++i) { const float g = acc[ai][0][m][n][i], up = acc[ai][1][m][n][i]; o[4 * n + i] = g * up * sigmoidf_fast(g); }
                u32x4 w; w.x = cvt_pk_bf16(o[0], o[1]); w.y = cvt_pk_bf16(o[2], o[3]); w.z = cvt_pk_bf16(o[4], o[5]); w.w = cvt_pk_bf16(o[6], o[7]);
                *(u32x4*)rowp = w; }
    }
};
struct EpiResid { static constexpr bool PERM = false, AFTER_DRAIN = false; float* X; const float* gate; float coef;
    __device__ __forceinline__ void operator()(const f32x4 (&acc)[2][2][4][2], const Unit& u, int wr, int wc, int fr, int fq) const {
        const int bb = u.pm / 17, jj = u.pm % 17, midx = jj == 0 ? 4 : bb;
        const int col0 = u.pn * BM + wc * 32 + 4 * fq; const float* gv = gate + (size_t)midx * MODW + col0;
        f32x4 gt[2][2];
#pragma unroll
        for (int bj = 0; bj < 2; ++bj)
#pragma unroll
            for (int n = 0; n < 2; ++n) gt[bj][n] = *(const f32x4*)(gv + bj * HALF + n * 16) * coef;
        float* const row0 = X + (size_t)(u.pm * BM + wr * 64 + fr) * DM + col0;
        f32x4 b[2][2][4];
#define ER_LOAD(buf, p) do { _Pragma("unroll") for (int q = 0; q < 2; ++q) { const int s_ = 2 * (p) + q; const float* rp = row0 + (size_t)((s_ >> 2) * HALF + (s_ & 3) * 16) * DM; \
            _Pragma("unroll") for (int c = 0; c < 4; ++c) b[buf][q][c] = *(const f32x4*)(rp + (c >> 1) * HALF + (c & 1) * 16); } } while (0)
        ER_LOAD(0, 0);
#pragma unroll
        for (int p = 0; p < 4; ++p) { if (p < 3) ER_LOAD((p + 1) & 1, p + 1);
#pragma unroll
            for (int q = 0; q < 2; ++q) { const int s_ = 2 * p + q, ai = s_ >> 2, m = s_ & 3; float* rp = row0 + (size_t)(ai * HALF + m * 16) * DM;
#pragma unroll
                for (int c = 0; c < 4; ++c) *(f32x4*)(rp + (c >> 1) * HALF + (c & 1) * 16) = b[p & 1][q][c] + gt[c >> 1][c & 1] * acc[ai][c >> 1][m][c & 1]; } }
#undef ER_LOAD
    }
};
struct EpiResidX { static constexpr bool PERM = false, AFTER_DRAIN = false; float* X; const float* gate; const float* xin;
    __device__ __forceinline__ void operator()(const f32x4 (&acc)[2][2][4][2], const Unit& u, int wr, int wc, int fr, int fq) const {
        const int bb = u.pm / 17, jj = u.pm % 17;
        const int col0 = u.pn * BM + wc * 32 + 4 * fq; const float* gv = gate + (size_t)bb * MODW + col0;
        f32x4 gt[2][2];
#pragma unroll
        for (int bj = 0; bj < 2; ++bj)
#pragma unroll
            for (int n = 0; n < 2; ++n) gt[bj][n] = *(const f32x4*)(gv + bj * HALF + n * 16) * 0.5f;
        float* const row0 = X + (size_t)(u.pm * BM + wr * 64 + fr) * DM + col0; const float* const src0 = xin + (size_t)(bb * SEQL + (jj - 1) * BM + wr * 64 + fr) * DM + col0;
        f32x4 b[2][2][4];
#define ER_LOAD(buf, p) do { _Pragma("unroll") for (int q = 0; q < 2; ++q) { const int s_ = 2 * (p) + q; const float* rp = src0 + (size_t)((s_ >> 2) * HALF + (s_ & 3) * 16) * DM; \
            _Pragma("unroll") for (int c = 0; c < 4; ++c) b[buf][q][c] = *(const f32x4*)(rp + (c >> 1) * HALF + (c & 1) * 16); } } while (0)
        ER_LOAD(0, 0);
#pragma unroll
        for (int p = 0; p < 4; ++p) { if (p < 3) ER_LOAD((p + 1) & 1, p + 1);
#pragma unroll
            for (int q = 0; q < 2; ++q) { const int s_ = 2 * p + q, ai = s_ >> 2, m = s_ & 3; float* rp = row0 + (size_t)(ai * HALF + m * 16) * DM;
#pragma unroll
                for (int c = 0; c < 4; ++c) *(f32x4*)(rp + (c >> 1) * HALF + (c & 1) * 16) = b[p & 1][q][c] + gt[c >> 1][c & 1] * acc[ai][c >> 1][m][c & 1]; } }
#undef ER_LOAD
    }
};
struct EpiWin { static constexpr bool PERM = true, AFTER_DRAIN = false; bf16_t* P; bf16_t* UG; bf16_t* VA;
    __device__ __forceinline__ void operator()(const f32x4 (&acc)[2][2][4][2], const Unit& u, int wr, int wc, int fr, int fq) const {
        const int row0 = u.pm * BM + wr * 64 + fr, col0 = u.pn * BM + wc * 32 + 8 * fq;
#pragma unroll
        for (int ai = 0; ai < 2; ++ai)
#pragma unroll
            for (int m = 0; m < 4; ++m) { const int row = row0 + ai * HALF + m * 16;
                const int b = row / SPB, s = row % SPB, rc = b * NCH + s / TCH, j = s % TCH;
#pragma unroll
                for (int bj = 0; bj < 2; ++bj) { const f32x4 v0 = acc[ai][bj][m][0], v1 = acc[ai][bj][m][1];
                    u32x4 w; w.x = cvt_pk_bf16(v0[0], v0[1]); w.y = cvt_pk_bf16(v0[2], v0[3]); w.z = cvt_pk_bf16(v1[0], v1[1]); w.w = cvt_pk_bf16(v1[2], v1[3]);
                    const int col = col0 + bj * HALF;
                    if (u.pn < 2) { const int g = col >> 4, ho0 = col & 15; *(u32x4*)(UG + (size_t)(g * RCP + rc) * KS5 + j * 16 + ho0) = w; }
                    else if (u.pn == 6 || u.pn == 7) *(u32x4*)(VA + ((size_t)(b * 6 + ((col - 1536) >> 7)) * SPB + s) * 128 + ((col - 1536) & 127)) = w;
                    else if (u.pn == 13) *(u32x4*)(VA + ((size_t)(b * 6 + 4 + ((col - 3328) >> 7)) * SPB + s) * 128 + ((col - 3328) & 127)) = w;
                    else *(u32x4*)(P + (size_t)row * INC + col) = w; } }
    }
};
struct EpiS5State { static constexpr bool PERM = false, AFTER_DRAIN = false; float* SST;
    __device__ __forceinline__ void operator()(const f32x4 (&acc)[2][2][4][2], const Unit& u, int wr, int wc, int fr, int fq) const {
        const int col0 = wc * 32 + 4 * fq;
#pragma unroll
        for (int ai = 0; ai < 2; ++ai)
#pragma unroll
            for (int m = 0; m < 4; ++m) { float* rowp = SST + (size_t)(u.pm * BM + ai * HALF + wr * 64 + m * 16 + fr) * 256 + col0;
#pragma unroll
                for (int bj = 0; bj < 2; ++bj)
#pragma unroll
                    for (int n = 0; n < 2; ++n) *(f32x4*)(rowp + bj * HALF + n * 16) = acc[ai][bj][m][n]; }
    }
};
struct EpiS5Out { static constexpr bool PERM = true, AFTER_DRAIN = false; const bf16_t* UG; const float* dskip; bf16_t* YG;
    __device__ __forceinline__ void operator()(const f32x4 (&acc)[2][2][4][2], const Unit& u, int wr, int wc, int fr, int fq) const {
        const int g = u.pm / RCT, pmr = u.pm % RCT, pnr = u.pn % NT5;
#pragma unroll
        for (int bj = 0; bj < 2; ++bj) { const int cn8 = 256 * pnr + 128 * bj + 32 * wc + 8 * fq, l = cn8 >> 4, ho0 = cn8 & 15;
            const f32x4 d0 = *(const f32x4*)(dskip + g * 16 + ho0), d1 = *(const f32x4*)(dskip + g * 16 + ho0 + 4);
            u32x4 ub[2][4];
#pragma unroll
            for (int ai = 0; ai < 2; ++ai)
#pragma unroll
                for (int m = 0; m < 4; ++m) ub[ai][m] = *(const u32x4*)(UG + (size_t)(g * RCP + 256 * pmr + 128 * ai + 64 * wr + 16 * m + fr) * KS5 + cn8);
#pragma unroll
            for (int ai = 0; ai < 2; ++ai)
#pragma unroll
                for (int m = 0; m < 4; ++m) { const int rc = 256 * pmr + 128 * ai + 64 * wr + 16 * m + fr;
                    if (rc < RCV) { const int b = rc / NCH, c = rc % NCH; const size_t row = (size_t)b * SPB + c * TCH + l;
                        const u32x4 uu = ub[ai][m];
                        float y[8];
                        y[0] = acc[ai][bj][m][0][0] + d0[0] * bflo(uu.x); y[1] = acc[ai][bj][m][0][1] + d0[1] * bfhi(uu.x);
                        y[2] = acc[ai][bj][m][0][2] + d0[2] * bflo(uu.y); y[3] = acc[ai][bj][m][0][3] + d0[3] * bfhi(uu.y);
                        y[4] = acc[ai][bj][m][1][0] + d1[0] * bflo(uu.z); y[5] = acc[ai][bj][m][1][1] + d1[1] * bfhi(uu.z);
                        y[6] = acc[ai][bj][m][1][2] + d1[2] * bflo(uu.w); y[7] = acc[ai][bj][m][1][3] + d1[3] * bfhi(uu.w);
#pragma unroll
                        for (int i = 0; i < 8; ++i) { const float v = y[i]; y[i] = v * sigmoidf_fast(1.5957691216057308f * (v + 0.044715f * v * v * v)); }
                        u32x4 w; w.x = cvt_pk_bf16(y[0], y[1]); w.y = cvt_pk_bf16(y[2], y[3]); w.z = cvt_pk_bf16(y[4], y[5]); w.w = cvt_pk_bf16(y[6], y[7]);
                        *(u32x4*)(YG + row * 512 + g * 16 + ho0) = w; } } }
    }
};
struct EpiGLU { static constexpr bool PERM = true, AFTER_DRAIN = false; const bf16_t* YG; const float* gb; bf16_t* MIX;
    __device__ __forceinline__ void operator()(const f32x4 (&acc)[2][2][4][2], const Unit& u, int wr, int wc, int fr, int fq) const {
        const int row0 = u.pm * BM + wr * 64 + fr, col0 = u.pn * BM + wc * 32 + 8 * fq;
#pragma unroll
        for (int bj = 0; bj < 2; ++bj) { const int col = col0 + bj * HALF; const f32x4 b0 = *(const f32x4*)(gb + col), b1 = *(const f32x4*)(gb + col + 4);
            u32x4 yb[2][4];
#pragma unroll
            for (int ai = 0; ai < 2; ++ai)
#pragma unroll
                for (int m = 0; m < 4; ++m) yb[ai][m] = *(const u32x4*)(YG + (size_t)(row0 + ai * HALF + m * 16) * 512 + col);
#pragma unroll
            for (int ai = 0; ai < 2; ++ai)
#pragma unroll
                for (int m = 0; m < 4; ++m) { const size_t row = (size_t)(row0 + ai * HALF + m * 16);
                    const u32x4 yy = yb[ai][m];
                    const f32x4 z0 = acc[ai][bj][m][0] + b0, z1 = acc[ai][bj][m][1] + b1;
                    float o[8];
                    o[0] = bflo(yy.x) * sigmoidf_fast(z0[0]); o[1] = bfhi(yy.x) * sigmoidf_fast(z0[1]); o[2] = bflo(yy.y) * sigmoidf_fast(z0[2]); o[3] = bfhi(yy.y) * sigmoidf_fast(z0[3]);
                    o[4] = bflo(yy.z) * sigmoidf_fast(z1[0]); o[5] = bfhi(yy.z) * sigmoidf_fast(z1[1]); o[6] = bflo(yy.w) * sigmoidf_fast(z1[2]); o[7] = bfhi(yy.w) * sigmoidf_fast(z1[3]);
                    u32x4 w; w.x = cvt_pk_bf16(o[0], o[1]); w.y = cvt_pk_bf16(o[2], o[3]); w.z = cvt_pk_bf16(o[4], o[5]); w.w = cvt_pk_bf16(o[6], o[7]);
                    *(u32x4*)(MIX + row * DM + col) = w; } }
    }
};
struct S5StateOrder { int G, c;
    __device__ bool next(int i, Unit& u) const { const int L = i * G + c; if (L >= S5G * RCT) return false; u.pm = L; u.pn = L / RCT; u.kofs = 0; u.ks = 0; return true; }
    __device__ __forceinline__ void a_ready(const Unit&) const {}
    __device__ __forceinline__ void done(const Unit&) const {}
};
struct S5OutOrder { int G, c;
    __device__ bool next(int i, Unit& u) const { const int L = i * G + c; if (L >= S5G * RCT * NT5) return false; const int g = L / (RCT * NT5), rem = L % (RCT * NT5); u.pm = RCT * g + rem % RCT; u.pn = NT5 * g + rem / RCT; u.kofs = 0; u.ks = 0; return true; }
    __device__ __forceinline__ void a_ready(const Unit&) const {}
    __device__ __forceinline__ void done(const Unit&) const {}
};
struct FlexOrder { StaticOrder so; bool lat;
    __device__ void init(bool lat_, int N, int G_, int c_) { lat = lat_; so.init(lat_ ? 64 * BM : R, N, G_, c_); }
    __device__ bool next(int i, Unit& u) const { if (!so.next(i, u)) return false; if (lat) u.pm = (u.pm >> 4) * 17 + 1 + (u.pm & 15); return true; }
    __device__ __forceinline__ void a_ready(const Unit&) const {}
    __device__ __forceinline__ void done(const Unit&) const {}
};
struct CtxSplitOrder { int G, c, ksbytes;
    __device__ bool next(int i, Unit& u) const { const int L = i * G + c; if (L >= 128) return false; const int p = L >> 5, rem = L & 31; u.pm = 17 * p; u.pn = rem & 7; u.ks = rem >> 3; u.kofs = u.ks * ksbytes; return true; }
    __device__ __forceinline__ void a_ready(const Unit&) const {}
    __device__ __forceinline__ void done(const Unit&) const {}
};
struct EpiPart { static constexpr bool PERM = false, AFTER_DRAIN = false; float* PART;
    __device__ __forceinline__ void operator()(const f32x4 (&acc)[2][2][4][2], const Unit& u, int wr, int wc, int fr, int fq) const {
        const int col0 = u.pn * BM + wc * 32 + 4 * fq, prow = (u.pm / 17) * 256;
#pragma unroll
        for (int ai = 0; ai < 2; ++ai)
#pragma unroll
            for (int m = 0; m < 4; ++m) { float* rowp = PART + ((size_t)u.ks * 1024 + prow + ai * HALF + wr * 64 + m * 16 + fr) * DM + col0;
#pragma unroll
                for (int bj = 0; bj < 2; ++bj)
#pragma unroll
                    for (int n = 0; n < 2; ++n) *(f32x4*)(rowp + bj * HALF + n * 16) = acc[ai][bj][m][n]; }
    }
};
}

__device__ __forceinline__ void transpose_item(const float* W, int K, int N, bf16_t* WT, int k0, int n0, int rowbase, LAS float* scr, int lane) {
#pragma unroll 8
    for (int i = 0; i < 32; ++i) { const int kk = 2 * i + (lane >> 5); scr[kk * 33 + (lane & 31)] = W[(size_t)(k0 + kk) * N + n0 + (lane & 31)]; }
    LDS_WAIT(); asm volatile("" ::: "memory");
    const int c = lane & 7;
#pragma unroll
    for (int j = 0; j < 4; ++j) { const int n = (lane >> 3) + 8 * j; const LAS float* s = scr + (8 * c) * 33 + n;
        v4u o; o.x = pk2(s[0 * 33], s[1 * 33]); o.y = pk2(s[2 * 33], s[3 * 33]); o.z = pk2(s[4 * 33], s[5 * 33]); o.w = pk2(s[6 * 33], s[7 * 33]);
        *(GAS v4u*)(WT + (size_t)(rowbase + n) * K + k0 + 8 * c) = o; }
    LDS_WAIT(); asm volatile("" ::: "memory");
}
__device__ __forceinline__ void norm_mod_rows(float* XS, bf16_t* H, const float* g, const float* modl, int modk, int gw, int NGW, int lane, int tid, LAS float* tab, const float* part, const float* pgate, float pcoef, bool skipctx, const float* xin) {
    for (int i = tid; i < 5 * DM; i += NWAVES * 64) { const int m = i / DM, k = i % DM; const float* mv = modl + (size_t)m * MODW + (3 * modk) * DM + k; tab[i] = g[k] * (1.f + mv[DM]); tab[5 * DM + i] = mv[0]; }
    __syncthreads();
    auto rowsrc = [&](int r) { const int b = r / SPB, s = r % SPB; return (const f32x4*)((xin && s >= CTXL) ? xin + (size_t)(b * SEQL + s - CTXL) * DM : XS + (size_t)r * DM) + lane; };
    auto finish = [&](f32x4 (&v)[8], int r) {
        const int b = r / SPB, s = r % SPB, midx = s < CTXL ? 4 : b;
        if (skipctx && s < CTXL) return;
        if (part && s < CTXL) { const f32x4* pr = (const f32x4*)(part + (size_t)(b * CTXL + s) * DM) + lane; f32x4* xw = (f32x4*)(XS + (size_t)r * DM) + lane;
#pragma unroll
            for (int j = 0; j < 8; ++j) { const f32x4 ps = (pr[64 * j] + pr[64 * j + 1024 * DM / 4]) + (pr[64 * j + 2 * 1024 * DM / 4] + pr[64 * j + 3 * 1024 * DM / 4]);
                v[j] = v[j] + (*(const f32x4*)(pgate + 4 * (lane + 64 * j)) * pcoef) * ps; xw[64 * j] = v[j]; } }
        float ss = 0.f;
#pragma unroll
        for (int j = 0; j < 8; ++j) ss += (v[j].x * v[j].x + v[j].y * v[j].y) + (v[j].z * v[j].z + v[j].w * v[j].w);
        const float rstd = 1.f / sqrtf(wave_sum(ss) * (1.f / DM) + EPS);
        unsigned long long* o8 = (unsigned long long*)(H + (size_t)r * DM) + lane; const LAS f32x4* cs = (const LAS f32x4*)(tab + midx * DM) + lane; const LAS f32x4* sh = (const LAS f32x4*)(tab + (5 + midx) * DM) + lane;
#pragma unroll
        for (int j = 0; j < 8; ++j) { const f32x4 o = (v[j] * rstd) * cs[64 * j] + sh[64 * j];
            o8[64 * j] = (unsigned long long)cvtpk2(o.x, o.y) | ((unsigned long long)cvtpk2(o.z, o.w) << 32); }
    };
    for (int r0 = gw; r0 < R; r0 += 2 * NGW) {
        const int r1 = r0 + NGW; const bool two = r1 < R;
        const f32x4* xa = rowsrc(r0); const f32x4* xb = rowsrc(two ? r1 : r0);
        f32x4 va[8], vb[8];
#pragma unroll
        for (int j = 0; j < 8; ++j) va[j] = xa[64 * j];
#pragma unroll
        for (int j = 0; j < 8; ++j) vb[j] = xb[64 * j];
        finish(va, r0); if (two) finish(vb, r1);
    }
}
__device__ __forceinline__ void unpack8(const u32x4v w, float (&f)[8]) {
    f[0] = bflo(w.x); f[1] = bfhi(w.x); f[2] = bflo(w.y); f[3] = bfhi(w.y); f[4] = bflo(w.z); f[5] = bfhi(w.z); f[6] = bflo(w.w); f[7] = bfhi(w.w);
}
__device__ __forceinline__ u32x4v pack8(const float (&f)[8]) { u32x4v w; w.x = cvtpk2(f[0], f[1]); w.y = cvtpk2(f[2], f[3]); w.z = cvtpk2(f[4], f[5]); w.w = cvtpk2(f[6], f[7]); return w; }
template <int XORL> __device__ __forceinline__ void rope8(float (&f)[8], bool first, const f32x2v* tab) {
#pragma unroll
    for (int e = 0; e < 8; ++e) {
        const f32x2v cs = tab[e];
        const float other = __shfl_xor(f[e], XORL);
        f[e] = first ? (f[e] * cs.x - other * cs.y) : (other * cs.y + f[e] * cs.x);
    }
}
__device__ __forceinline__ void s5_tables(unsigned char* ws, const float* p_cre, const float* p_cim, int mask, int layer, int t0, int stride) {
    const f32x2v* const APOW = (const f32x2v*)(ws + WS_APOW); const f32x2v* const BBAR = (const f32x2v*)(ws + WS_BBAR);
    const float* const KTAB = (const float*)(ws + WS_KTAB); bf16_t* const TZE = (bf16_t*)(ws + WS_TZE); bf16_t* const SM = (bf16_t*)(ws + WS_SM);
                    if (mask & 1) {   constexpr int NL = S5G * KU * (KU / 8); const int N1 = (layer + 1) * NL;
                        for (int e0 = layer * NL + t0; e0 < N1; e0 += 4 * stride) {
                            f32x4 a0[4], a1[4]; size_t dsto[4];
#pragma unroll
                            for (int u = 0; u < 4; ++u) { int e = e0 + u * stride; e = e < N1 ? e : N1 - 1;
                                { const int k8 = e % (KU / 8), n = (e / (KU / 8)) % KU, lg = e / ((KU / 8) * KU), t = n >> 4, ho = n & 15, jj = k8 >> 1, hi0 = (k8 & 1) * 8;
                                    const float* src = KTAB + ((size_t)lg * NLAG + (t - jj + TCH - 1)) * 256 + ho * 16 + hi0; a0[u] = *(const f32x4*)src; a1[u] = *(const f32x4*)(src + 4);
                                    dsto[u] = ((size_t)lg * KU + n) * KS5 + k8 * 8; } }
#pragma unroll
                            for (int u = 0; u < 4; ++u) { const float o[8] = {a0[u].x, a0[u].y, a0[u].z, a0[u].w, a1[u].x, a1[u].y, a1[u].z, a1[u].w}; *(u32x4v*)(TZE + dsto[u]) = pack8(o); }
                        } }
                    if (mask & 2) {   constexpr int NL = S5G * KU * 32; const int N2 = (layer + 1) * NL;
                        for (int e0 = layer * NL + t0; e0 < N2; e0 += 4 * stride) {
                            f32x2v ap[4][4]; f32x4 cr4[4], ci4[4]; size_t dsto[4];
#pragma unroll
                            for (int u = 0; u < 4; ++u) { int e = e0 + u * stride; e = e < N2 ? e : N2 - 1;
                                { const int q = e & 31, n = (e >> 5) % KU, lg = (e >> 5) / KU, t = n >> 4, ho = n & 15, d = q >> 4, p0 = (q & 15) * 4, l = lg / S5G, g = lg % S5G, base = (l * 2 + d) * S5G + g, pw = d == 0 ? t + 1 : TCH - t;
                                    cr4[u] = *(const f32x4*)(p_cre + ((size_t)base * S5H + ho) * S5P + p0); ci4[u] = *(const f32x4*)(p_cim + ((size_t)base * S5H + ho) * S5P + p0);
#pragma unroll
                                    for (int pp = 0; pp < 4; ++pp) ap[u][pp] = APOW[((size_t)base * S5P + p0 + pp) * 65 + pw];
                                    dsto[u] = ((size_t)lg * KU + n) * KS5 + (KU / 8 + q) * 8; } }
#pragma unroll
                            for (int u = 0; u < 4; ++u) { float o[8];
#pragma unroll
                                for (int pp = 0; pp < 4; ++pp) { const float cr = cr4[u][pp], ci = ci4[u][pp]; o[2 * pp] = cr * ap[u][pp].x - ci * ap[u][pp].y; o[2 * pp + 1] = -(cr * ap[u][pp].y + ci * ap[u][pp].x); }
                                *(u32x4v*)(TZE + dsto[u]) = pack8(o); }
                        } }
                    if (mask & 4) {   constexpr int NL = S5G * 256 * (KU / 8); const int N3 = (layer + 1) * NL;
                        for (int e0 = layer * NL + t0; e0 < N3; e0 += 4 * stride) {
                            f32x2v ap[4]; f32x4 bq[4][4]; size_t dsto[4]; int ri[4];
#pragma unroll
                            for (int u = 0; u < 4; ++u) { int e = e0 + u * stride; e = e < N3 ? e : N3 - 1;
                                { const int k8 = e % (KU / 8), n = (e / (KU / 8)) & 255, lg = e / ((KU / 8) * 256), l = lg / S5G, g = lg % S5G, d = n >> 7, p = (n & 127) >> 1, jj = k8 >> 1, hi0 = (k8 & 1) * 8;
                                    const int base = (l * 2 + d) * S5G + g, pw = d == 0 ? TCH - 1 - jj : jj; ri[u] = n & 1;
                                    ap[u] = APOW[((size_t)base * S5P + p) * 65 + pw]; const f32x4* bp = (const f32x4*)(BBAR + ((size_t)base * S5P + p) * S5H + hi0);
#pragma unroll
                                    for (int w = 0; w < 4; ++w) bq[u][w] = bp[w];
                                    dsto[u] = ((size_t)lg * 256 + n) * KU + k8 * 8; } }
#pragma unroll
                            for (int u = 0; u < 4; ++u) { float o[8];
#pragma unroll
                                for (int w = 0; w < 4; ++w) { const f32x4 b2 = bq[u][w];
                                    o[2 * w] = ri[u] ? (ap[u].x * b2.y + ap[u].y * b2.x) : (ap[u].x * b2.x - ap[u].y * b2.y);
                                    o[2 * w + 1] = ri[u] ? (ap[u].x * b2.w + ap[u].y * b2.z) : (ap[u].x * b2.z - ap[u].y * b2.w); }
                                *(u32x4v*)(SM + dsto[u]) = pack8(o); }
                        } }
}
__device__ __forceinline__ const void* ldptr(LAS unsigned char* ldsl, int i) {
    const unsigned long long v = *(volatile LAS unsigned long long*)(ldsl + PTR_OFF + 8 * i);
    const unsigned lo = __builtin_amdgcn_readfirstlane((unsigned)v), hi = __builtin_amdgcn_readfirstlane((unsigned)(v >> 32));
    return (const void*)(const GAS void*)(((unsigned long long)hi << 32) | lo);
}
struct Args { const float* in[27]; float* out; unsigned char* ws; int ph_lo, ph_hi; };
__global__ void __launch_bounds__(NWAVES * 64, 2) mega_fwd(Args args) {
    extern __shared__ __attribute__((aligned(16))) unsigned char lds[];
    LAS unsigned char* const ldsl = (LAS unsigned char*)lds;
    const int tid = threadIdx.x;
#define PH_IDS int tid_l = threadIdx.x; asm volatile("" : "+v"(tid_l)); const int tid = tid_l, lane = tid & 63, wave = __builtin_amdgcn_readfirstlane(tid >> 6); \
    int G_l = gridDim.x, bx_l = blockIdx.x; asm volatile("" : "+s"(G_l), "+s"(bx_l)); const int G = G_l, bx = bx_l, vcu = (G % 8 == 0) ? (bx % 8) * (G / 8) + bx / 8 : bx; \
    const int gw = vcu * NWAVES + wave, NGW = G * NWAVES; (void)lane; (void)gw; (void)NGW; (void)vcu; (void)bx; (void)tid;
    for (int u = tid; u < (LDS_BYTES - LDSCTL_OFF) / 4; u += NWAVES * 64) ((LAS unsigned*)(ldsl + LDSCTL_OFF))[u] = 0u;
    __syncthreads();
    if (tid < 27) ((LAS unsigned long long*)(ldsl + PTR_OFF))[tid] = (unsigned long long)args.in[tid];
    if (tid == 27) ((LAS unsigned long long*)(ldsl + PTR_OFF))[27] = (unsigned long long)args.out;
    if (tid == 28) ((LAS unsigned long long*)(ldsl + PTR_OFF))[28] = (unsigned long long)args.ws;
    __syncthreads();
#define INP(i) ((const float*)ldptr(ldsl, (i)))
#define WSP() ((unsigned char*)ldptr(ldsl, 28))
#define WS_F32(off) ((float*)(ws + (off)))
#define WS_BF(off) ((bf16_t*)(ws + (off)))
    XcdBarrier bar; bar.bar = (unsigned*)(args.ws + WS_CTL) + CW_BAR; bar.x = 0; bar.st = nullptr;
    if (MK_N_LAUNCHES == 1) bar = xcd_barrier_post((unsigned*)(args.ws + WS_CTL) + CW_BAR, (volatile LAS unsigned*)(ldsl + MISC_OFF) + 8);
    const int lo = args.ph_lo, hi = args.ph_hi; int ph = 0;
#define PH_ON (ph >= lo && ph < hi)
#define PH_END do { if (ph >= lo && ph + 1 < hi) xcd_barrier(bar); asm volatile("" ::: "memory"); ++ph; } while (0)
    if (PH_ON) for (int rep = 0; rep < PROBE_REPS(ph); ++rep) { PH_IDS (void)rep;
        unsigned char* const ws = WSP();
        {   const float* const c_in = INP(1); const float* const cctx_in = INP(3); const float* const ada_w = INP(4); const float* const ada_b = INP(5); float* const MODV = WS_F32(WS_MODV);
            LAS float* sl = (LAS float*)ldsl;
            LAS float* part = (LAS float*)(ldsl + 40960);
            for (int i = tid; i < 5 * DM; i += NWAVES * 64) { const int m = i / DM, k = i % DM; const float v = m < 4 ? c_in[m * DM + k] : cctx_in[k]; sl[i] = v / (1.f + expf(-v)); }
            __syncthreads();
            for (int it = vcu; it < 2 * 288; it += G) {
                const int layer = it / 288, n0 = (it % 288) * 64, kb = wave * 256;
                const float* W = ada_w + (size_t)layer * DM * MODW + (size_t)kb * MODW + n0 + lane;
                float a0 = 0.f, a1 = 0.f, a2 = 0.f, a3 = 0.f, a4 = 0.f;
#pragma unroll 4
                for (int kk = 0; kk < 256; kk += 4) {
                    const float w0 = W[(size_t)(kk + 0) * MODW], w1 = W[(size_t)(kk + 1) * MODW], w2 = W[(size_t)(kk + 2) * MODW], w3 = W[(size_t)(kk + 3) * MODW];
                    const f32x4 s0 = *(const LAS f32x4*)(sl + 0 * DM + kb + kk), s1 = *(const LAS f32x4*)(sl + 1 * DM + kb + kk), s2 = *(const LAS f32x4*)(sl + 2 * DM + kb + kk),
                                s3 = *(const LAS f32x4*)(sl + 3 * DM + kb + kk), s4 = *(const LAS f32x4*)(sl + 4 * DM + kb + kk);
                    a0 += s0.x * w0 + s0.y * w1 + s0.z * w2 + s0.w * w3; a1 += s1.x * w0 + s1.y * w1 + s1.z * w2 + s1.w * w3; a2 += s2.x * w0 + s2.y * w1 + s2.z * w2 + s2.w * w3;
                    a3 += s3.x * w0 + s3.y * w1 + s3.z * w2 + s3.w * w3; a4 += s4.x * w0 + s4.y * w1 + s4.z * w2 + s4.w * w3;
                }
                part[(wave * 5 + 0) * 64 + lane] = a0; part[(wave * 5 + 1) * 64 + lane] = a1; part[(wave * 5 + 2) * 64 + lane] = a2; part[(wave * 5 + 3) * 64 + lane] = a3; part[(wave * 5 + 4) * 64 + lane] = a4;
                __syncthreads();
                if (tid < 320) { const int m = tid >> 6, l = tid & 63; float s = 0.f;
#pragma unroll
                    for (int w = 0; w < 8; ++w) s += part[(w * 5 + m) * 64 + l];
                    MODV[(size_t)(layer * 5 + m) * MODW + n0 + l] = s + ada_b[layer * MODW + n0 + l]; }
                __syncthreads();
            }
        }
        __syncthreads();
        {   LAS float* scr = (LAS float*)(ldsl + wave * 16384);
            bf16_t* const WGU = WS_BF(WS_WGU); bf16_t* const WD = WS_BF(WS_WD); bf16_t* const WIN = WS_BF(WS_WIN); bf16_t* const WOUT = WS_BF(WS_WOUT); bf16_t* const GLUW = WS_BF(WS_GLU);
            constexpr int I_F = 5632, I_FFN = 3 * I_F * 4, I_IN = 3584, I_OUT = 2048, I_GLU = 128, I_L = I_IN + I_OUT + I_GLU, NITEMS = I_FFN + 2 * I_L;
            const int n3 = (2 * 288 > 2 * G) ? 2 * 288 - 2 * G : 0, vw = vcu < n3 ? (wave < 7 ? vcu * 7 + wave : -1) : n3 * 7 + (vcu - n3) * 8 + wave, NVW = n3 * 7 + (G - n3) * 8;
            for (int it = vw; it < NITEMS && it >= 0; it += NVW) {
                if (it < I_FFN) { const int fi = it / (3 * I_F), rem = it % (3 * I_F), kind = rem / I_F, item = rem % I_F;
                    if (kind < 2) { const int nblk = FF / 32, kbk = item / nblk, nb = item % nblk, n0 = 32 * nb;
                        transpose_item(INP(7 + kind) + (size_t)fi * DM * FF, DM, FF, WGU + (size_t)fi * 2 * FF * DM, 64 * kbk, n0, (n0 / 128) * 256 + (n0 % 128) + kind * 128, scr, lane); }
                    else { const int nblk = DM / 32, kbk = item / nblk, nb = item % nblk;
                        transpose_item(INP(9) + (size_t)fi * FF * DM, FF, DM, WD + (size_t)fi * DM * FF, 64 * kbk, 32 * nb, 32 * nb, scr, lane); } }
                else { const int it2 = it - I_FFN, l = it2 / I_L, rem = it2 % I_L;
                    if (rem < I_IN) { const int nblk = INC / 32, kbk = rem / nblk, nb = rem % nblk;
                        transpose_item(INP(10) + (size_t)l * DM * INC, DM, INC, WIN + (size_t)l * INC * DM, 64 * kbk, 32 * nb, 32 * nb, scr, lane); }
                    else if (rem < I_IN + I_OUT) { const int r2 = rem - I_IN, nblk = DM / 32, kbk = r2 / nblk, nb = r2 % nblk;
                        transpose_item(INP(11) + (size_t)l * DM * DM, DM, DM, WOUT + (size_t)l * DM * DM, 64 * kbk, 32 * nb, 32 * nb, scr, lane); }
                    else { const int r2 = rem - I_IN - I_OUT, nblk = 512 / 32, kbk = r2 / nblk, nb = r2 % nblk;
                        transpose_item(INP(20) + (size_t)l * 512 * 512, 512, 512, GLUW + (size_t)l * 512 * 512, 64 * kbk, 32 * nb, 32 * nb, scr, lane); } }
            }
        }
        {   const float* const ctx_in = INP(2); float* const XS = WS_F32(WS_XS);
            for (int i = bx * (NWAVES * 64) + tid; i < NB * CTXL * (DM / 4); i += G * (NWAVES * 64)) {
                const int r = i / (DM / 4), c4 = i % (DM / 4), b = r / CTXL, s_ = r % CTXL;
                ((f32x4*)(XS + (size_t)(b * SPB + s_) * DM))[c4] = ((const f32x4*)ctx_in)[i]; }
        }
        {   f32x2v* const ROPE = (f32x2v*)(ws + WS_ROPE);
            for (int e = bx * (NWAVES * 64) + tid; e < 64 * 48; e += G * (NWAVES * 64)) { const int pos = e / 48, i = e % 48;
                const float freq = i < 16 ? exp2f(-(float)i * (13.287712379549449f / 16.f)) : exp2f(-(float)(i - 16) * (13.287712379549449f / 32.f));
                const float ang = (float)pos * freq; ROPE[e] = (f32x2v){cosf(ang), sinf(ang)}; } }
        {   const float* const p_lre = INP(12); const float* const p_lim = INP(13); const float* const p_ldt = INP(14); const float* const p_bre = INP(15); const float* const p_bim = INP(16);
            f32x2v* const APOW = (f32x2v*)(ws + WS_APOW); f32x2v* const BBAR = (f32x2v*)(ws + WS_BBAR);
        for (int idx = bx * (NWAVES * 64) + tid; idx < 2 * 2 * S5G * S5P * 65; idx += G * (NWAVES * 64)) { const int e = idx / 65, k = idx % 65;
            const float lre = p_lre[e], lim = p_lim[e], dt = expf(p_ldt[e / S5P]);
            const float xr = lre * dt; const double trev = (double)lim * (double)dt * 0.15915494309189535;
            const double tk = trev * (double)k; const float ang = (float)((tk - floor(tk)) * 6.283185307179586); const float mg = expf(xr * (float)k);
            APOW[idx] = (f32x2v){mg * cosf(ang), mg * sinf(ang)}; }
        for (int idx = bx * (NWAVES * 64) + tid; idx < 2 * 2 * S5G * S5P * S5H; idx += G * (NWAVES * 64)) { const int e = idx / S5H;
            const float lre = p_lre[e], lim = p_lim[e], dt = expf(p_ldt[e / S5P]);
            const float xr = lre * dt; const double trev = (double)lim * (double)dt * 0.15915494309189535;
            const float y = (float)((trev - floor(trev)) * 6.283185307179586);
            const float er = expm1f(xr), cy = cosf(y), sy = sinf(y), shf = sinf(0.5f * y);
            const float nr = er * cy - 2.f * shf * shf, ni = (er + 1.f) * sy, den = 1.f / (lre * lre + lim * lim);
            const float qr = (nr * lre + ni * lim) * den, qi = (ni * lre - nr * lim) * den;
            const float br = p_bre[idx], bi = p_bim[idx];
            BBAR[idx] = (f32x2v){qr * br - qi * bi, qr * bi + qi * br}; }
        }
    }
    PH_END;

    for (int fi = 0; fi < 4; ++fi) {
        const int layer = fi >> 1, which = fi & 1;
        if (PH_ON) for (int rep = 0; rep < PROBE_REPS(ph); ++rep) { PH_IDS (void)rep;
            unsigned char* const ws = WSP(); const float* const modl = WS_F32(WS_MODV) + (size_t)layer * 5 * MODW;
            {
                const bool fix = (fi == 1 || fi == 2) && rep == 0; const float* const pg = WS_F32(WS_MODV) + (size_t)4 * MODW + (fi == 1 ? 5 : 8) * DM;
                norm_mod_rows(WS_F32(WS_XS), WS_BF(WS_H), INP(6) + (size_t)(layer * 3 + which * 2) * DM, modl, which * 2, gw, NGW, lane, tid, (LAS float*)ldsl, fix ? WS_F32(WS_PART) : nullptr, pg, fi == 1 ? 1.f : 0.5f, fi == 3, fi == 0 ? INP(0) : nullptr); }
            if (fi == 0) {
                const float* const p_cre = INP(17); const float* const p_cim = INP(18); const f32x2v* const APOW = (const f32x2v*)(ws + WS_APOW); const f32x2v* const BBAR = (const f32x2v*)(ws + WS_BBAR); float* const KTAB = WS_F32(WS_KTAB);
                for (int e = bx * (NWAVES * 64) + tid; e < 2 * S5G * 2 * (TCH / 8) * 256; e += G * (NWAVES * 64)) {
                    const int hi_ = e & 15, ho = (e >> 4) & 15, kg = (e >> 8) % (TCH / 8), d = ((e >> 8) / (TCH / 8)) & 1, lg = (e >> 8) / (TCH / 8) / 2, l = lg / S5G, g = lg % S5G;
                    const int base = (l * 2 + d) * S5G + g;
                    const float* cre = p_cre + ((size_t)base * S5H + ho) * S5P; const float* cim = p_cim + ((size_t)base * S5H + ho) * S5P;
                    float acc[8] = {0.f, 0.f, 0.f, 0.f, 0.f, 0.f, 0.f, 0.f};
#pragma unroll 4
                    for (int p = 0; p < S5P; ++p) { const f32x2v bb = BBAR[((size_t)base * S5P + p) * S5H + hi_]; const float cr = cre[p], ci = cim[p];
                        const float wr_ = cr * bb.x - ci * bb.y, wi_ = cr * bb.y + ci * bb.x; const f32x2v* ap = APOW + ((size_t)base * S5P + p) * 65 + 8 * kg;
#pragma unroll
                        for (int q = 0; q < 8; ++q) { const f32x2v a = ap[q]; acc[q] += wr_ * a.x - wi_ * a.y; } }
                    if (d == 0 && kg == 0) { const int base1 = (l * 2 + 1) * S5G + g; const float* cre1 = p_cre + ((size_t)base1 * S5H + ho) * S5P; const float* cim1 = p_cim + ((size_t)base1 * S5H + ho) * S5P;
#pragma unroll 8
                        for (int p = 0; p < S5P; ++p) { const f32x2v bb = BBAR[((size_t)base1 * S5P + p) * S5H + hi_]; acc[0] += cre1[p] * bb.x - cim1[p] * bb.y; } }
#pragma unroll
                    for (int q = 0; q < 8; ++q) { const int k = 8 * kg + q; if (d == 1 && k == 0) continue;
                        KTAB[((size_t)lg * NLAG + (TCH - 1) + (d == 0 ? k : -k)) * 256 + ho * 16 + hi_] = acc[q]; }
                }
            }
        }
        PH_END;
        if (PH_ON) for (int rep = 0; rep < PROBE_REPS(ph); ++rep) { PH_IDS (void)rep;
            unsigned char* const ws = WSP();
            pg8::Gemm g{WS_BF(WS_H), WS_BF(WS_WGU) + (size_t)fi * 2 * FF * DM, R, 2 * FF, DM, DM, DM}; pg8::FlexOrder S; S.init(fi == 3, 2 * FF, G, bx);
            pg8::EpiGU E{WS_BF(WS_HACT)};
            pg8::gemm_phase<pg8::EpiGU, pg8::FlexOrder, true, true>(ldsl, g, S, E);
            if (fi == 0 && G == 256 && bx >= 176 && rep == 0) s5_tables(ws, INP(17), INP(18), 1, 0, (bx - 176) * (NWAVES * 64) + tid, 80 * (NWAVES * 64));
        }
        PH_END;
        if (PH_ON) for (int rep = 0; rep < PROBE_REPS(ph); ++rep) { PH_IDS (void)rep;
            unsigned char* const ws = WSP(); const float* const modl = WS_F32(WS_MODV) + (size_t)layer * 5 * MODW;
            if (fi < 3) {
                pg8::Gemm g{WS_BF(WS_HACT), WS_BF(WS_WD) + (size_t)fi * DM * FF, R, DM, FF / 4, FF, FF}; pg8::CtxSplitOrder S{G, bx, (FF / 4) * 2};
                pg8::EpiPart E{WS_F32(WS_PART)};
                pg8::gemm_phase<pg8::EpiPart, pg8::CtxSplitOrder, true, true>(ldsl, g, S, E);
                if (G == 256 && bx >= 128 && rep == 0) s5_tables(ws, INP(17), INP(18), fi == 0 ? 6 : fi == 1 ? 3 : 4, fi == 0 ? 0 : 1, (bx - 128) * (NWAVES * 64) + tid, 128 * (NWAVES * 64)); }
            pg8::Gemm g{WS_BF(WS_HACT), WS_BF(WS_WD) + (size_t)fi * DM * FF, R, DM, FF, FF, FF}; pg8::FlexOrder S; S.init(true, DM, G, bx);
            if (fi == 0) { pg8::EpiResidX E{WS_F32(WS_XS), modl + (size_t)2 * DM, INP(0)};
                pg8::gemm_phase<pg8::EpiResidX, pg8::FlexOrder, true, true>(ldsl, g, S, E); }
            else { pg8::EpiResid E{WS_F32(WS_XS), modl + (size_t)(which * 6 + 2) * DM, rep ? 0.f : 0.5f};
                pg8::gemm_phase<pg8::EpiResid, pg8::FlexOrder, true, true>(ldsl, g, S, E); }
        }
        PH_END;
        if (which == 0) {
            if (PH_ON) for (int rep = 0; rep < PROBE_REPS(ph); ++rep) { PH_IDS (void)rep;
                unsigned char* const ws = WSP(); const float* const modl = WS_F32(WS_MODV) + (size_t)layer * 5 * MODW;
                norm_mod_rows(WS_F32(WS_XS), WS_BF(WS_H), INP(6) + (size_t)(layer * 3 + 1) * DM, modl, 1, gw, NGW, lane, tid, (LAS float*)ldsl, rep == 0 ? WS_F32(WS_PART) : nullptr, modl + (size_t)4 * MODW + 2 * DM, 0.5f, false, nullptr);
                if (layer == 0) { if (G == 256) {   }
                    else { s5_tables(ws, INP(17), INP(18), 7, 0, bx * (NWAVES * 64) + tid, G * (NWAVES * 64)); s5_tables(ws, INP(17), INP(18), 7, 1, bx * (NWAVES * 64) + tid, G * (NWAVES * 64)); } }
            }
            PH_END;
            if (PH_ON) for (int rep = 0; rep < PROBE_REPS(ph); ++rep) { PH_IDS (void)rep;
                unsigned char* const ws = WSP();
                pg8::Gemm g{WS_BF(WS_H), WS_BF(WS_WIN) + (size_t)layer * INC * DM, R, INC, DM, DM, DM}; pg8::StaticOrder S; S.init(R, INC, G, bx);
                pg8::EpiWin E{WS_BF(WS_P), WS_BF(WS_UG), WS_BF(WS_VA)};
                pg8::gemm_phase<pg8::EpiWin, pg8::StaticOrder, true, true>(ldsl, g, S, E);
            }
            PH_END;
            if (PH_ON) for (int rep = 0; rep < PROBE_REPS(ph); ++rep) { PH_IDS (void)rep;
                unsigned char* const ws = WSP();
                {   pg8::Gemm g{WS_BF(WS_UG), WS_BF(WS_SM) + (size_t)layer * S5G * 256 * KU, S5G * RCP, S5G * 256, KU, KS5, KU}; pg8::S5StateOrder S{G, bx};
                    pg8::EpiS5State E{WS_F32(WS_SST)};
                    pg8::gemm_phase<pg8::EpiS5State, pg8::S5StateOrder, true, true>(ldsl, g, S, E); }
                const float* kg = INP(25) + layer * 128;
                const bf16_t* const PB = WS_BF(WS_P); bf16_t* const KA = WS_BF(WS_KA); const f32x2v* const ROPE = (const f32x2v*)(ws + WS_ROPE);
                constexpr int NSU = S5G * RCT; const bool spare = G > 2 * NSU;
                for (int r = spare ? (bx - NSU) * NWAVES + wave : gw; r < R && r >= 0; r += spare ? (G - NSU) * NWAVES : NGW) {
                    const int b = r / SPB, s = r % SPB; const bool lat = s >= CTXL; const int t = lat ? s - CTXL : 0; const f32x2v* const trow = ROPE + (t >> 6) * 48; const f32x2v* const tcol = ROPE + (t & 63) * 48;
                    const bf16_t* pr = PB + (size_t)r * INC; bf16_t* ka = KA + ((size_t)(b * 6) * SPB + s) * 128;
                    const int li8 = lane & 7, li16 = lane & 15; float f[8];
                    {
                        unpack8(*(const u32x4v*)(pr + 1024 + 8 * lane), f);
                        if (lat) rope8<2>(f, (li8 & 2) == 0, (li8 < 4 ? trow : tcol) + 8 * (li8 & 1));
                        *(u32x4v*)(ka + (size_t)(lane >> 4) * SPB * 128 + 8 * (lane & 15)) = pack8(f); }
                    {
                        const int lk = lane & 31;
                        unpack8(*(const u32x4v*)(pr + 3072 + 8 * lk), f);
                        float ss = 0.f;
#pragma unroll
                        for (int e = 0; e < 8; ++e) ss += f[e] * f[e];
                        ss += __shfl_xor(ss, 1); ss += __shfl_xor(ss, 2); ss += __shfl_xor(ss, 4); ss += __shfl_xor(ss, 8);
                        const float rstd = 1.f / sqrtf(ss * (1.f / 128.f) + EPS);
#pragma unroll
                        for (int e = 0; e < 8; ++e) f[e] = f[e] * rstd * kg[8 * li16 + e];
                        if (lat) rope8<4>(f, (li16 & 4) == 0, (li16 < 8 ? trow : tcol) + 16 + 8 * (li16 & 3));
                        if (lane < 32) *(u32x4v*)(ka + (size_t)(4 + (lk >> 4)) * SPB * 128 + 8 * (lk & 15)) = pack8(f); }
                }
            }
            PH_END;
            if (PH_ON) for (int rep = 0; rep < PROBE_REPS(ph); ++rep) { PH_IDS (void)rep;
                unsigned char* const ws = WSP();
                {
                    static_assert(NCH / 17 == 8, "the two-level scan is laid out for 8 segments of 17 chunks");
                    const f32x2v* const APOW = (const f32x2v*)(ws + WS_APOW); const float* const SST = WS_F32(WS_SST); bf16_t* const UG = WS_BF(WS_UG);
                    for (int item = gw; item < NB * S5G * 2 * 8; item += NGW) {
                        const int oct = item & 7, d = (item >> 3) & 1, g = (item >> 4) & 31, b = item >> 9, seg = lane >> 3, p = oct * 8 + (lane & 7);
                        const f32x2v aT = APOW[((size_t)((layer * 2 + d) * S5G + g) * S5P + p) * 65 + TCH];
                        f32x2v sv[17];
#pragma unroll
                        for (int q = 0; q < 17; ++q) { const int idx = seg * 17 + q, c = d == 0 ? idx : (idx < NCC ? NCC - 1 - idx : NCH + NCC - 1 - idx);
                            sv[q] = *(const f32x2v*)(SST + (size_t)(g * RCP + b * NCH + c) * 256 + d * 128 + p * 2); }
                        float lr[17], li[17]; float rr = 0.f, ri_ = 0.f;
#pragma unroll
                        for (int q = 0; q < 17; ++q) { lr[q] = rr; li[q] = ri_; const float nr = aT.x * rr - aT.y * ri_ + sv[q].x, ni = aT.x * ri_ + aT.y * rr + sv[q].y; rr = nr; ri_ = ni; }
                        float ar = 1.f, ai = 0.f;
#pragma unroll
                        for (int q = 0; q < 17; ++q) { const float nr = ar * aT.x - ai * aT.y, ni = ar * aT.y + ai * aT.x; ar = nr; ai = ni; }
                        float cr = 0.f, ci = 0.f;
#pragma unroll
                        for (int sgi = 0; sgi < 7; ++sgi) { const float tr = __shfl(rr, sgi * 8 + (lane & 7)), ti = __shfl(ri_, sgi * 8 + (lane & 7));
                            if (sgi < seg) { const float nr = ar * cr - ai * ci + tr, ni = ar * ci + ai * cr + ti; cr = nr; ci = ni; } }
                        float pr = 1.f, pi = 0.f;
#pragma unroll
                        for (int q = 0; q < 17; ++q) { const int idx = seg * 17 + q, c = d == 0 ? idx : (idx < NCC ? NCC - 1 - idx : NCH + NCC - 1 - idx);
                            const float hr = lr[q] + pr * cr - pi * ci, hi_ = li[q] + pr * ci + pi * cr;
                            *(unsigned*)(UG + (size_t)(g * RCP + b * NCH + c) * KS5 + KU + d * 128 + p * 2) = cvtpk2(hr, hi_);
                            const float nr = pr * aT.x - pi * aT.y, ni = pr * aT.y + pi * aT.x; pr = nr; pi = ni; }
                    }
                }
                const bf16_t* const KA = WS_BF(WS_KA); const bf16_t* const PB = WS_BF(WS_P); const float* const qgf = INP(24) + layer * 128; const float* const ropef = (const float*)(ws + WS_ROPE); const bf16_t* const VA = WS_BF(WS_VA); bf16_t* const OD = WS_BF(WS_OD); bf16_t* const MIX = WS_BF(WS_MIX);
                const int nunits = 1024 + (layer == 0 ? 64 : 0);
                for (int i = 0;; ++i) {
                    const int U = i * G + vcu; if (U >= nunits) break;
                    int b, slot, qrow0, seq;
                    if (U < 1024) { b = U >> 8; slot = ((U >> 4) + 8 * (b & 1)) & 15; qrow0 = b * SPB + CTXL + (U & 15) * 256; seq = SPB; }
                    else { const int U2 = U - 1024; b = U2 >> 4; slot = U2 & 15; qrow0 = b * SPB; seq = CTXL; }
                    const size_t kvoff = ((size_t)(b * 6 + (slot < 8 ? (slot >> 1) : 4 + ((slot - 8) >> 2))) * SPB) * 128;

                    __syncthreads();
                    const int tpos0 = U < 1024 ? (U & 15) * 256 : -1;
                    if (slot < 8)
                        at128::attn_dma_body<4, INC, 128, 128, 1024, 1024>((const at128::bf16*)(PB + (size_t)qrow0 * INC + 512 + slot * 64), (const at128::bf16*)(KA + kvoff),
                            (const at128::bf16*)(VA + kvoff), nullptr, (at128::bf16*)(OD + (size_t)qrow0 * 1024 + slot * 128), seq, (char*)lds, (slot & 1) * 128, nullptr, ropef, tpos0);
                    else
                        at128::attn_dma_body<8, INC, 128, 128, 1024, DM>((const at128::bf16*)(PB + (size_t)qrow0 * INC + 2048 + (slot - 8) * 128), (const at128::bf16*)(KA + kvoff),
                            (const at128::bf16*)(VA + kvoff), nullptr, (at128::bf16*)(MIX + (size_t)qrow0 * DM + 1024 + (slot - 8) * 128), seq, (char*)lds, 0, qgf, ropef, tpos0);
                }
                __syncthreads();
            }
            PH_END;
            if (PH_ON) for (int rep = 0; rep < PROBE_REPS(ph); ++rep) { PH_IDS (void)rep;
                unsigned char* const ws = WSP();
                {   pg8::Gemm g{WS_BF(WS_UG), WS_BF(WS_TZE) + (size_t)layer * S5G * KU * KS5, S5G * RCP, S5G * KU, KS5, KS5, KS5}; pg8::S5OutOrder S{G, bx};
                    pg8::EpiS5Out E{WS_BF(WS_UG), INP(19) + layer * 512, WS_BF(WS_YG)};
                    pg8::gemm_phase<pg8::EpiS5Out, pg8::S5OutOrder, true, true>(ldsl, g, S, E); }
                const float* lv = INP(22) + layer * 256; const bf16_t* const OD = WS_BF(WS_OD); bf16_t* const MIX = WS_BF(WS_MIX); const float lam_init = layer == 0 ? 0.2f : 0.35550906759f;
                const float lam = expf(wave_sum(lv[lane] * lv[64 + lane])) - expf(wave_sum(lv[128 + lane] * lv[192 + lane])) + lam_init;
                const float* sg = INP(23) + layer * 128; const int li16 = lane & 15, hh = lane >> 4;
                for (int r = gw; r < R; r += NGW) {
                    if (layer == 1 && (r % SPB) < CTXL) continue;
                    const bf16_t* o1 = OD + (size_t)r * 1024 + (2 * hh) * 128 + 8 * li16;
                    float f[8], f2[8]; unpack8(*(const u32x4v*)o1, f); unpack8(*(const u32x4v*)(o1 + 128), f2);
#pragma unroll
                    for (int e = 0; e < 8; ++e) f[e] -= lam * f2[e];
                    float ss = 0.f;
#pragma unroll
                    for (int e = 0; e < 8; ++e) ss += f[e] * f[e];
                    ss += __shfl_xor(ss, 1); ss += __shfl_xor(ss, 2); ss += __shfl_xor(ss, 4); ss += __shfl_xor(ss, 8);
                    const float rstd = (1.f - lam_init) / sqrtf(ss * (1.f / 128.f) + EPS);
#pragma unroll
                    for (int e = 0; e < 8; ++e) f[e] = f[e] * rstd * sg[8 * li16 + e];
                    *(u32x4v*)(MIX + (size_t)r * DM + 512 + hh * 128 + 8 * li16) = pack8(f);
                }
            }
            PH_END;
            if (PH_ON) for (int rep = 0; rep < PROBE_REPS(ph); ++rep) { PH_IDS (void)rep;
                unsigned char* const ws = WSP();
                pg8::Gemm g{WS_BF(WS_YG), WS_BF(WS_GLU) + (size_t)layer * 512 * 512, R, 512, 512, 512, 512}; pg8::StaticOrder S; S.init(R, 512, G, bx);
                pg8::EpiGLU E{WS_BF(WS_YG), INP(21) + layer * 512, WS_BF(WS_MIX)};
                pg8::gemm_phase<pg8::EpiGLU, pg8::StaticOrder, true, true>(ldsl, g, S, E);
            }
            PH_END;
            if (PH_ON) for (int rep = 0; rep < PROBE_REPS(ph); ++rep) { PH_IDS (void)rep;
                unsigned char* const ws = WSP(); const float* const modl = WS_F32(WS_MODV) + (size_t)layer * 5 * MODW;
                if (layer == 0) {
                    pg8::Gemm g{WS_BF(WS_MIX), WS_BF(WS_WOUT), R, DM, DM / 4, DM, DM}; pg8::CtxSplitOrder S{G, bx, (DM / 4) * 2};
                    pg8::EpiPart E{WS_F32(WS_PART)};
                    pg8::gemm_phase<pg8::EpiPart, pg8::CtxSplitOrder, true, true>(ldsl, g, S, E); }
                pg8::Gemm g{WS_BF(WS_MIX), WS_BF(WS_WOUT) + (size_t)layer * DM * DM, R, DM, DM, DM, DM}; pg8::FlexOrder S; S.init(true, DM, G, bx);
                pg8::EpiResid E{WS_F32(WS_XS), modl + (size_t)5 * DM, rep ? 0.f : 1.0f};
                pg8::gemm_phase<pg8::EpiResid, pg8::FlexOrder, true, true>(ldsl, g, S, E);
            }
            PH_END;
        }
    }
    if (PH_ON) for (int rep = 0; rep < PROBE_REPS(ph); ++rep) { PH_IDS (void)rep;
        unsigned char* const ws = WSP(); const float* fg = INP(26); const float* const XS = WS_F32(WS_XS); float* const outp = (float*)ldptr(ldsl, 27);
        for (int q0 = gw; q0 < NB * SEQL; q0 += 2 * NGW) {
            f32x4 v[2][8]; int qq[2];
#pragma unroll
            for (int u = 0; u < 2; ++u) { const int q = q0 + u * NGW < NB * SEQL ? q0 + u * NGW : q0; qq[u] = q; const int b = q / SEQL, t = q % SEQL; const f32x4* xr = (const f32x4*)(XS + (size_t)(b * SPB + CTXL + t) * DM) + lane;
#pragma unroll
                for (int j = 0; j < 8; ++j) v[u][j] = xr[64 * j]; }
#pragma unroll
            for (int u = 0; u < 2; ++u) { if (u == 1 && qq[1] == q0) continue;
                float ss = 0.f;
#pragma unroll
                for (int j = 0; j < 8; ++j) ss += (v[u][j].x * v[u][j].x + v[u][j].y * v[u][j].y) + (v[u][j].z * v[u][j].z + v[u][j].w * v[u][j].w);
                const float rstd = 1.f / sqrtf(wave_sum(ss) * (1.f / DM) + EPS);
                f32x4* orow = (f32x4*)(outp + (size_t)qq[u] * DM) + lane;
#pragma unroll
                for (int j = 0; j < 8; ++j) orow[64 * j] = v[u][j] * rstd * *(const f32x4*)(fg + 4 * (lane + 64 * j)); }
        }
    }
#undef PH_ON
#undef PH_END
}

extern "C" void kernel_launch(void* const* d_in, const int* in_sizes, int n_in, void* d_out, int out_size, void* d_ws, size_t ws_size, hipStream_t stream) {
    static int grid = 0;
    if (grid == 0) {
        if (n_in != 27 || in_sizes[0] != NB * SEQL * DM || out_size != NB * SEQL * DM || ws_size < WS_END) {
            fprintf(stderr, "kernel_launch: shape mismatch: n_in %d in0 %d out %d ws %zu (need %zu)\n", n_in, n_in > 0 ? in_sizes[0] : -1, out_size, ws_size, (size_t)WS_END); grid = -1; return; }
        int dev = 0, cus = 0, per_cu = 0;
        if (hipGetDevice(&dev) != hipSuccess || hipDeviceGetAttribute(&cus, hipDeviceAttributeMultiprocessorCount, dev) != hipSuccess) { fprintf(stderr, "kernel_launch: device query failed\n"); grid = -1; return; }
        if (hipFuncSetAttribute((const void*)mega_fwd, hipFuncAttributeMaxDynamicSharedMemorySize, LDS_BYTES) != hipSuccess) { fprintf(stderr, "kernel_launch: hipFuncSetAttribute failed\n"); grid = -1; return; }
        if (hipOccupancyMaxActiveBlocksPerMultiprocessor(&per_cu, (const void*)mega_fwd, NWAVES * 64, LDS_BYTES) != hipSuccess || per_cu < 1)
            fprintf(stderr, "kernel_launch: note: occupancy query reports %d workgroups per CU\n", per_cu);
        (void)hipGetLastError();
        grid = cus;
    }
    if (grid < 0) return;
    if (hipMemsetAsync((char*)d_ws + WS_CTL, 0, CTL_ZERO_BYTES, stream) != hipSuccess) { fprintf(stderr, "kernel_launch: memset failed\n"); return; }
    Args a{};
    for (int i = 0; i < 27; ++i) a.in[i] = (const float*)d_in[i];
    a.out = (float*)d_out; a.ws = (unsigned char*)d_ws;
#if MK_N_LAUNCHES == 1
    a.ph_lo = 0; a.ph_hi = NPH;
    hipLaunchKernelGGL(mega_fwd, dim3(grid), dim3(NWAVES * 64), LDS_BYTES, stream, a);
#else
    for (int k = 0; k < NPH; ++k) { a.ph_lo = k; a.ph_hi = k + 1; hipLaunchKernelGGL(mega_fwd, dim3(grid), dim3(NWAVES * 64), LDS_BYTES, stream, a); }
#endif
    const hipError_t le = hipPeekAtLastError();
    if (le != hipSuccess) fprintf(stderr, "kernel_launch: launch failed: %s\n", hipGetErrorName(le));
}
```

```cpp
#include <hip/hip_runtime.h>
#include <hip/hip_bf16.h>
#include <cstdio>
#include <cstdint>
#include <cmath>
namespace pg8 {
#define PG8_LAS __attribute__((address_space(3)))
typedef unsigned short bf16_t;
typedef short bf16x8 __attribute__((ext_vector_type(8)));
typedef float f32x4 __attribute__((ext_vector_type(4)));
typedef unsigned u32x4 __attribute__((ext_vector_type(4)));
constexpr int BM = 256, BK = 64, HALF = 128, HTB = HALF * BK * 2  , STAGE_BYTES = 8 * HTB, NXCD = 8, WGM = 8;

__host__ __device__ __forceinline__ int lds_byte(int r, int c) { const int st = (r >> 4) * 2 + (c >> 5), rr = r & 15, cc = c & 31, ob = rr * 64 + cc * 2; return st * 1024 + (ob ^ (((ob >> 9) & 1) << 5)); }
__host__ __device__ __forceinline__ void stage_rc(int b, int& R, int& C) { const int st = b / 1024, sb = b % 1024, swz = sb ^ (((sb >> 9) & 1) << 5); R = (st >> 1) * 16 + swz / 64; C = (st & 1) * 32 + (swz % 64) / 2; }
__host__ __device__ __forceinline__ int perm32(int rho) { const int n = rho >> 4, i = rho & 15; return 8 * (i >> 2) + 4 * n + (i & 3); }

struct Unit { int pm, pn, kofs, ks; };
struct Gemm { const bf16_t* A; const bf16_t* Bt; int M, N, K, lda, ldb; };

struct StaticOrder {
    int nM, nN, nwg, G, c, wgm = WGM;
    __host__ __device__ void init(int M, int N, int G_, int c_) { nM = M / BM; nN = N / BM; nwg = nM * nN; G = G_; c = c_; }
    __host__ __device__ bool next(int i, Unit& u) const {
        const long L = (long)i * G + c; if (L >= nwg) return false;
        int wgid = (int)L; { const int q = nwg / NXCD, r = nwg % NXCD, xcd = wgid % NXCD, off = wgid / NXCD; wgid = (xcd < r ? xcd * (q + 1) : r * (q + 1) + (xcd - r) * q) + off; }
        const int nig = wgm * nN, gid = wgid / nig, fm = gid * wgm, gsz = (nM - fm) < wgm ? (nM - fm) : wgm;
        u.pm = fm + ((wgid % nig) % gsz); u.pn = (wgid % nig) / gsz; u.kofs = 0; u.ks = 0; return true;
    }
    __device__ __forceinline__ void a_ready(const Unit&) const {}
    __device__ __forceinline__ void done(const Unit&) const {}
};

__device__ __forceinline__ unsigned cvt_pk_bf16(float lo, float hi) { unsigned r; asm volatile("v_cvt_pk_bf16_f32 %0, %1, %2" : "=v"(r) : "v"(lo), "v"(hi)); return r; }
typedef float f32x2 __attribute__((ext_vector_type(2)));
__device__ __forceinline__ f32x2 gelu_pk(f32x2 v) {
    const f32x2 av = __builtin_elementwise_abs(v), d = av * 0.2316418882f + 1.0f;
    f32x2 t; t.x = __builtin_amdgcn_rcpf(d.x); t.y = __builtin_amdgcn_rcpf(d.y);
    f32x2 q = t * 0.5307027145f + (-0.7265760135f); q = q * t + 0.7107068705f; q = q * t + (-0.142248368f); q = q * t + 0.127414796f; q = q * t;
    const f32x2 s = (v * v) * (-0.72134752044f);
    f32x2 e; e.x = __builtin_amdgcn_exp2f(s.x); e.y = __builtin_amdgcn_exp2f(s.y);
    const f32x2 m = v * (q * e), r = v - m;
    f32x2 o; o.x = v.x < 0.f ? m.x : r.x; o.y = v.y < 0.f ? m.y : r.y; return o;
}

template <int ACT  > struct EpiBf16 {
    static constexpr bool PERM = true, AFTER_DRAIN = false; static_assert(ACT == 0 || ACT == 1, "EpiBf16: ACT is 0 (none) or 1 (gelu_pk)");
    bf16_t* O; int ldc; const float* bias; int split_cols; size_t split_stride; float scale0;
    __device__ __forceinline__ void operator()(const f32x4 (&acc)[2][2][4][2], const Unit& u, int wr, int wc, int fr, int fq) const {
        const int row0 = u.pm * BM + wr * 64 + fr; int colt = u.pn * BM; bf16_t* base = O;
        float sc = 1.f; if (split_cols) { const int t = colt / split_cols; base += (size_t)t * split_stride; colt -= t * split_cols; if (t == 0) sc = scale0; }
        const int col0 = colt + wc * 32 + 8 * fq, bcol0 = u.pn * BM + wc * 32 + 8 * fq;
        f32x4 bv[2][2];
#pragma unroll
        for (int bj = 0; bj < 2; ++bj)
#pragma unroll
            for (int n = 0; n < 2; ++n) bv[bj][n] = bias ? *(const f32x4*)(bias + bcol0 + bj * HALF + 4 * n) : (f32x4){0.f, 0.f, 0.f, 0.f};
#pragma unroll
        for (int ai = 0; ai < 2; ++ai)
#pragma unroll
            for (int m = 0; m < 4; ++m) { bf16_t* rowp = base + (size_t)(row0 + ai * HALF + m * 16) * ldc + col0;
#pragma unroll
                for (int bj = 0; bj < 2; ++bj) { f32x4 v0 = acc[ai][bj][m][0] + bv[bj][0], v1 = acc[ai][bj][m][1] + bv[bj][1];
                    if (ACT == 1) { f32x2 a = gelu_pk((f32x2){v0[0], v0[1]}), b = gelu_pk((f32x2){v0[2], v0[3]}), c = gelu_pk((f32x2){v1[0], v1[1]}), d = gelu_pk((f32x2){v1[2], v1[3]});
                        v0 = (f32x4){a.x, a.y, b.x, b.y}; v1 = (f32x4){c.x, c.y, d.x, d.y}; }
                    v0 = v0 * sc; v1 = v1 * sc; u32x4 w; w.x = cvt_pk_bf16(v0[0], v0[1]); w.y = cvt_pk_bf16(v0[2], v0[3]); w.z = cvt_pk_bf16(v1[0], v1[1]); w.w = cvt_pk_bf16(v1[2], v1[3]);
                    *(u32x4*)(rowp + bj * HALF) = w; } }
    }
};


template <class Epi, class Sched, bool ALIGN_EPI = false, bool SP2 = false>
__device__ __forceinline__ void gemm_phase(PG8_LAS unsigned char* lds, const Gemm g, const Sched& S, const Epi& E) {
    int tid_l = threadIdx.x; asm volatile("" : "+v"(tid_l));
    const int tid = tid_l, wid = __builtin_amdgcn_readfirstlane(tid >> 6), lane = tid & 63, wr = wid >> 2, wc = wid & 3, fr = lane & 15, fq = lane >> 4;
    const int K = g.K, nt = K / BK;
    unsigned voffA[2], voffB[2];
#pragma unroll
    for (int i = 0; i < 2; ++i) { int R, C; stage_rc(tid * 16 + i * 8192, R, C); const int Rb = Epi::PERM ? ((R & ~31) + perm32(R & 31)) : R;
        voffA[i] = (unsigned)(R * g.lda + C) * 2u; voffB[i] = (unsigned)(Rb * g.ldb + C) * 2u; }
    const size_t kstep = (size_t)(BK * 2);
    const size_t hstepA = (size_t)HALF * g.lda * 2, hstepB = (size_t)HALF * g.ldb * 2;
    const size_t tstepA = 2 * hstepA, tstepB = 2 * hstepB;
    const unsigned ldsw = (unsigned)wid * 1024u;
    const int aoff = lds_byte(wr * 64 + fr, fq * 8), boff = lds_byte(wc * 32 + fr, fq * 8);
#define PG8_SA(b, h) (((b) * 2 + (h)) * HTB)
#define PG8_SB(b, h) ((4 + (b) * 2 + (h)) * HTB)
#define PG8_STAGE(bufoff, gbase, voff) do { _Pragma("unroll") for (int _i = 0; _i < 2; ++_i) \
        __builtin_amdgcn_global_load_lds((const unsigned*)((const char*)(gbase) + (voff)[_i]), (PG8_LAS unsigned*)(lds + (bufoff) + ldsw + _i * 8192), 16, 0, 0); } while (0)
#define PG8_LDA(dst, b, h) do { _Pragma("unroll") for (int m = 0; m < 4; ++m) _Pragma("unroll") for (int k = 0; k < 2; ++k) dst[m][k] = *(const PG8_LAS bf16x8*)(lds + PG8_SA(b, h) + aoff + m * 2048 + k * 1024); } while (0)
#define PG8_LDB(dst, b, h) do { _Pragma("unroll") for (int n = 0; n < 2; ++n) _Pragma("unroll") for (int k = 0; k < 2; ++k) dst[n][k] = *(const PG8_LAS bf16x8*)(lds + PG8_SB(b, h) + boff + n * 2048 + k * 1024); } while (0)
#define PG8_MMA(ai, bj, At, Bt) do { __builtin_amdgcn_s_setprio(1); _Pragma("unroll") for (int m = 0; m < 4; ++m) _Pragma("unroll") for (int n = 0; n < 2; ++n) _Pragma("unroll") for (int k = 0; k < 2; ++k) \
        acc[ai][bj][m][n] = __builtin_amdgcn_mfma_f32_16x16x32_bf16(Bt[n][k], At[m][k], acc[ai][bj][m][n], 0, 0, 0); __builtin_amdgcn_s_setprio(0); } while (0)
#define PG8_WAIT_V(n) asm volatile("s_waitcnt vmcnt(" #n ")" ::: "memory")
#define PG8_WAIT_L(n) asm volatile("s_waitcnt lgkmcnt(" #n ")" ::: "memory")
#define PG8_BAR __builtin_amdgcn_s_barrier()
#define PG8_SCHED __builtin_amdgcn_sched_barrier(0)
    Unit cur, nxt; int ui = 0;
    if (!S.next(0, cur)) return;
    f32x4 acc[2][2][4][2];
#pragma unroll
    for (int a = 0; a < 2; ++a)
#pragma unroll
        for (int b = 0; b < 2; ++b)
#pragma unroll
            for (int m = 0; m < 4; ++m)
#pragma unroll
                for (int n = 0; n < 2; ++n) acc[a][b][m][n] = (f32x4){0.f, 0.f, 0.f, 0.f};
    bf16x8 At[4][2], B0[2][2], B1[2][2];
    const char* cA = (const char*)g.A + (size_t)cur.pm * tstepA + cur.kofs; const char* cB = (const char*)g.Bt + (size_t)cur.pn * tstepB + cur.kofs;
    S.a_ready(cur);
    if constexpr (SP2) {
        PG8_STAGE(PG8_SB(0, 0), cB, voffB); PG8_STAGE(PG8_SB(0, 1), cB + hstepB, voffB); PG8_STAGE(PG8_SA(0, 0), cA, voffA); PG8_STAGE(PG8_SA(0, 1), cA + hstepA, voffA);
        if (wr == 1) PG8_BAR;
        PG8_WAIT_V(2); PG8_BAR;
        PG8_STAGE(PG8_SB(1, 0), cB + kstep, voffB); PG8_STAGE(PG8_SA(1, 0), cA + kstep, voffA); PG8_STAGE(PG8_SB(1, 1), cB + hstepB + kstep, voffB);
        PG8_WAIT_V(6); PG8_BAR;
    } else {
        PG8_STAGE(PG8_SB(0, 0), cB, voffB); PG8_STAGE(PG8_SA(0, 0), cA, voffA); PG8_STAGE(PG8_SB(0, 1), cB + hstepB, voffB); PG8_STAGE(PG8_SA(0, 1), cA + hstepA, voffA);
        if (wr == 1) PG8_BAR;
        PG8_WAIT_V(4); PG8_BAR;
        PG8_STAGE(PG8_SB(1, 0), cB + kstep, voffB); PG8_STAGE(PG8_SA(1, 0), cA + kstep, voffA); PG8_STAGE(PG8_SB(1, 1), cB + hstepB + kstep, voffB);
        PG8_WAIT_V(6); PG8_BAR;
    }
    for (;;) {
        const bool has_next = S.next(ui + 1, nxt);
        const char* nA = has_next ? (const char*)g.A + (size_t)nxt.pm * tstepA + nxt.kofs : cA; const char* nB = has_next ? (const char*)g.Bt + (size_t)nxt.pn * tstepB + nxt.kofs : cB;
        for (int t = 0; t < nt; t += 2) {
            const bool last = (t == nt - 2);
            const char* a1 = cA + (size_t)(t + 1) * kstep;
            const char* a2 = last ? nA : cA + (size_t)(t + 2) * kstep; const char* b2 = last ? nB : cB + (size_t)(t + 2) * kstep;
            const char* a3 = a2 + kstep; const char* b3 = b2 + kstep;
            if (last && has_next) S.a_ready(nxt);
            if constexpr (SP2) {
            PG8_LDB(B0, 0, 0); PG8_LDB(B1, 0, 1); PG8_SCHED; PG8_LDA(At, 0, 0); PG8_STAGE(PG8_SA(1, 1), a1 + hstepA, voffA);
            PG8_WAIT_V(8); PG8_WAIT_L(0); PG8_BAR; PG8_MMA(0, 0, At, B0); PG8_MMA(0, 1, At, B1); PG8_BAR; PG8_SCHED;
            PG8_LDA(At, 0, 1); PG8_STAGE(PG8_SB(0, 0), b2, voffB); PG8_STAGE(PG8_SB(0, 1), b2 + hstepB, voffB); PG8_STAGE(PG8_SA(0, 0), a2, voffA);
            PG8_WAIT_V(8); PG8_WAIT_L(0); PG8_BAR; PG8_MMA(1, 0, At, B0); PG8_MMA(1, 1, At, B1); PG8_BAR; PG8_SCHED;
            PG8_LDB(B0, 1, 0); PG8_LDB(B1, 1, 1); PG8_SCHED; PG8_LDA(At, 1, 0); PG8_STAGE(PG8_SA(0, 1), a2 + hstepA, voffA);
            PG8_WAIT_V(8); PG8_WAIT_L(0); PG8_BAR; PG8_MMA(0, 0, At, B0); PG8_MMA(0, 1, At, B1); PG8_BAR; PG8_SCHED;
            PG8_LDA(At, 1, 1); PG8_STAGE(PG8_SB(1, 0), b3, voffB); PG8_STAGE(PG8_SB(1, 1), b3 + hstepB, voffB); PG8_STAGE(PG8_SA(1, 0), a3, voffA);
            PG8_WAIT_V(8); PG8_WAIT_L(0); PG8_BAR; PG8_MMA(1, 0, At, B0); PG8_MMA(1, 1, At, B1); PG8_BAR; PG8_SCHED;
            } else {
            PG8_LDB(B0, 0, 0); PG8_SCHED; PG8_LDA(At, 0, 0); PG8_STAGE(PG8_SA(1, 1), a1 + hstepA, voffA);
            PG8_WAIT_L(8); PG8_BAR; PG8_WAIT_L(0); PG8_MMA(0, 0, At, B0); PG8_BAR; PG8_SCHED;
            PG8_LDB(B1, 0, 1); PG8_STAGE(PG8_SB(0, 0), b2, voffB);
            PG8_BAR; PG8_WAIT_L(0); PG8_MMA(0, 1, At, B1); PG8_BAR;
            PG8_LDA(At, 0, 1); PG8_STAGE(PG8_SA(0, 0), a2, voffA);
            PG8_BAR; PG8_WAIT_L(0); PG8_MMA(1, 0, At, B0); PG8_BAR; PG8_SCHED;
            PG8_STAGE(PG8_SB(0, 1), b2 + hstepB, voffB);
            PG8_WAIT_V(6); PG8_BAR; PG8_MMA(1, 1, At, B1); PG8_BAR;
            PG8_LDB(B0, 1, 0); PG8_SCHED; PG8_LDA(At, 1, 0); PG8_STAGE(PG8_SA(0, 1), a2 + hstepA, voffA);
            PG8_WAIT_L(8); PG8_BAR; PG8_WAIT_L(0); PG8_MMA(0, 0, At, B0); PG8_BAR; PG8_SCHED;
            PG8_LDB(B1, 1, 1); PG8_STAGE(PG8_SB(1, 0), b3, voffB);
            PG8_BAR; PG8_WAIT_L(0); PG8_MMA(0, 1, At, B1); PG8_BAR;
            PG8_LDA(At, 1, 1); PG8_STAGE(PG8_SA(1, 0), a3, voffA);
            PG8_BAR; PG8_WAIT_L(0); PG8_MMA(1, 0, At, B0); PG8_BAR; PG8_SCHED;
            PG8_STAGE(PG8_SB(1, 1), b3 + hstepB, voffB);
            PG8_WAIT_V(6); PG8_BAR; PG8_MMA(1, 1, At, B1); PG8_BAR;
            }
        }
        if constexpr (ALIGN_EPI) { if (wr == 0) PG8_BAR; }
        if constexpr (!Epi::AFTER_DRAIN) { E(acc, cur, wr, wc, fr, fq); S.done(cur); }
        if (!has_next) break;
#pragma unroll
        for (int a = 0; a < 2; ++a)
#pragma unroll
            for (int b = 0; b < 2; ++b)
#pragma unroll
                for (int m = 0; m < 4; ++m)
#pragma unroll
                    for (int n = 0; n < 2; ++n) acc[a][b][m][n] = (f32x4){0.f, 0.f, 0.f, 0.f};
        cur = nxt; cA = nA; cB = nB; ++ui;
        if constexpr (ALIGN_EPI) { if (wr == 1) PG8_BAR; }
    }
    PG8_WAIT_V(0);
    if constexpr (!ALIGN_EPI) { if (wr == 0) PG8_BAR; }
    PG8_BAR;
    if constexpr (Epi::AFTER_DRAIN) { E.fused(acc, cur, wr, wc, fr, fq, lds, wid, lane); S.done(cur); }
#undef PG8_SA
#undef PG8_SB
#undef PG8_STAGE
#undef PG8_LDA
#undef PG8_LDB
#undef PG8_MMA
#undef PG8_WAIT_V
#undef PG8_WAIT_L
#undef PG8_BAR
#undef PG8_SCHED
}
}

namespace at128 {
using bf16 = __hip_bfloat16;
constexpr int D = 128, NW = 8, QBLK = 32, KVBLK = 64, SDEPTH = 2;
constexpr float SCALE = 0.088388347648318440f, THR = 8.f;
constexpr size_t SHM_V = KVBLK * D * 2, SHM_K = KVBLK * D * 2, SHM_ATTN = 2 * SHM_V + 2 * SHM_K + NW * 64 * 4;
constexpr int DMA_SCRATCH_OFF = 131072 + 4096;
using bf16x8 = __attribute__((ext_vector_type(8))) short;
using s16x4  = __attribute__((ext_vector_type(4))) short;
using f32x16 = __attribute__((ext_vector_type(16))) float;
using f32x8  = __attribute__((ext_vector_type(8))) float;
using u32x4  = __attribute__((ext_vector_type(4))) unsigned;
#define KSWZ(row, colB) ((row) * 256 + ((colB) ^ (((row) & 7) << 4)))
#define SBAR() __builtin_amdgcn_sched_barrier(0)
__device__ __forceinline__ int crow(int r, int hi) { return (r & 3) + 8 * (r >> 2) + 4 * hi; }
__device__ __forceinline__ unsigned cvtpk(float lo, float hi) {
  unsigned r; asm volatile("v_cvt_pk_bf16_f32 %0, %1, %2" : "=v"(r) : "v"(lo), "v"(hi)); return r;
}
template <typename TIn> struct Stage;
template <> struct Stage<bf16>  { using T = bf16x8;
  __device__ static __forceinline__ T ld8(const bf16* p) { return *reinterpret_cast<const bf16x8*>(p); }
  __device__ static __forceinline__ bf16x8 tobf(T x) { return x; } };
template <> struct Stage<float> { using T = f32x8;
  __device__ static __forceinline__ T ld8(const float* p) { return *reinterpret_cast<const f32x8*>(p); }
  __device__ static __forceinline__ bf16x8 tobf(T x) {
    u32x4 w = {cvtpk(x[0], x[1]), cvtpk(x[2], x[3]), cvtpk(x[4], x[5]), cvtpk(x[6], x[7])}; return *reinterpret_cast<bf16x8*>(&w); } };

__device__ __forceinline__ void partialSM(f32x16& p0, f32x16& p1, float& m_reg, float& mn, float& alpha) {
  constexpr float C = SCALE * 1.4426950408889634f;
  float pmax = p0[0]; for (int r = 1; r < 16; ++r) pmax = fmaxf(pmax, p0[r]); for (int r = 0; r < 16; ++r) pmax = fmaxf(pmax, p1[r]);
  { auto rr = __builtin_amdgcn_permlane32_swap(__float_as_uint(pmax), __float_as_uint(pmax), false, false);
    pmax = fmaxf(__uint_as_float(rr[0]), __uint_as_float(rr[1])); }
  if (__builtin_expect(__all(pmax - m_reg <= THR / SCALE), 1)) { mn = m_reg; alpha = 1.f; }
  else { mn = fmaxf(m_reg, pmax); alpha = __builtin_amdgcn_exp2f((m_reg - mn) * C); m_reg = mn; }
  float mnC = -mn * C;
  for (int r = 0; r < 16; ++r) p0[r] = fmaf(p0[r], C, mnC); for (int r = 0; r < 16; ++r) p1[r] = fmaf(p1[r], C, mnC);
  for (int r = 0; r < 16; ++r) p0[r] = __builtin_amdgcn_exp2f(p0[r]);
}
__device__ __forceinline__ void finishSM(f32x16& p0, f32x16& p1, float alpha, float& l_reg, bf16x8& pa0, bf16x8& pa1, bf16x8& pa2, bf16x8& pa3) {
  for (int r = 0; r < 16; ++r) p1[r] = __builtin_amdgcn_exp2f(p1[r]);
  float ps = 0; for (int r = 0; r < 16; ++r) ps += p0[r]; for (int r = 0; r < 16; ++r) ps += p1[r];
  { auto rr = __builtin_amdgcn_permlane32_swap(__float_as_uint(ps), __float_as_uint(ps), false, false);
    ps = __uint_as_float(rr[0]) + __uint_as_float(rr[1]); }
  l_reg = l_reg * alpha + ps;
#define PK4(P, BASE, OUT) do { unsigned a0 = cvtpk(P[BASE + 0], P[BASE + 1]), a1 = cvtpk(P[BASE + 2], P[BASE + 3]);   \
    unsigned b0 = cvtpk(P[BASE + 4], P[BASE + 5]), b1 = cvtpk(P[BASE + 6], P[BASE + 7]);                              \
    auto r0 = __builtin_amdgcn_permlane32_swap(a0, b0, false, false); auto r1 = __builtin_amdgcn_permlane32_swap(a1, b1, false, false); \
    u32x4 w = {r0[0], r1[0], r0[1], r1[1]}; OUT = *reinterpret_cast<bf16x8*>(&w); } while (0)
  PK4(p0, 0, pa0); PK4(p0, 8, pa1); PK4(p1, 0, pa2); PK4(p1, 8, pa3);
#undef PK4
}
template <int ND> __device__ __forceinline__ void qkt(f32x16& p0, f32x16& p1, const bf16* Ks, const bf16x8* qr, int r32, int hi, int kcb) {
  p0 = f32x16{}; p1 = f32x16{};
  const char* Kb = (const char*)Ks + kcb;
#pragma unroll
  for (int d0 = 0; d0 < ND; ++d0) { int cb = (d0 * 16 + hi * 8) * 2;
    bf16x8 b0 = *reinterpret_cast<const bf16x8*>(Kb + KSWZ(r32, cb));
    bf16x8 b1 = *reinterpret_cast<const bf16x8*>(Kb + KSWZ(32 + r32, cb));
    p0 = __builtin_amdgcn_mfma_f32_32x32x16_bf16(b0, qr[d0], p0, 0, 0, 0);
    p1 = __builtin_amdgcn_mfma_f32_32x32x16_bf16(b1, qr[d0], p1, 0, 0, 0); }
}
__device__ __forceinline__ int v_st(int k, int c) { const int kk = (k & ~0xC) | ((k & 4) << 1) | ((k & 8) >> 1); return ((kk >> 3) * 4 + (c >> 5)) * 512 + ((kk & 7) * 32 + (c & 31)) * 2; }
__device__ __forceinline__ int v_rd_base(int lane) { return ((lane & 3) << 3) | (((lane >> 2) & 3) << 6) | (((lane >> 4) & 1) << 5) | (((lane >> 5) & 1) << 8); }
constexpr int v_rd_off(int d0, int ks, int half) { return d0 * 512 + ks * 4096 + half * 2048; }
template <int OFF> __device__ __forceinline__ s16x4 tr_read(int vb) {
  s16x4 r; asm volatile("ds_read_b64_tr_b16 %0, %1 offset:%2" : "=&v"(r) : "v"(vb), "i"(OFF) : "memory"); return r;
}
template <int D0> __device__ __forceinline__ void pv_one(f32x16& od, int vb, bf16x8 pa0, bf16x8 pa1, bf16x8 pa2, bf16x8 pa3) {
  const s16x4 l0 = tr_read<v_rd_off(D0, 0, 0)>(vb), h0 = tr_read<v_rd_off(D0, 0, 1)>(vb), l1 = tr_read<v_rd_off(D0, 1, 0)>(vb), h1 = tr_read<v_rd_off(D0, 1, 1)>(vb);
  const s16x4 l2 = tr_read<v_rd_off(D0, 2, 0)>(vb), h2 = tr_read<v_rd_off(D0, 2, 1)>(vb), l3 = tr_read<v_rd_off(D0, 3, 0)>(vb), h3 = tr_read<v_rd_off(D0, 3, 1)>(vb);
  asm volatile("s_waitcnt lgkmcnt(0)" ::: "memory"); SBAR();
#define PK(L, H) (bf16x8){L[0], L[1], L[2], L[3], H[0], H[1], H[2], H[3]}
  od = __builtin_amdgcn_mfma_f32_32x32x16_bf16(pa0, PK(l0, h0), od, 0, 0, 0);
  od = __builtin_amdgcn_mfma_f32_32x32x16_bf16(pa1, PK(l1, h1), od, 0, 0, 0);
  od = __builtin_amdgcn_mfma_f32_32x32x16_bf16(pa2, PK(l2, h2), od, 0, 0, 0);
  od = __builtin_amdgcn_mfma_f32_32x32x16_bf16(pa3, PK(l3, h3), od, 0, 0, 0);
#undef PK
}
__device__ __forceinline__ void pv_d0(f32x16* o, int vb, bf16x8 pa0, bf16x8 pa1, bf16x8 pa2, bf16x8 pa3) {
  pv_one<0>(o[0], vb, pa0, pa1, pa2, pa3); pv_one<1>(o[1], vb, pa0, pa1, pa2, pa3); pv_one<2>(o[2], vb, pa0, pa1, pa2, pa3); pv_one<3>(o[3], vb, pa0, pa1, pa2, pa3);
}

template <int ND, int LDQ, int LDK, int LDV, int LDOF, int LDOB>
__device__ __forceinline__ void attn_dense_body(const bf16* __restrict__ Qb, const bf16* __restrict__ Kh, const bf16* __restrict__ Vh,
                                                float* __restrict__ Of, bf16* __restrict__ Ob16, int seq, char* lds, int kcb,
                                                const float* __restrict__ qgain, const float* __restrict__ rope, int tpos0) {
  using TQ = bf16; using St = Stage<bf16>; using SQ = Stage<TQ>;
  int tid_l = threadIdx.x; asm volatile("" : "+v"(tid_l));
  const int tid = tid_l, wid = tid >> 6, lane = tid & 63, r32 = lane & 31, hi = lane >> 5;
  bf16* V_lds = (bf16*)lds; bf16* K_lds = (bf16*)(lds + 2 * SHM_V);
  float* ws = (float*)(lds + 2 * SHM_V + 2 * SHM_K) + wid * 64; float* li_l = ws; float* al_l = ws + 32;
  float m_reg = -1e30f, l_reg = 0; f32x16 o[4] = {}; bf16x8 qr[ND];
  const TQ* Qw = Qb + (long)(wid * QBLK + r32) * LDQ + hi * 8;
  {
    float f[ND][8];
#pragma unroll
    for (int d0 = 0; d0 < ND; ++d0) { const u32x4 w = *reinterpret_cast<const u32x4*>(Qw + d0 * 16);
      f[d0][0] = __uint_as_float(w[0] << 16); f[d0][1] = __uint_as_float(w[0] & 0xffff0000u); f[d0][2] = __uint_as_float(w[1] << 16); f[d0][3] = __uint_as_float(w[1] & 0xffff0000u);
      f[d0][4] = __uint_as_float(w[2] << 16); f[d0][5] = __uint_as_float(w[2] & 0xffff0000u); f[d0][6] = __uint_as_float(w[3] << 16); f[d0][7] = __uint_as_float(w[3] & 0xffff0000u); }
    if constexpr (ND == 8) {
      float ss = 0.f;
#pragma unroll
      for (int d0 = 0; d0 < ND; ++d0)
#pragma unroll
        for (int e = 0; e < 8; ++e) ss += f[d0][e] * f[d0][e];
      ss += __shfl_xor(ss, 32);
      const float rstd = 1.f / sqrtf(ss * (1.f / 128.f) + 1e-6f);
#pragma unroll
      for (int d0 = 0; d0 < ND; ++d0) { const float* gp = qgain + d0 * 16 + hi * 8;
#pragma unroll
        for (int e = 0; e < 8; ++e) f[d0][e] = f[d0][e] * rstd * gp[e]; }
    }
    if (tpos0 >= 0) { const int t = tpos0 + wid * QBLK + r32; constexpr int Q4 = ND / 4, TOFF = ND == 8 ? 16 : 0;
#pragma unroll
      for (int hf = 0; hf < 2; ++hf) { const float* tb = rope + (size_t)((hf == 0 ? (t >> 6) : (t & 63)) * 48 + TOFF + hi * 8) * 2;
#pragma unroll
        for (int q = 0; q < Q4; ++q)
#pragma unroll
          for (int e = 0; e < 8; ++e) { const float cs = tb[(q * 16 + e) * 2], sn = tb[(q * 16 + e) * 2 + 1]; const int da = hf * 2 * Q4 + q, db = da + Q4;
            const float x1 = f[da][e], x2 = f[db][e]; f[da][e] = x1 * cs - x2 * sn; f[db][e] = x1 * sn + x2 * cs; } }
    }
    constexpr float QS = ND == 8 ? 1.f : 1.4142135623730951f;
#pragma unroll
    for (int d0 = 0; d0 < ND; ++d0) { u32x4 w = {cvtpk(f[d0][0] * QS, f[d0][1] * QS), cvtpk(f[d0][2] * QS, f[d0][3] * QS), cvtpk(f[d0][4] * QS, f[d0][5] * QS), cvtpk(f[d0][6] * QS, f[d0][7] * QS)};
      qr[d0] = *reinterpret_cast<bf16x8*>(&w); }
  }
  const int sr = tid >> 4, sc = (tid & 15) * 8, vst0 = v_st(sr, sc), vst1 = v_st(32 + sr, sc);
  const int vb0 = (int)(uintptr_t)V_lds + v_rd_base(lane);
  struct { typename St::T vs0, vs1, ks0, ks1; } sr_[SDEPTH];
#define SLOAD(i, k0) do { sr_[i].vs0 = St::ld8(&Vh[(long)((k0) + sr) * LDV + sc]); sr_[i].vs1 = St::ld8(&Vh[(long)((k0) + 32 + sr) * LDV + sc]); \
    sr_[i].ks0 = St::ld8(&Kh[(long)((k0) + sr) * LDK + sc]); sr_[i].ks1 = St::ld8(&Kh[(long)((k0) + 32 + sr) * LDK + sc]); } while (0)
#define SWRITE(b, i) do { *(bf16x8*)((char*)V_lds + (b) * SHM_V + vst0) = St::tobf(sr_[i].vs0);          \
    *(bf16x8*)((char*)V_lds + (b) * SHM_V + vst1) = St::tobf(sr_[i].vs1); int kc = sc * 2;               \
    *(bf16x8*)((char*)K_lds + (b) * SHM_K + KSWZ(sr, kc)) = St::tobf(sr_[i].ks0);                       \
    *(bf16x8*)((char*)K_lds + (b) * SHM_K + KSWZ(32 + sr, kc)) = St::tobf(sr_[i].ks1); } while (0)
#define SWAIT() do { if constexpr (SDEPTH == 2) asm volatile("s_waitcnt vmcnt(4)" ::: "memory"); else asm volatile("s_waitcnt vmcnt(0)" ::: "memory"); } while (0)
#define RESC(a) do { if (__any((a) < 1.f)) { if (hi == 0) al_l[r32] = (a); asm volatile("s_waitcnt lgkmcnt(0)" ::: "memory"); \
    for (int d = 0; d < 4; ++d) for (int r = 0; r < 16; ++r) o[d][r] *= al_l[crow(r, hi)]; } } while (0)
  f32x16 pA0, pA1, pB0, pB1; float mnA, mnB, alA, alB; bf16x8 pa0, pa1, pa2, pa3; const int NT = seq / KVBLK;
  constexpr int SE = 0, SO = SDEPTH - 1;
  SLOAD(SE, 0); asm volatile("s_waitcnt vmcnt(0)" ::: "memory"); SWRITE(0, SE); __syncthreads();
  qkt<ND>(pA0, pA1, K_lds, qr, r32, hi, kcb); partialSM(pA0, pA1, m_reg, mnA, alA);
  SLOAD(SO, KVBLK); if constexpr (SDEPTH == 2) { if (2 < NT) SLOAD(SE, 2 * KVBLK); }
  SWAIT(); SWRITE(1, SO); __syncthreads();
  for (int j = 1; j + 1 < NT; j += 2) {
    SBAR(); qkt<ND>(pB0, pB1, (bf16*)((char*)K_lds + SHM_K), qr, r32, hi, kcb);
    finishSM(pA0, pA1, alA, l_reg, pa0, pa1, pa2, pa3); SBAR();
    SLOAD(SO, (j + SDEPTH) * KVBLK); SBAR();
    pv_d0(o, vb0, pa0, pa1, pa2, pa3); partialSM(pB0, pB1, m_reg, mnB, alB);
    __syncthreads(); SWAIT(); SWRITE(0, SE);
    RESC(alB); __syncthreads();
    SBAR(); qkt<ND>(pA0, pA1, K_lds, qr, r32, hi, kcb);
    finishSM(pB0, pB1, alB, l_reg, pa0, pa1, pa2, pa3); SBAR();
    if (SDEPTH == 1 || j + 3 < NT) SLOAD(SE, (j + 1 + SDEPTH) * KVBLK); SBAR();
    pv_d0(o, vb0 + (int)SHM_V, pa0, pa1, pa2, pa3); partialSM(pA0, pA1, m_reg, mnA, alA);
    __syncthreads(); SWAIT(); SWRITE(1, SO);
    RESC(alA); __syncthreads();
  }
  SBAR(); qkt<ND>(pB0, pB1, (bf16*)((char*)K_lds + SHM_K), qr, r32, hi, kcb);
  finishSM(pA0, pA1, alA, l_reg, pa0, pa1, pa2, pa3); SBAR();
  pv_d0(o, vb0, pa0, pa1, pa2, pa3); partialSM(pB0, pB1, m_reg, mnB, alB);
  __syncthreads(); RESC(alB);
  finishSM(pB0, pB1, alB, l_reg, pa0, pa1, pa2, pa3); SBAR();
  pv_d0(o, vb0 + (int)SHM_V, pa0, pa1, pa2, pa3);
  if (hi == 0) li_l[r32] = l_reg; asm volatile("s_waitcnt lgkmcnt(0)" ::: "memory");
  float rli[16];
#pragma unroll
  for (int r = 0; r < 16; ++r) rli[r] = __builtin_amdgcn_rcpf(li_l[crow(r, hi)]);
  if (Of) { float* Ow = Of + (long)(wid * QBLK) * LDOF;
#pragma unroll
    for (int r = 0; r < 16; ++r) { int orow = crow(r, hi);
#pragma unroll
      for (int d0 = 0; d0 < 4; ++d0) Ow[(long)orow * LDOF + d0 * 32 + r32] = o[d0][r] * rli[r]; }
  } else { unsigned short* Ow = (unsigned short*)Ob16 + (long)(wid * QBLK) * LDOB;
#pragma unroll
    for (int r = 0; r < 16; ++r) { int orow = crow(r, hi);
#pragma unroll
      for (int d0 = 0; d0 < 4; ++d0) Ow[(long)orow * LDOB + d0 * 32 + r32] = (unsigned short)(cvtpk(o[d0][r] * rli[r], 0.f) & 0xffffu); }
  }
#undef SLOAD
#undef SWRITE
#undef SWAIT
#undef RESC
}

template <int ND, int LDQ, int LDK, int LDV, int LDOF, int LDOB>
__device__ __forceinline__ void attn_dma_body(const bf16* __restrict__ Qb, const bf16* __restrict__ Kh, const bf16* __restrict__ Vh,
                                                float* __restrict__ Of, bf16* __restrict__ Ob16, int seq, char* lds, int kcb,
                                                const float* __restrict__ qgain, const float* __restrict__ rope, int tpos0) {
  using TQ = bf16; using St = Stage<bf16>; using SQ = Stage<TQ>;
  int tid_l = threadIdx.x; asm volatile("" : "+v"(tid_l));
  const int tid = tid_l, wid = __builtin_amdgcn_readfirstlane(tid >> 6), lane = tid & 63, r32 = lane & 31, hi = lane >> 5;
  bf16* V_lds = (bf16*)lds; bf16* K_lds = (bf16*)(lds + 4 * SHM_V);
  float* ws = (float*)(lds + DMA_SCRATCH_OFF) + wid * 64; float* li_l = ws; float* al_l = ws + 32;
  float m_reg = -1e30f, l_reg = 0; f32x16 o[4] = {}; bf16x8 qr[ND];
  const TQ* Qw = Qb + (long)(wid * QBLK + r32) * LDQ + hi * 8;
  const int vb0 = (int)(uintptr_t)V_lds + v_rd_base(lane);
  unsigned koff[2], voff[2];
#pragma unroll
  for (int i = 0; i < 2; ++i) { const int g = (wid * 2 + i) * 64 + lane;
    { const int row = g >> 4, cg = g & 15; koff[i] = (unsigned)(row * LDK * 2 + ((cg ^ (row & 7)) << 4)); }
    { const int st = g >> 5, w = g & 31, kk = (st >> 2) * 8 + (w >> 2), c = (st & 3) * 32 + (w & 3) * 8, k = (kk & ~0xC) | ((kk & 4) << 1) | ((kk & 8) >> 1); voff[i] = (unsigned)(k * LDV * 2 + c * 2); } }
  const unsigned ldsV = (unsigned)(uintptr_t)V_lds + (unsigned)wid * 2048u, ldsK = (unsigned)(uintptr_t)K_lds + (unsigned)wid * 2048u;
#define DMA16(gsrc, ldsdst) do { unsigned keep_; asm volatile("s_mov_b32 %0, m0\n\ts_mov_b32 m0, %2\n\ts_nop 0\n\tglobal_load_lds_dwordx4 %1, off\n\ts_mov_b32 m0, %0" : "=&s"(keep_) : "v"(gsrc), "s"(ldsdst) : "memory"); } while (0)
#define ISSUE(t) do { const char* kt_ = (const char*)Kh + (size_t)(t) * (KVBLK * LDK * 2); const char* vt_ = (const char*)Vh + (size_t)(t) * (KVBLK * LDV * 2); const unsigned so_ = (unsigned)((t) & 3) * (unsigned)SHM_K; \
    DMA16(kt_ + koff[0], __builtin_amdgcn_readfirstlane(ldsK + so_)); DMA16(kt_ + koff[1], __builtin_amdgcn_readfirstlane(ldsK + so_ + 1024u)); \
    DMA16(vt_ + voff[0], __builtin_amdgcn_readfirstlane(ldsV + so_)); DMA16(vt_ + voff[1], __builtin_amdgcn_readfirstlane(ldsV + so_ + 1024u)); } while (0)
  ISSUE(0); ISSUE(1);
  {
    float f[ND][8];
#pragma unroll
    for (int d0 = 0; d0 < ND; ++d0) { const u32x4 w = *reinterpret_cast<const u32x4*>(Qw + d0 * 16);
      f[d0][0] = __uint_as_float(w[0] << 16); f[d0][1] = __uint_as_float(w[0] & 0xffff0000u); f[d0][2] = __uint_as_float(w[1] << 16); f[d0][3] = __uint_as_float(w[1] & 0xffff0000u);
      f[d0][4] = __uint_as_float(w[2] << 16); f[d0][5] = __uint_as_float(w[2] & 0xffff0000u); f[d0][6] = __uint_as_float(w[3] << 16); f[d0][7] = __uint_as_float(w[3] & 0xffff0000u); }
    if constexpr (ND == 8) {
      float ss = 0.f;
#pragma unroll
      for (int d0 = 0; d0 < ND; ++d0)
#pragma unroll
        for (int e = 0; e < 8; ++e) ss += f[d0][e] * f[d0][e];
      ss += __shfl_xor(ss, 32);
      const float rstd = 1.f / sqrtf(ss * (1.f / 128.f) + 1e-6f);
#pragma unroll
      for (int d0 = 0; d0 < ND; ++d0) { const float* gp = qgain + d0 * 16 + hi * 8;
#pragma unroll
        for (int e = 0; e < 8; ++e) f[d0][e] = f[d0][e] * rstd * gp[e]; }
    }
    if (tpos0 >= 0) { const int t = tpos0 + wid * QBLK + r32; constexpr int Q4 = ND / 4, TOFF = ND == 8 ? 16 : 0;
#pragma unroll
      for (int hf = 0; hf < 2; ++hf) { const float* tb = rope + (size_t)((hf == 0 ? (t >> 6) : (t & 63)) * 48 + TOFF + hi * 8) * 2;
#pragma unroll
        for (int q = 0; q < Q4; ++q)
#pragma unroll
          for (int e = 0; e < 8; ++e) { const float cs = tb[(q * 16 + e) * 2], sn = tb[(q * 16 + e) * 2 + 1]; const int da = hf * 2 * Q4 + q, db = da + Q4;
            const float x1 = f[da][e], x2 = f[db][e]; f[da][e] = x1 * cs - x2 * sn; f[db][e] = x1 * sn + x2 * cs; } }
    }
    constexpr float QS = ND == 8 ? 1.f : 1.4142135623730951f;
#pragma unroll
    for (int d0 = 0; d0 < ND; ++d0) { u32x4 w = {cvtpk(f[d0][0] * QS, f[d0][1] * QS), cvtpk(f[d0][2] * QS, f[d0][3] * QS), cvtpk(f[d0][4] * QS, f[d0][5] * QS), cvtpk(f[d0][6] * QS, f[d0][7] * QS)};
      qr[d0] = *reinterpret_cast<bf16x8*>(&w); }
  }
#define WAIT_BAR(N) asm volatile("s_waitcnt vmcnt(" #N ") lgkmcnt(0)\n\ts_barrier" ::: "memory")
#define RESC(a) do { if (__any((a) < 1.f)) { if (hi == 0) al_l[r32] = (a); asm volatile("s_waitcnt lgkmcnt(0)" ::: "memory"); \
    for (int d = 0; d < 4; ++d) for (int r = 0; r < 16; ++r) o[d][r] *= al_l[crow(r, hi)]; } } while (0)
  f32x16 pA0, pA1, pB0, pB1; float mnA, mnB, alA, alB; bf16x8 pa0, pa1, pa2, pa3; const int NT = seq / KVBLK;
#define STEP(PC0, PC1, mnC, alC, PP0, PP1, alP, t) do { if ((t) + 1 < NT) WAIT_BAR(4); else WAIT_BAR(0); \
    if ((t) + 2 < NT) ISSUE((t) + 2); \
    SBAR(); qkt<ND>(PC0, PC1, (bf16*)((char*)K_lds + ((t) & 3) * SHM_K), qr, r32, hi, kcb); \
    finishSM(PP0, PP1, alP, l_reg, pa0, pa1, pa2, pa3); SBAR(); \
    pv_d0(o, vb0 + (((t) - 1) & 3) * (int)SHM_V, pa0, pa1, pa2, pa3); partialSM(PC0, PC1, m_reg, mnC, alC); \
    RESC(alC); } while (0)
  WAIT_BAR(4);
  if (2 < NT) ISSUE(2);
  qkt<ND>(pA0, pA1, K_lds, qr, r32, hi, kcb); partialSM(pA0, pA1, m_reg, mnA, alA);
  for (int t0 = 0; t0 < NT; t0 += 4) {
    STEP(pB0, pB1, mnB, alB, pA0, pA1, alA, t0 + 1);
    STEP(pA0, pA1, mnA, alA, pB0, pB1, alB, t0 + 2);
    STEP(pB0, pB1, mnB, alB, pA0, pA1, alA, t0 + 3);
    if (t0 + 4 < NT) STEP(pA0, pA1, mnA, alA, pB0, pB1, alB, t0 + 4);
  }
  finishSM(pB0, pB1, alB, l_reg, pa0, pa1, pa2, pa3); SBAR();
  pv_d0(o, vb0 + 3 * (int)SHM_V, pa0, pa1, pa2, pa3);
  if (hi == 0) li_l[r32] = l_reg; asm volatile("s_waitcnt lgkmcnt(0)" ::: "memory");
  float rli[16];
#pragma unroll
  for (int r = 0; r < 16; ++r) rli[r] = __builtin_amdgcn_rcpf(li_l[crow(r, hi)]);
  if (Of) { float* Ow = Of + (long)(wid * QBLK) * LDOF;
#pragma unroll
    for (int r = 0; r < 16; ++r) { int orow = crow(r, hi);
#pragma unroll
      for (int d0 = 0; d0 < 4; ++d0) Ow[(long)orow * LDOF + d0 * 32 + r32] = o[d0][r] * rli[r]; }
  } else { unsigned short* Ow = (unsigned short*)Ob16 + (long)(wid * QBLK) * LDOB;
#pragma unroll
    for (int r = 0; r < 16; ++r) { int orow = crow(r, hi);
#pragma unroll
      for (int d0 = 0; d0 < 4; ++d0) Ow[(long)orow * LDOB + d0 * 32 + r32] = (unsigned short)(cvtpk(o[d0][r] * rli[r], 0.f) & 0xffffu); }
  }
#undef DMA16
#undef ISSUE
#undef WAIT_BAR
#undef STEP
#undef RESC
}

}
#define GAS __attribute__((address_space(1)))
#define LAS __attribute__((address_space(3)))
typedef unsigned short bf16_t;
typedef unsigned u32x4v __attribute__((ext_vector_type(4)));
typedef unsigned v4u __attribute__((ext_vector_type(4)));
typedef float f32x4 __attribute__((ext_vector_type(4)));
typedef short bf16x8 __attribute__((ext_vector_type(8)));
typedef GAS unsigned gu32;
typedef GAS unsigned long long gu64;
#define RLX_AGENT __ATOMIC_RELAXED, __HIP_MEMORY_SCOPE_AGENT
#define LDS_WAIT() asm volatile("s_waitcnt lgkmcnt(0)" ::: "memory")
#define VM_WAIT() asm volatile("s_waitcnt vmcnt(0)" ::: "memory")
__device__ __forceinline__ unsigned long long rt() { return __builtin_amdgcn_s_memrealtime(); }
__device__ __forceinline__ unsigned f2bf(float f) { unsigned u = __builtin_bit_cast(unsigned, f); return (u + 0x7fffu + ((u >> 16) & 1u)) >> 16; }
__device__ __forceinline__ unsigned pk2(float lo, float hi) { return f2bf(lo) | (f2bf(hi) << 16); }
#define XB_TMO      128
#define XB_XCNT(j)  (256  + 64 * (j))
#define XB_XSUB(j)  (1280 + 64 * (j))
#define XB_XGEN(j)  (2304 + 64 * (j))
#define XB_TOP      3328
#define XB_TOPGEN   3392
#define XCD_BAR_WORDS 3456
#define XB_SPIN_CAP (1u << 18)

__device__ __forceinline__ unsigned xb_ld(unsigned* p)              { return __hip_atomic_load(p, __ATOMIC_RELAXED, __HIP_MEMORY_SCOPE_AGENT); }
__device__ __forceinline__ unsigned xb_add(unsigned* p, unsigned v) { return __hip_atomic_fetch_add(p, v, __ATOMIC_RELAXED, __HIP_MEMORY_SCOPE_AGENT); }
__device__ __forceinline__ unsigned xb_xcc_id() { return (unsigned)__builtin_amdgcn_s_getreg((3 << 11) | 20) & 0xFu; }
#define XB_SPIN(cond, bar) do { unsigned _sp = 0; while (cond) { __builtin_amdgcn_s_sleep(1); \
    if ((++_sp & 255u) == 0u) { if (xb_ld(&(bar)[XB_TMO])) break; if (_sp > XB_SPIN_CAP) { atomicAdd(&(bar)[XB_TMO], 1u); break; } } } } while (0)

struct XcdBarrier {
    unsigned* bar; unsigned x;
    volatile LAS unsigned* st;
};

__device__ __forceinline__ XcdBarrier xcd_barrier_post(unsigned* bar, volatile LAS unsigned* st) {
    XcdBarrier b; b.bar = bar; b.x = xb_xcc_id(); b.st = st;
    if (threadIdx.x == 0) (void)xb_add(&bar[XB_XCNT(b.x)], 1u);
    return b;
}
__device__ __forceinline__ void xcd_barrier_complete(unsigned* bar, unsigned x, unsigned& nloc, unsigned& nx) {
    const unsigned G = gridDim.x * gridDim.y * gridDim.z;
    unsigned sum, cnt, mine, sp = 0u;
    for (;;) {
        sum = 0u; cnt = 0u; mine = 0u;
#pragma unroll
        for (unsigned j = 0; j < 16; ++j) { const unsigned c = xb_ld(&bar[XB_XCNT(j)]); sum += c; cnt += (c > 0u) ? 1u : 0u; mine = (j == x) ? c : mine; }
        if (sum == G) break;
        __builtin_amdgcn_s_sleep(1);
        if ((++sp & 255u) == 0u) { if (xb_ld(&bar[XB_TMO])) break; if (sp > XB_SPIN_CAP) { atomicAdd(&bar[XB_TMO], 1u); break; } }
    }
    nloc = mine > 0u ? mine : 1u; nx = cnt > 0u ? cnt : 1u;
}

__device__ __forceinline__ void xcd_barrier(const XcdBarrier& b) {
    asm volatile("s_waitcnt vmcnt(0)" ::: "memory");
    __syncthreads();
    if (threadIdx.x == 0) {
        unsigned* bar = b.bar;
        __builtin_amdgcn_s_waitcnt(0);
        unsigned nloc = b.st[0], nx = b.st[1];
        if (nloc == 0u) { xcd_barrier_complete(bar, b.x, nloc, nx); b.st[0] = nloc; b.st[1] = nx; }
        const unsigned old = xb_add(&bar[XB_XSUB(b.x)], 1u);
        const unsigned gen = old / nloc;
        if (old + 1u == (gen + 1u) * nloc) {
            __builtin_amdgcn_fence(__ATOMIC_RELEASE, "agent");
            asm volatile("s_waitcnt vmcnt(0)" ::: "memory");
            const unsigned og = xb_add(&bar[XB_TOP], 1u);
            const unsigned tg = og / nx;
            if (og + 1u == (tg + 1u) * nx) xb_add(&bar[XB_TOPGEN], 1u);
            else XB_SPIN(xb_ld(&bar[XB_TOPGEN]) == tg, bar);
            __builtin_amdgcn_fence(__ATOMIC_ACQUIRE, "agent");
            xb_add(&bar[XB_XGEN(b.x)], 1u);
            asm volatile("s_waitcnt vmcnt(0)" ::: "memory");
        } else {
            XB_SPIN(xb_ld(&bar[XB_XGEN(b.x)]) == gen, bar);
            __builtin_amdgcn_fence(__ATOMIC_ACQUIRE, "agent");
            asm volatile("s_waitcnt vmcnt(0)" ::: "memory");
        }
    }
    __syncthreads();
}


constexpr int DM = 2048, NB = 4, SEQL = 4096, CTXL = 256, SPB = 4352, R = NB * SPB, FF = 5632, INC = 3584, NMOD = 9, MODW = NMOD * DM;
constexpr int S5G = 32, S5P = 64, S5H = 16, TCH = 32;
constexpr int NCH = SPB / TCH, NCC = CTXL / TCH, RCV = NB * NCH, RCT = (RCV + 255) / 256, RCP = RCT * 256;
constexpr int KU = TCH * S5H, KS5 = KU + 256, NT5 = KU / 256, NLAG = 2 * TCH - 1;
static_assert(NCH % 17 == 0 && KU % 256 == 0, "S5 chunk geometry");
constexpr float EPS = 1e-6f;
constexpr int NWAVES = 8;
constexpr size_t MiB = 1u << 20;
constexpr size_t WS_CTL = 0, CTL_ZERO_BYTES = 1 * MiB;
constexpr size_t WS_MODV = 1 * MiB;
constexpr size_t WS_APOW = 2 * MiB;
constexpr size_t WS_BBAR = 7 * MiB;
constexpr size_t WS_ROPE = 6 * MiB + 512 * 1024;
constexpr size_t WS_KTAB = 8 * MiB;
constexpr size_t WS_WGU = 16 * MiB;
constexpr size_t WS_WD = 192 * MiB;
constexpr size_t WS_WIN = 280 * MiB;
constexpr size_t WS_WOUT = 308 * MiB;
constexpr size_t WS_GLU = 324 * MiB;
constexpr size_t WS_TZE = 326 * MiB;
constexpr size_t WS_SM = 486 * MiB;
constexpr size_t WS_XS = 518 * MiB;
constexpr size_t WS_H = 654 * MiB;
constexpr size_t WS_HACT = 722 * MiB;
constexpr size_t WS_P = 722 * MiB;
constexpr size_t WS_KA = 841 * MiB;
constexpr size_t WS_OD = 867 * MiB;
constexpr size_t WS_VA = 901 * MiB;
constexpr size_t WS_MIX = 935 * MiB;
constexpr size_t WS_UG = 1003 * MiB;
constexpr size_t WS_SST = 1043 * MiB;
constexpr size_t WS_YG = 1067 * MiB;
constexpr size_t WS_PART = 1084 * MiB;
constexpr size_t WS_END = 1116 * MiB;
static_assert((size_t)S5G * RCP * 256 * 4 <= 24 * MiB && (size_t)S5G * RCP * KS5 * 2 <= 40 * MiB && (size_t)2 * S5G * KU * KS5 * 2 <= 160 * MiB, "S5 buffers");
constexpr int CW_BAR = 4096;
constexpr int RING_BYTES = 131072, LDSCTL_OFF = RING_BYTES, MISC_OFF = LDSCTL_OFF + 320, PTR_OFF = MISC_OFF + 128, LDS_BYTES = 147456;
constexpr int NPH = 28;
#ifndef MK_N_LAUNCHES
#define MK_N_LAUNCHES 1
#endif
#ifndef PROBE_MASK
#define PROBE_MASK 0u
#endif
#define PROBE_REPS(ph) ((((unsigned)PROBE_MASK >> (ph)) & 1u) ? 2 : 1)

typedef float f32x2v __attribute__((ext_vector_type(2)));
__device__ __forceinline__ float wave_sum(float v) {
#pragma unroll
    for (int o = 1; o < 64; o <<= 1) v += __shfl_xor(v, o);
    return v;
}
__device__ __forceinline__ float bflo(unsigned w) { return __uint_as_float(w << 16); }
__device__ __forceinline__ float bfhi(unsigned w) { return __uint_as_float(w & 0xffff0000u); }
__device__ __forceinline__ unsigned cvtpk2(float lo, float hi) { unsigned r; asm volatile("v_cvt_pk_bf16_f32 %0, %1, %2" : "=v"(r) : "v"(lo), "v"(hi)); return r; }
__device__ __forceinline__ float sigmoidf_fast(float z) { return __builtin_amdgcn_rcpf(1.f + __builtin_amdgcn_exp2f(-1.4426950408889634f * z)); }

namespace pg8 {
struct EpiGU { static constexpr bool PERM = true, AFTER_DRAIN = false; bf16_t* O;
    __device__ __forceinline__ void operator()(const f32x4 (&acc)[2][2][4][2], const Unit& u, int wr, int wc, int fr, int fq) const {
        const int row0 = u.pm * BM + wr * 64 + fr, col0 = u.pn * HALF + wc * 32 + 8 * fq;
#pragma unroll
        for (int ai = 0; ai < 2; ++ai)
#pragma unroll
            for (int m = 0; m < 4; ++m) { bf16_t* rowp = O + (size_t)(row0 + ai * HALF + m * 16) * FF + col0;
                float o[8];
#pragma unroll
                for (int n = 0; n < 2; ++n)
#pragma unroll
                    for (int i = 0; i < 4; ++i) { const float g = acc[ai][0][m][n][i], up = acc[ai][1][m][n][i]; o[4 * n + i] = g * up * sigmoidf_fast(g); }
                u32x4 w; w.x = cvt_pk_bf16(o[0], o[1]); w.y = cvt_pk_bf16(o[2], o[3]); w.z = cvt_pk_bf16(o[4], o[5]); w.w = cvt_pk_bf16(o[6], o[7]);
                *(u32x4*)rowp = w; }
    }
};
struct EpiResid { static constexpr bool PERM = false, AFTER_DRAIN = false; float* X; const float* gate; float coef;
    __device__ __forceinline__ void operator()(const f32x4 (&acc)[2][2][4][2], const Unit& u, int wr, int wc, int fr, int fq) const {
        const int bb = u.pm / 17, jj = u.pm % 17, midx = jj == 0 ? 4 : bb;
        const int col0 = u.pn * BM + wc * 32 + 4 * fq; const float* gv = gate + (size_t)midx * MODW + col0;
        f32x4 gt[2][2];
#pragma unroll
        for (int bj = 0; bj < 2; ++bj)
#pragma unroll
            for (int n = 0; n < 2; ++n) gt[bj][n] = *(const f32x4*)(gv + bj * HALF + n * 16) * coef;
        float* const row0 = X + (size_t)(u.pm * BM + wr * 64 + fr) * DM + col0;
        f32x4 b[2][2][4];
#define ER_LOAD(buf, p) do { _Pragma("unroll") for (int q = 0; q < 2; ++q) { const int s_ = 2 * (p) + q; const float* rp = row0 + (size_t)((s_ >> 2) * HALF + (s_ & 3) * 16) * DM; \
            _Pragma("unroll") for (int c = 0; c < 4; ++c) b[buf][q][c] = *(const f32x4*)(rp + (c >> 1) * HALF + (c & 1) * 16); } } while (0)
        ER_LOAD(0, 0);
#pragma unroll
        for (int p = 0; p < 4; ++p) { if (p < 3) ER_LOAD((p + 1) & 1, p + 1);
#pragma unroll
            for (int q = 0; q < 2; ++q) { const int s_ = 2 * p + q, ai = s_ >> 2, m = s_ & 3; float* rp = row0 + (size_t)(ai * HALF + m * 16) * DM;
#pragma unroll
                for (int c = 0; c < 4; ++c) *(f32x4*)(rp + (c >> 1) * HALF + (c & 1) * 16) = b[p & 1][q][c] + gt[c >> 1][c & 1] * acc[ai][c >> 1][m][c & 1]; } }
#undef ER_LOAD
    }
};
struct EpiResidX { static constexpr bool PERM = false, AFTER_DRAIN = false; float* X; const float* gate; const float* xin;
    __device__ __forceinline__ void operator()(const f32x4 (&acc)[2][2][4][2], const Unit& u, int wr, int wc, int fr, int fq) const {
        const int bb = u.pm / 17, jj = u.pm % 17;
        const int col0 = u.pn * BM + wc * 32 + 4 * fq; const float* gv = gate + (size_t)bb * MODW + col0;
        f32x4 gt[2][2];
#pragma unroll
        for (int bj = 0; bj < 2; ++bj)
#pragma unroll
            for (int n = 0; n < 2; ++n) gt[bj][n] = *(const f32x4*)(gv + bj * HALF + n * 16) * 0.5f;
        float* const row0 = X + (size_t)(u.pm * BM + wr * 64 + fr) * DM + col0; const float* const src0 = xin + (size_t)(bb * SEQL + (jj - 1) * BM + wr * 64 + fr) * DM + col0;
        f32x4 b[2][2][4];
#define ER_LOAD(buf, p) do { _Pragma("unroll") for (int q = 0; q < 2; ++q) { const int s_ = 2 * (p) + q; const float* rp = src0 + (size_t)((s_ >> 2) * HALF + (s_ & 3) * 16) * DM; \
            _Pragma("unroll") for (int c = 0; c < 4; ++c) b[buf][q][c] = *(const f32x4*)(rp + (c >> 1) * HALF + (c & 1) * 16); } } while (0)
        ER_LOAD(0, 0);
#pragma unroll
        for (int p = 0; p < 4; ++p) { if (p < 3) ER_LOAD((p + 1) & 1, p + 1);
#pragma unroll
            for (int q = 0; q < 2; ++q) { const int s_ = 2 * p + q, ai = s_ >> 2, m = s_ & 3; float* rp = row0 + (size_t)(ai * HALF + m * 16) * DM;
#pragma unroll
                for (int c = 0; c < 4; ++c) *(f32x4*)(rp + (c >> 1) * HALF + (c & 1) * 16) = b[p & 1][q][c] + gt[c >> 1][c & 1] * acc[ai][c >> 1][m][c & 1]; } }
#undef ER_LOAD
    }
};
struct EpiWin { static constexpr bool PERM = true, AFTER_DRAIN = false; bf16_t* P; bf16_t* UG; bf16_t* VA;
    __device__ __forceinline__ void operator()(const f32x4 (&acc)[2][2][4][2], const Unit& u, int wr, int wc, int fr, int fq) const {
        const int row0 = u.pm * BM + wr * 64 + fr, col0 = u.pn * BM + wc * 32 + 8 * fq;
#pragma unroll
        for (int ai = 0; ai < 2; ++ai)
#pragma unroll
            for (int m = 0; m < 4; ++m) { const int row = row0 + ai * HALF + m * 16;
                const int b = row / SPB, s = row % SPB, rc = b * NCH + s / TCH, j = s % TCH;
#pragma unroll
                for (int bj = 0; bj < 2; ++bj) { const f32x4 v0 = acc[ai][bj][m][0], v1 = acc[ai][bj][m][1];
                    u32x4 w; w.x = cvt_pk_bf16(v0[0], v0[1]); w.y = cvt_pk_bf16(v0[2], v0[3]); w.z = cvt_pk_bf16(v1[0], v1[1]); w.w = cvt_pk_bf16(v1[2], v1[3]);
                    const int col = col0 + bj * HALF;
                    if (u.pn < 2) { const int g = col >> 4, ho0 = col & 15; *(u32x4*)(UG + (size_t)(g * RCP + rc) * KS5 + j * 16 + ho0) = w; }
                    else if (u.pn == 6 || u.pn == 7) *(u32x4*)(VA + ((size_t)(b * 6 + ((col - 1536) >> 7)) * SPB + s) * 128 + ((col - 1536) & 127)) = w;
                    else if (u.pn == 13) *(u32x4*)(VA + ((size_t)(b * 6 + 4 + ((col - 3328) >> 7)) * SPB + s) * 128 + ((col - 3328) & 127)) = w;
                    else *(u32x4*)(P + (size_t)row * INC + col) = w; } }
    }
};
struct EpiS5State { static constexpr bool PERM = false, AFTER_DRAIN = false; float* SST;
    __device__ __forceinline__ void operator()(const f32x4 (&acc)[2][2][4][2], const Unit& u, int wr, int wc, int fr, int fq) const {
        const int col0 = wc * 32 + 4 * fq;
#pragma unroll
        for (int ai = 0; ai < 2; ++ai)
#pragma unroll
            for (int m = 0; m < 4; ++m) { float* rowp = SST + (size_t)(u.pm * BM + ai * HALF + wr * 64 + m * 16 + fr) * 256 + col0;
#pragma unroll
                for (int bj = 0; bj < 2; ++bj)
#pragma unroll
                    for (int n = 0; n < 2; ++n) *(f32x4*)(rowp + bj * HALF + n * 16) = acc[ai][bj][m][n]; }
    }
};
struct EpiS5Out { static constexpr bool PERM = true, AFTER_DRAIN = false; const bf16_t* UG; const float* dskip; bf16_t* YG;
    __device__ __forceinline__ void operator()(const f32x4 (&acc)[2][2][4][2], const Unit& u, int wr, int wc, int fr, int fq) const {
        const int g = u.pm / RCT, pmr = u.pm % RCT, pnr = u.pn % NT5;
#pragma unroll
        for (int bj = 0; bj < 2; ++bj) { const int cn8 = 256 * pnr + 128 * bj + 32 * wc + 8 * fq, l = cn8 >> 4, ho0 = cn8 & 15;
            const f32x4 d0 = *(const f32x4*)(dskip + g * 16 + ho0), d1 = *(const f32x4*)(dskip + g * 16 + ho0 + 4);
            u32x4 ub[2][4];
#pragma unroll
            for (int ai = 0; ai < 2; ++ai)
#pragma unroll
                for (int m = 0; m < 4; ++m) ub[ai][m] = *(const u32x4*)(UG + (size_t)(g * RCP + 256 * pmr + 128 * ai + 64 * wr + 16 * m + fr) * KS5 + cn8);
#pragma unroll
            for (int ai = 0; ai < 2; ++ai)
#pragma unroll
                for (int m = 0; m < 4; ++m) { const int rc = 256 * pmr + 128 * ai + 64 * wr + 16 * m + fr;
                    if (rc < RCV) { const int b = rc / NCH, c = rc % NCH; const size_t row = (size_t)b * SPB + c * TCH + l;
                        const u32x4 uu = ub[ai][m];
                        float y[8];
                        y[0] = acc[ai][bj][m][0][0] + d0[0] * bflo(uu.x); y[1] = acc[ai][bj][m][0][1] + d0[1] * bfhi(uu.x);
                        y[2] = acc[ai][bj][m][0][2] + d0[2] * bflo(uu.y); y[3] = acc[ai][bj][m][0][3] + d0[3] * bfhi(uu.y);
                        y[4] = acc[ai][bj][m][1][0] + d1[0] * bflo(uu.z); y[5] = acc[ai][bj][m][1][1] + d1[1] * bfhi(uu.z);
                        y[6] = acc[ai][bj][m][1][2] + d1[2] * bflo(uu.w); y[7] = acc[ai][bj][m][1][3] + d1[3] * bfhi(uu.w);
#pragma unroll
                        for (int i = 0; i < 8; ++i) { const float v = y[i]; y[i] = v * sigmoidf_fast(1.5957691216057308f * (v + 0.044715f * v * v * v)); }
                        u32x4 w; w.x = cvt_pk_bf16(y[0], y[1]); w.y = cvt_pk_bf16(y[2], y[3]); w.z = cvt_pk_bf16(y[4], y[5]); w.w = cvt_pk_bf16(y[6], y[7]);
                        *(u32x4*)(YG + row * 512 + g * 16 + ho0) = w; } } }
    }
};
struct EpiGLU { static constexpr bool PERM = true, AFTER_DRAIN = false; const bf16_t* YG; const float* gb; bf16_t* MIX;
    __device__ __forceinline__ void operator()(const f32x4 (&acc)[2][2][4][2], const Unit& u, int wr, int wc, int fr, int fq) const {
        const int row0 = u.pm * BM + wr * 64 + fr, col0 = u.pn * BM + wc * 32 + 8 * fq;
#pragma unroll
        for (int bj = 0; bj < 2; ++bj) { const int col = col0 + bj * HALF; const f32x4 b0 = *(const f32x4*)(gb + col), b1 = *(const f32x4*)(gb + col + 4);
            u32x4 yb[2][4];
#pragma unroll
            for (int ai = 0; ai < 2; ++ai)
#pragma unroll
                for (int m = 0; m < 4; ++m) yb[ai][m] = *(const u32x4*)(YG + (size_t)(row0 + ai * HALF + m * 16) * 512 + col);
#pragma unroll
            for (int ai = 0; ai < 2; ++ai)
#pragma unroll
                for (int m = 0; m < 4; ++m) { const size_t row = (size_t)(row0 + ai * HALF + m * 16);
                    const u32x4 yy = yb[ai][m];
                    const f32x4 z0 = acc[ai][bj][m][0] + b0, z1 = acc[ai][bj][m][1] + b1;
                    float o[8];
                    o[0] = bflo(yy.x) * sigmoidf_fast(z0[0]); o[1] = bfhi(yy.x) * sigmoidf_fast(z0[1]); o[2] = bflo(yy.y) * sigmoidf_fast(z0[2]); o[3] = bfhi(yy.y) * sigmoidf_fast(z0[3]);
                    o[4] = bflo(yy.z) * sigmoidf_fast(z1[0]); o[5] = bfhi(yy.z) * sigmoidf_fast(z1[1]); o[6] = bflo(yy.w) * sigmoidf_fast(z1[2]); o[7] = bfhi(yy.w) * sigmoidf_fast(z1[3]);
                    u32x4 w; w.x = cvt_pk_bf16(o[0], o[1]); w.y = cvt_pk_bf16(o[2], o[3]); w.z = cvt_pk_bf16(o[4], o[5]); w.w = cvt_pk_bf16(o[6], o[7]);
                    *(u32x4*)(MIX + row * DM + col) = w; } }
    }
};
struct S5StateOrder { int G, c;
    __device__ bool next(int i, Unit& u) const { const int L = i * G + c; if (L >= S5G * RCT) return false; u.pm = L; u.pn = L / RCT; u.kofs = 0; u.ks = 0; return true; }
    __device__ __forceinline__ void a_ready(const Unit&) const {}
    __device__ __forceinline__ void done(const Unit&) const {}
};
struct S5OutOrder { int G, c;
    __device__ bool next(int i, Unit& u) const { const int L = i * G + c; if (L >= S5G * RCT * NT5) return false; const int g = L / (RCT * NT5), rem = L % (RCT * NT5); u.pm = RCT * g + rem % RCT; u.pn = NT5 * g + rem / RCT; u.kofs = 0; u.ks = 0; return true; }
    __device__ __forceinline__ void a_ready(const Unit&) const {}
    __device__ __forceinline__ void done(const Unit&) const {}
};
struct FlexOrder { StaticOrder so; bool lat;
    __device__ void init(bool lat_, int N, int G_, int c_) { lat = lat_; so.init(lat_ ? 64 * BM : R, N, G_, c_); so.wgm = 4; }
    __device__ bool next(int i, Unit& u) const { if (!so.next(i, u)) return false; if (lat) u.pm = (u.pm >> 4) * 17 + 1 + (u.pm & 15); return true; }
    __device__ __forceinline__ void a_ready(const Unit&) const {}
    __device__ __forceinline__ void done(const Unit&) const {}
};
struct CtxSplitOrder { int G, c, ksbytes;
    __device__ bool next(int i, Unit& u) const { int p, pn, ks;
        if (G % 8 == 0) { if (i || (c & 7) >= 4 || (c >> 3) >= 32) return false; ks = c & 7; const int j = c >> 3; p = j & 3; pn = j >> 2; }
        else { const int L = i * G + c; if (L >= 128) return false; p = L >> 5; pn = L & 7; ks = (L & 31) >> 3; }
        u.pm = 17 * p; u.pn = pn; u.ks = ks; u.kofs = ks * ksbytes; return true; }
    __device__ __forceinline__ void a_ready(const Unit&) const {}
    __device__ __forceinline__ void done(const Unit&) const {}
};
struct EpiPart { static constexpr bool PERM = false, AFTER_DRAIN = false; float* PART;
    __device__ __forceinline__ void operator()(const f32x4 (&acc)[2][2][4][2], const Unit& u, int wr, int wc, int fr, int fq) const {
        const int col0 = u.pn * BM + wc * 32 + 4 * fq, prow = (u.pm / 17) * 256;
#pragma unroll
        for (int ai = 0; ai < 2; ++ai)
#pragma unroll
            for (int m = 0; m < 4; ++m) { float* rowp = PART + ((size_t)u.ks * 1024 + prow + ai * HALF + wr * 64 + m * 16 + fr) * DM + col0;
#pragma unroll
                for (int bj = 0; bj < 2; ++bj)
#pragma unroll
                    for (int n = 0; n < 2; ++n) *(f32x4*)(rowp + bj * HALF + n * 16) = acc[ai][bj][m][n]; }
    }
};
}

__device__ __forceinline__ void transpose_item(const float* W, int K, int N, bf16_t* WT, int k0, int n0, int rowbase, LAS float* scr, int lane) {
#pragma unroll 8
    for (int i = 0; i < 32; ++i) { const int kk = 2 * i + (lane >> 5); scr[kk * 33 + (lane & 31)] = W[(size_t)(k0 + kk) * N + n0 + (lane & 31)]; }
    LDS_WAIT(); asm volatile("" ::: "memory");
    const int c = lane & 7;
#pragma unroll
    for (int j = 0; j < 4; ++j) { const int n = (lane >> 3) + 8 * j; const LAS float* s = scr + (8 * c) * 33 + n;
        v4u o; o.x = pk2(s[0 * 33], s[1 * 33]); o.y = pk2(s[2 * 33], s[3 * 33]); o.z = pk2(s[4 * 33], s[5 * 33]); o.w = pk2(s[6 * 33], s[7 * 33]);
        *(GAS v4u*)(WT + (size_t)(rowbase + n) * K + k0 + 8 * c) = o; }
    LDS_WAIT(); asm volatile("" ::: "memory");
}
__device__ __forceinline__ void norm_mod_rows(float* XS, bf16_t* H, const float* g, const float* modl, int modk, int gw, int NGW, int lane, int tid, LAS float* tab, const float* part, const float* pgate, float pcoef, bool skipctx, const float* xin) {
    for (int i = tid; i < 5 * DM; i += NWAVES * 64) { const int m = i / DM, k = i % DM; const float* mv = modl + (size_t)m * MODW + (3 * modk) * DM + k; tab[i] = g[k] * (1.f + mv[DM]); tab[5 * DM + i] = mv[0]; }
    __syncthreads();
    auto rowsrc = [&](int r) { const int b = r / SPB, s = r % SPB; return (const f32x4*)((xin && s >= CTXL) ? xin + (size_t)(b * SEQL + s - CTXL) * DM : XS + (size_t)r * DM) + lane; };
    auto finish = [&](f32x4 (&v)[8], int r) {
        const int b = r / SPB, s = r % SPB, midx = s < CTXL ? 4 : b;
        if (skipctx && s < CTXL) return;
        if (part && s < CTXL) { const f32x4* pr = (const f32x4*)(part + (size_t)(b * CTXL + s) * DM) + lane; f32x4* xw = (f32x4*)(XS + (size_t)r * DM) + lane;
#pragma unroll
            for (int j = 0; j < 8; ++j) { const f32x4 ps = (pr[64 * j] + pr[64 * j + 1024 * DM / 4]) + (pr[64 * j + 2 * 1024 * DM / 4] + pr[64 * j + 3 * 1024 * DM / 4]);
                v[j] = v[j] + (*(const f32x4*)(pgate + 4 * (lane + 64 * j)) * pcoef) * ps; xw[64 * j] = v[j]; } }
        float ss = 0.f;
#pragma unroll
        for (int j = 0; j < 8; ++j) ss += (v[j].x * v[j].x + v[j].y * v[j].y) + (v[j].z * v[j].z + v[j].w * v[j].w);
        const float rstd = 1.f / sqrtf(wave_sum(ss) * (1.f / DM) + EPS);
        unsigned long long* o8 = (unsigned long long*)(H + (size_t)r * DM) + lane; const LAS f32x4* cs = (const LAS f32x4*)(tab + midx * DM) + lane; const LAS f32x4* sh = (const LAS f32x4*)(tab + (5 + midx) * DM) + lane;
#pragma unroll
        for (int j = 0; j < 8; ++j) { const f32x4 o = (v[j] * rstd) * cs[64 * j] + sh[64 * j];
            o8[64 * j] = (unsigned long long)cvtpk2(o.x, o.y) | ((unsigned long long)cvtpk2(o.z, o.w) << 32); }
    };
    for (int r0 = gw; r0 < R; r0 += 2 * NGW) {
        const int r1 = r0 + NGW; const bool two = r1 < R;
        const f32x4* xa = rowsrc(r0); const f32x4* xb = rowsrc(two ? r1 : r0);
        f32x4 va[8], vb[8];
#pragma unroll
        for (int j = 0; j < 8; ++j) va[j] = xa[64 * j];
#pragma unroll
        for (int j = 0; j < 8; ++j) vb[j] = xb[64 * j];
        finish(va, r0); if (two) finish(vb, r1);
    }
}
__device__ __forceinline__ void unpack8(const u32x4v w, float (&f)[8]) {
    f[0] = bflo(w.x); f[1] = bfhi(w.x); f[2] = bflo(w.y); f[3] = bfhi(w.y); f[4] = bflo(w.z); f[5] = bfhi(w.z); f[6] = bflo(w.w); f[7] = bfhi(w.w);
}
__device__ __forceinline__ u32x4v pack8(const float (&f)[8]) { u32x4v w; w.x = cvtpk2(f[0], f[1]); w.y = cvtpk2(f[2], f[3]); w.z = cvtpk2(f[4], f[5]); w.w = cvtpk2(f[6], f[7]); return w; }
template <int XORL> __device__ __forceinline__ void rope8(float (&f)[8], bool first, const f32x2v* tab) {
#pragma unroll
    for (int e = 0; e < 8; ++e) {
        const f32x2v cs = tab[e];
        const float other = __shfl_xor(f[e], XORL);
        f[e] = first ? (f[e] * cs.x - other * cs.y) : (other * cs.y + f[e] * cs.x);
    }
}
__device__ __forceinline__ void s5_tables(unsigned char* ws, const float* p_cre, const float* p_cim, int mask, int layer, int t0, int stride) {
    const f32x2v* const APOW = (const f32x2v*)(ws + WS_APOW); const f32x2v* const BBAR = (const f32x2v*)(ws + WS_BBAR);
    const float* const KTAB = (const float*)(ws + WS_KTAB); bf16_t* const TZE = (bf16_t*)(ws + WS_TZE); bf16_t* const SM = (bf16_t*)(ws + WS_SM);
                    if (mask & 1) {   constexpr int NL = S5G * KU * (KU / 8); const int N1 = (layer + 1) * NL;
                        for (int e0 = layer * NL + t0; e0 < N1; e0 += 4 * stride) {
                            f32x4 a0[4], a1[4]; size_t dsto[4];
#pragma unroll
                            for (int u = 0; u < 4; ++u) { int e = e0 + u * stride; e = e < N1 ? e : N1 - 1;
                                { const int k8 = e % (KU / 8), n = (e / (KU / 8)) % KU, lg = e / ((KU / 8) * KU), t = n >> 4, ho = n & 15, jj = k8 >> 1, hi0 = (k8 & 1) * 8;
                                    const float* src = KTAB + ((size_t)lg * NLAG + (t - jj + TCH - 1)) * 256 + ho * 16 + hi0; a0[u] = *(const f32x4*)src; a1[u] = *(const f32x4*)(src + 4);
                                    dsto[u] = ((size_t)lg * KU + n) * KS5 + k8 * 8; } }
#pragma unroll
                            for (int u = 0; u < 4; ++u) { const float o[8] = {a0[u].x, a0[u].y, a0[u].z, a0[u].w, a1[u].x, a1[u].y, a1[u].z, a1[u].w}; *(u32x4v*)(TZE + dsto[u]) = pack8(o); }
                        } }
                    if (mask & 2) {   constexpr int NL = S5G * KU * 32; const int N2 = (layer + 1) * NL;
                        for (int e0 = layer * NL + t0; e0 < N2; e0 += 4 * stride) {
                            f32x2v ap[4][4]; f32x4 cr4[4], ci4[4]; size_t dsto[4];
#pragma unroll
                            for (int u = 0; u < 4; ++u) { int e = e0 + u * stride; e = e < N2 ? e : N2 - 1;
                                { const int q = e & 31, n = (e >> 5) % KU, lg = (e >> 5) / KU, t = n >> 4, ho = n & 15, d = q >> 4, p0 = (q & 15) * 4, l = lg / S5G, g = lg % S5G, base = (l * 2 + d) * S5G + g, pw = d == 0 ? t + 1 : TCH - t;
                                    cr4[u] = *(const f32x4*)(p_cre + ((size_t)base * S5H + ho) * S5P + p0); ci4[u] = *(const f32x4*)(p_cim + ((size_t)base * S5H + ho) * S5P + p0);
#pragma unroll
                                    for (int pp = 0; pp < 4; ++pp) ap[u][pp] = APOW[((size_t)base * S5P + p0 + pp) * 65 + pw];
                                    dsto[u] = ((size_t)lg * KU + n) * KS5 + (KU / 8 + q) * 8; } }
#pragma unroll
                            for (int u = 0; u < 4; ++u) { float o[8];
#pragma unroll
                                for (int pp = 0; pp < 4; ++pp) { const float cr = cr4[u][pp], ci = ci4[u][pp]; o[2 * pp] = cr * ap[u][pp].x - ci * ap[u][pp].y; o[2 * pp + 1] = -(cr * ap[u][pp].y + ci * ap[u][pp].x); }
                                *(u32x4v*)(TZE + dsto[u]) = pack8(o); }
                        } }
                    if (mask & 4) {   constexpr int NL = S5G * 256 * (KU / 8); const int N3 = (layer + 1) * NL;
                        for (int e0 = layer * NL + t0; e0 < N3; e0 += 4 * stride) {
                            f32x2v ap[4]; f32x4 bq[4][4]; size_t dsto[4]; int ri[4];
#pragma unroll
                            for (int u = 0; u < 4; ++u) { int e = e0 + u * stride; e = e < N3 ? e : N3 - 1;
                                { const int k8 = e % (KU / 8), n = (e / (KU / 8)) & 255, lg = e / ((KU / 8) * 256), l = lg / S5G, g = lg % S5G, d = n >> 7, p = (n & 127) >> 1, jj = k8 >> 1, hi0 = (k8 & 1) * 8;
                                    const int base = (l * 2 + d) * S5G + g, pw = d == 0 ? TCH - 1 - jj : jj; ri[u] = n & 1;
                                    ap[u] = APOW[((size_t)base * S5P + p) * 65 + pw]; const f32x4* bp = (const f32x4*)(BBAR + ((size_t)base * S5P + p) * S5H + hi0);
#pragma unroll
                                    for (int w = 0; w < 4; ++w) bq[u][w] = bp[w];
                                    dsto[u] = ((size_t)lg * 256 + n) * KU + k8 * 8; } }
#pragma unroll
                            for (int u = 0; u < 4; ++u) { float o[8];
#pragma unroll
                                for (int w = 0; w < 4; ++w) { const f32x4 b2 = bq[u][w];
                                    o[2 * w] = ri[u] ? (ap[u].x * b2.y + ap[u].y * b2.x) : (ap[u].x * b2.x - ap[u].y * b2.y);
                                    o[2 * w + 1] = ri[u] ? (ap[u].x * b2.w + ap[u].y * b2.z) : (ap[u].x * b2.z - ap[u].y * b2.w); }
                                *(u32x4v*)(SM + dsto[u]) = pack8(o); }
                        } }
}
__device__ __forceinline__ const void* ldptr(LAS unsigned char* ldsl, int i) {
    const unsigned long long v = *(volatile LAS unsigned long long*)(ldsl + PTR_OFF + 8 * i);
    const unsigned lo = __builtin_amdgcn_readfirstlane((unsigned)v), hi = __builtin_amdgcn_readfirstlane((unsigned)(v >> 32));
    return (const void*)(const GAS void*)(((unsigned long long)hi << 32) | lo);
}
struct Args { const float* in[27]; float* out; unsigned char* ws; int ph_lo, ph_hi; };
__global__ void __launch_bounds__(NWAVES * 64, 2) mega_fwd(Args args) {
    extern __shared__ __attribute__((aligned(16))) unsigned char lds[];
    LAS unsigned char* const ldsl = (LAS unsigned char*)lds;
    const int tid = threadIdx.x;
#define PH_IDS int tid_l = threadIdx.x; asm volatile("" : "+v"(tid_l)); const int tid = tid_l, lane = tid & 63, wave = __builtin_amdgcn_readfirstlane(tid >> 6); \
    int G_l = gridDim.x, bx_l = blockIdx.x; asm volatile("" : "+s"(G_l), "+s"(bx_l)); const int G = G_l, bx = bx_l, vcu = (G % 8 == 0) ? (bx % 8) * (G / 8) + bx / 8 : bx; \
    const int gw = vcu * NWAVES + wave, NGW = G * NWAVES; (void)lane; (void)gw; (void)NGW; (void)vcu; (void)bx; (void)tid;
    for (int u = tid; u < (LDS_BYTES - LDSCTL_OFF) / 4; u += NWAVES * 64) ((LAS unsigned*)(ldsl + LDSCTL_OFF))[u] = 0u;
    __syncthreads();
    if (tid < 27) ((LAS unsigned long long*)(ldsl + PTR_OFF))[tid] = (unsigned long long)args.in[tid];
    if (tid == 27) ((LAS unsigned long long*)(ldsl + PTR_OFF))[27] = (unsigned long long)args.out;
    if (tid == 28) ((LAS unsigned long long*)(ldsl + PTR_OFF))[28] = (unsigned long long)args.ws;
    __syncthreads();
#define INP(i) ((const float*)ldptr(ldsl, (i)))
#define WSP() ((unsigned char*)ldptr(ldsl, 28))
#define WS_F32(off) ((float*)(ws + (off)))
#define WS_BF(off) ((bf16_t*)(ws + (off)))
    XcdBarrier bar; bar.bar = (unsigned*)(args.ws + WS_CTL) + CW_BAR; bar.x = 0; bar.st = nullptr;
    if (MK_N_LAUNCHES == 1) bar = xcd_barrier_post((unsigned*)(args.ws + WS_CTL) + CW_BAR, (volatile LAS unsigned*)(ldsl + MISC_OFF) + 8);
    const int lo = args.ph_lo, hi = args.ph_hi; int ph = 0;
#define PH_ON (ph >= lo && ph < hi)
#define PH_END do { if (ph >= lo && ph + 1 < hi) xcd_barrier(bar); asm volatile("" ::: "memory"); ++ph; } while (0)
    if (PH_ON) for (int rep = 0; rep < PROBE_REPS(ph); ++rep) { PH_IDS (void)rep;
        unsigned char* const ws = WSP();
        {   const float* const c_in = INP(1); const float* const cctx_in = INP(3); const float* const ada_w = INP(4); const float* const ada_b = INP(5); float* const MODV = WS_F32(WS_MODV);
            LAS float* sl = (LAS float*)ldsl;
            LAS float* part = (LAS float*)(ldsl + 40960);
            for (int i = tid; i < 5 * DM; i += NWAVES * 64) { const int m = i / DM, k = i % DM; const float v = m < 4 ? c_in[m * DM + k] : cctx_in[k]; sl[i] = v / (1.f + expf(-v)); }
            __syncthreads();
            for (int it = vcu; it < 2 * 288; it += G) {
                const int layer = it / 288, n0 = (it % 288) * 64, kb = wave * 256;
                const float* W = ada_w + (size_t)layer * DM * MODW + (size_t)kb * MODW + n0 + lane;
                float a0 = 0.f, a1 = 0.f, a2 = 0.f, a3 = 0.f, a4 = 0.f;
#pragma unroll 4
                for (int kk = 0; kk < 256; kk += 4) {
                    const float w0 = W[(size_t)(kk + 0) * MODW], w1 = W[(size_t)(kk + 1) * MODW], w2 = W[(size_t)(kk + 2) * MODW], w3 = W[(size_t)(kk + 3) * MODW];
                    const f32x4 s0 = *(const LAS f32x4*)(sl + 0 * DM + kb + kk), s1 = *(const LAS f32x4*)(sl + 1 * DM + kb + kk), s2 = *(const LAS f32x4*)(sl + 2 * DM + kb + kk),
                                s3 = *(const LAS f32x4*)(sl + 3 * DM + kb + kk), s4 = *(const LAS f32x4*)(sl + 4 * DM + kb + kk);
                    a0 += s0.x * w0 + s0.y * w1 + s0.z * w2 + s0.w * w3; a1 += s1.x * w0 + s1.y * w1 + s1.z * w2 + s1.w * w3; a2 += s2.x * w0 + s2.y * w1 + s2.z * w2 + s2.w * w3;
                    a3 += s3.x * w0 + s3.y * w1 + s3.z * w2 + s3.w * w3; a4 += s4.x * w0 + s4.y * w1 + s4.z * w2 + s4.w * w3;
                }
                part[(wave * 5 + 0) * 64 + lane] = a0; part[(wave * 5 + 1) * 64 + lane] = a1; part[(wave * 5 + 2) * 64 + lane] = a2; part[(wave * 5 + 3) * 64 + lane] = a3; part[(wave * 5 + 4) * 64 + lane] = a4;
                __syncthreads();
                if (tid < 320) { const int m = tid >> 6, l = tid & 63; float s = 0.f;
#pragma unroll
                    for (int w = 0; w < 8; ++w) s += part[(w * 5 + m) * 64 + l];
                    MODV[(size_t)(layer * 5 + m) * MODW + n0 + l] = s + ada_b[layer * MODW + n0 + l]; }
                __syncthreads();
            }
        }
        __syncthreads();
        {   LAS float* scr = (LAS float*)(ldsl + wave * 16384);
            bf16_t* const WGU = WS_BF(WS_WGU); bf16_t* const WD = WS_BF(WS_WD); bf16_t* const WIN = WS_BF(WS_WIN); bf16_t* const WOUT = WS_BF(WS_WOUT); bf16_t* const GLUW = WS_BF(WS_GLU);
            constexpr int I_F = 5632, I_FFN = 3 * I_F * 4, I_IN = 3584, I_OUT = 2048, I_GLU = 128, I_L = I_IN + I_OUT + I_GLU, NITEMS = I_FFN + 2 * I_L;
            const int n3 = (2 * 288 > 2 * G) ? 2 * 288 - 2 * G : 0, vw = vcu < n3 ? (wave < 7 ? vcu * 7 + wave : -1) : n3 * 7 + (vcu - n3) * 8 + wave, NVW = n3 * 7 + (G - n3) * 8;
            for (int it = vw; it < NITEMS && it >= 0; it += NVW) {
                if (it < I_FFN) { const int fi = it / (3 * I_F), rem = it % (3 * I_F), kind = rem / I_F, item = rem % I_F;
                    if (kind < 2) { const int nblk = FF / 32, kbk = item / nblk, nb = item % nblk, n0 = 32 * nb;
                        transpose_item(INP(7 + kind) + (size_t)fi * DM * FF, DM, FF, WGU + (size_t)fi * 2 * FF * DM, 64 * kbk, n0, (n0 / 128) * 256 + (n0 % 128) + kind * 128, scr, lane); }
                    else { const int nblk = DM / 32, kbk = item / nblk, nb = item % nblk;
                        transpose_item(INP(9) + (size_t)fi * FF * DM, FF, DM, WD + (size_t)fi * DM * FF, 64 * kbk, 32 * nb, 32 * nb, scr, lane); } }
                else { const int it2 = it - I_FFN, l = it2 / I_L, rem = it2 % I_L;
                    if (rem < I_IN) { const int nblk = INC / 32, kbk = rem / nblk, nb = rem % nblk;
                        transpose_item(INP(10) + (size_t)l * DM * INC, DM, INC, WIN + (size_t)l * INC * DM, 64 * kbk, 32 * nb, 32 * nb, scr, lane); }
                    else if (rem < I_IN + I_OUT) { const int r2 = rem - I_IN, nblk = DM / 32, kbk = r2 / nblk, nb = r2 % nblk;
                        transpose_item(INP(11) + (size_t)l * DM * DM, DM, DM, WOUT + (size_t)l * DM * DM, 64 * kbk, 32 * nb, 32 * nb, scr, lane); }
                    else { const int r2 = rem - I_IN - I_OUT, nblk = 512 / 32, kbk = r2 / nblk, nb = r2 % nblk;
                        transpose_item(INP(20) + (size_t)l * 512 * 512, 512, 512, GLUW + (size_t)l * 512 * 512, 64 * kbk, 32 * nb, 32 * nb, scr, lane); } }
            }
        }
        {   const float* const ctx_in = INP(2); float* const XS = WS_F32(WS_XS);
            for (int i = bx * (NWAVES * 64) + tid; i < NB * CTXL * (DM / 4); i += G * (NWAVES * 64)) {
                const int r = i / (DM / 4), c4 = i % (DM / 4), b = r / CTXL, s_ = r % CTXL;
                ((f32x4*)(XS + (size_t)(b * SPB + s_) * DM))[c4] = ((const f32x4*)ctx_in)[i]; }
        }
        {   f32x2v* const ROPE = (f32x2v*)(ws + WS_ROPE);
            for (int e = bx * (NWAVES * 64) + tid; e < 64 * 48; e += G * (NWAVES * 64)) { const int pos = e / 48, i = e % 48;
                const float freq = i < 16 ? exp2f(-(float)i * (13.287712379549449f / 16.f)) : exp2f(-(float)(i - 16) * (13.287712379549449f / 32.f));
                const float ang = (float)pos * freq; ROPE[e] = (f32x2v){cosf(ang), sinf(ang)}; } }
        {   const float* const p_lre = INP(12); const float* const p_lim = INP(13); const float* const p_ldt = INP(14); const float* const p_bre = INP(15); const float* const p_bim = INP(16);
            f32x2v* const APOW = (f32x2v*)(ws + WS_APOW); f32x2v* const BBAR = (f32x2v*)(ws + WS_BBAR);
        for (int idx = bx * (NWAVES * 64) + tid; idx < 2 * 2 * S5G * S5P * 65; idx += G * (NWAVES * 64)) { const int e = idx / 65, k = idx % 65;
            const float lre = p_lre[e], lim = p_lim[e], dt = expf(p_ldt[e / S5P]);
            const float xr = lre * dt; const double trev = (double)lim * (double)dt * 0.15915494309189535;
            const double tk = trev * (double)k; const float ang = (float)((tk - floor(tk)) * 6.283185307179586); const float mg = expf(xr * (float)k);
            APOW[idx] = (f32x2v){mg * cosf(ang), mg * sinf(ang)}; }
        for (int idx = bx * (NWAVES * 64) + tid; idx < 2 * 2 * S5G * S5P * S5H; idx += G * (NWAVES * 64)) { const int e = idx / S5H;
            const float lre = p_lre[e], lim = p_lim[e], dt = expf(p_ldt[e / S5P]);
            const float xr = lre * dt; const double trev = (double)lim * (double)dt * 0.15915494309189535;
            const float y = (float)((trev - floor(trev)) * 6.283185307179586);
            const float er = expm1f(xr), cy = cosf(y), sy = sinf(y), shf = sinf(0.5f * y);
            const float nr = er * cy - 2.f * shf * shf, ni = (er + 1.f) * sy, den = 1.f / (lre * lre + lim * lim);
            const float qr = (nr * lre + ni * lim) * den, qi = (ni * lre - nr * lim) * den;
            const float br = p_bre[idx], bi = p_bim[idx];
            BBAR[idx] = (f32x2v){qr * br - qi * bi, qr * bi + qi * br}; }
        }
    }
    PH_END;

    for (int fi = 0; fi < 4; ++fi) {
        const int layer = fi >> 1, which = fi & 1;
        if (PH_ON) for (int rep = 0; rep < PROBE_REPS(ph); ++rep) { PH_IDS (void)rep;
            unsigned char* const ws = WSP(); const float* const modl = WS_F32(WS_MODV) + (size_t)layer * 5 * MODW;
            {
                const bool fix = (fi == 1 || fi == 2) && rep == 0; const float* const pg = WS_F32(WS_MODV) + (size_t)4 * MODW + (fi == 1 ? 5 : 8) * DM;
                norm_mod_rows(WS_F32(WS_XS), WS_BF(WS_H), INP(6) + (size_t)(layer * 3 + which * 2) * DM, modl, which * 2, gw, NGW, lane, tid, (LAS float*)ldsl, fix ? WS_F32(WS_PART) : nullptr, pg, fi == 1 ? 1.f : 0.5f, fi == 3, fi == 0 ? INP(0) : nullptr); }
            if (fi == 0) {
                const float* const p_cre = INP(17); const float* const p_cim = INP(18); const f32x2v* const APOW = (const f32x2v*)(ws + WS_APOW); const f32x2v* const BBAR = (const f32x2v*)(ws + WS_BBAR); float* const KTAB = WS_F32(WS_KTAB);
                for (int e = bx * (NWAVES * 64) + tid; e < 2 * S5G * 2 * (TCH / 8) * 256; e += G * (NWAVES * 64)) {
                    const int hi_ = e & 15, ho = (e >> 4) & 15, kg = (e >> 8) % (TCH / 8), d = ((e >> 8) / (TCH / 8)) & 1, lg = (e >> 8) / (TCH / 8) / 2, l = lg / S5G, g = lg % S5G;
                    const int base = (l * 2 + d) * S5G + g;
                    const float* cre = p_cre + ((size_t)base * S5H + ho) * S5P; const float* cim = p_cim + ((size_t)base * S5H + ho) * S5P;
                    float acc[8] = {0.f, 0.f, 0.f, 0.f, 0.f, 0.f, 0.f, 0.f};
#pragma unroll 4
                    for (int p = 0; p < S5P; ++p) { const f32x2v bb = BBAR[((size_t)base * S5P + p) * S5H + hi_]; const float cr = cre[p], ci = cim[p];
                        const float wr_ = cr * bb.x - ci * bb.y, wi_ = cr * bb.y + ci * bb.x; const f32x2v* ap = APOW + ((size_t)base * S5P + p) * 65 + 8 * kg;
#pragma unroll
                        for (int q = 0; q < 8; ++q) { const f32x2v a = ap[q]; acc[q] += wr_ * a.x - wi_ * a.y; } }
                    if (d == 0 && kg == 0) { const int base1 = (l * 2 + 1) * S5G + g; const float* cre1 = p_cre + ((size_t)base1 * S5H + ho) * S5P; const float* cim1 = p_cim + ((size_t)base1 * S5H + ho) * S5P;
#pragma unroll 8
                        for (int p = 0; p < S5P; ++p) { const f32x2v bb = BBAR[((size_t)base1 * S5P + p) * S5H + hi_]; acc[0] += cre1[p] * bb.x - cim1[p] * bb.y; } }
#pragma unroll
                    for (int q = 0; q < 8; ++q) { const int k = 8 * kg + q; if (d == 1 && k == 0) continue;
                        KTAB[((size_t)lg * NLAG + (TCH - 1) + (d == 0 ? k : -k)) * 256 + ho * 16 + hi_] = acc[q]; }
                }
            }
        }
        PH_END;
        if (PH_ON) for (int rep = 0; rep < PROBE_REPS(ph); ++rep) { PH_IDS (void)rep;
            unsigned char* const ws = WSP();
            pg8::Gemm g{WS_BF(WS_H), WS_BF(WS_WGU) + (size_t)fi * 2 * FF * DM, R, 2 * FF, DM, DM, DM}; pg8::FlexOrder S; S.init(fi == 3, 2 * FF, G, bx);
            pg8::EpiGU E{WS_BF(WS_HACT)};
            pg8::gemm_phase<pg8::EpiGU, pg8::FlexOrder, true, true>(ldsl, g, S, E);
            if (fi == 0 && G == 256 && bx >= 176 && rep == 0) s5_tables(ws, INP(17), INP(18), 1, 0, (bx - 176) * (NWAVES * 64) + tid, 80 * (NWAVES * 64));
        }
        PH_END;
        if (PH_ON) for (int rep = 0; rep < PROBE_REPS(ph); ++rep) { PH_IDS (void)rep;
            unsigned char* const ws = WSP(); const float* const modl = WS_F32(WS_MODV) + (size_t)layer * 5 * MODW;
            if (fi < 3) {
                pg8::Gemm g{WS_BF(WS_HACT), WS_BF(WS_WD) + (size_t)fi * DM * FF, R, DM, FF / 4, FF, FF}; pg8::CtxSplitOrder S{G, bx, (FF / 4) * 2};
                pg8::EpiPart E{WS_F32(WS_PART)};
                pg8::gemm_phase<pg8::EpiPart, pg8::CtxSplitOrder, true, true>(ldsl, g, S, E);
                if (G == 256 && (bx & 7) >= 4 && rep == 0) s5_tables(ws, INP(17), INP(18), fi == 0 ? 6 : fi == 1 ? 3 : 4, fi == 0 ? 0 : 1, ((bx >> 3) + 32 * ((bx & 7) - 4)) * (NWAVES * 64) + tid, 128 * (NWAVES * 64)); }
            pg8::Gemm g{WS_BF(WS_HACT), WS_BF(WS_WD) + (size_t)fi * DM * FF, R, DM, FF, FF, FF}; pg8::FlexOrder S; S.init(true, DM, G, bx);
            if (fi == 0) { pg8::EpiResidX E{WS_F32(WS_XS), modl + (size_t)2 * DM, INP(0)};
                pg8::gemm_phase<pg8::EpiResidX, pg8::FlexOrder, true, true>(ldsl, g, S, E); }
            else { pg8::EpiResid E{WS_F32(WS_XS), modl + (size_t)(which * 6 + 2) * DM, rep ? 0.f : 0.5f};
                pg8::gemm_phase<pg8::EpiResid, pg8::FlexOrder, true, true>(ldsl, g, S, E); }
        }
        PH_END;
        if (which == 0) {
            if (PH_ON) for (int rep = 0; rep < PROBE_REPS(ph); ++rep) { PH_IDS (void)rep;
                unsigned char* const ws = WSP(); const float* const modl = WS_F32(WS_MODV) + (size_t)layer * 5 * MODW;
                norm_mod_rows(WS_F32(WS_XS), WS_BF(WS_H), INP(6) + (size_t)(layer * 3 + 1) * DM, modl, 1, gw, NGW, lane, tid, (LAS float*)ldsl, rep == 0 ? WS_F32(WS_PART) : nullptr, modl + (size_t)4 * MODW + 2 * DM, 0.5f, false, nullptr);
                if (layer == 0) { if (G == 256) {   }
                    else { s5_tables(ws, INP(17), INP(18), 7, 0, bx * (NWAVES * 64) + tid, G * (NWAVES * 64)); s5_tables(ws, INP(17), INP(18), 7, 1, bx * (NWAVES * 64) + tid, G * (NWAVES * 64)); } }
            }
            PH_END;
            if (PH_ON) for (int rep = 0; rep < PROBE_REPS(ph); ++rep) { PH_IDS (void)rep;
                unsigned char* const ws = WSP();
                pg8::Gemm g{WS_BF(WS_H), WS_BF(WS_WIN) + (size_t)layer * INC * DM, R, INC, DM, DM, DM}; pg8::StaticOrder S; S.init(R, INC, G, bx); S.wgm = 4;
                pg8::EpiWin E{WS_BF(WS_P), WS_BF(WS_UG), WS_BF(WS_VA)};
                pg8::gemm_phase<pg8::EpiWin, pg8::StaticOrder, true, true>(ldsl, g, S, E);
            }
            PH_END;
            if (PH_ON) for (int rep = 0; rep < PROBE_REPS(ph); ++rep) { PH_IDS (void)rep;
                unsigned char* const ws = WSP();
                {   pg8::Gemm g{WS_BF(WS_UG), WS_BF(WS_SM) + (size_t)layer * S5G * 256 * KU, S5G * RCP, S5G * 256, KU, KS5, KU}; pg8::S5StateOrder S{G, bx};
                    pg8::EpiS5State E{WS_F32(WS_SST)};
                    pg8::gemm_phase<pg8::EpiS5State, pg8::S5StateOrder, true, true>(ldsl, g, S, E); }
                const float* kg = INP(25) + layer * 128;
                const bf16_t* const PB = WS_BF(WS_P); bf16_t* const KA = WS_BF(WS_KA); const f32x2v* const ROPE = (const f32x2v*)(ws + WS_ROPE);
                constexpr int NSU = S5G * RCT; const bool spare = G > 2 * NSU;
                const int rstart = spare ? (bx - NSU) * NWAVES + wave : gw, rstride = spare ? (G - NSU) * NWAVES : NGW;
                const int li8 = lane & 7, li16 = lane & 15, lk = lane & 31;
                for (int r0 = rstart; r0 < R && r0 >= 0; r0 += 4 * rstride) {
                    u32x4v wd[4], wg[4]; int rr[4];
#pragma unroll
                    for (int u = 0; u < 4; ++u) { const int r = r0 + u * rstride; rr[u] = r < R ? r : r0;
                        const bf16_t* pr = PB + (size_t)rr[u] * INC; wd[u] = *(const u32x4v*)(pr + 1024 + 8 * lane); wg[u] = *(const u32x4v*)(pr + 3072 + 8 * lk); }
#pragma unroll
                    for (int u = 0; u < 4; ++u) { const int r = rr[u];
                        const int b = r / SPB, s = r % SPB; const bool lat = s >= CTXL; const int t = lat ? s - CTXL : 0; const f32x2v* const trow = ROPE + (t >> 6) * 48; const f32x2v* const tcol = ROPE + (t & 63) * 48;
                        bf16_t* ka = KA + ((size_t)(b * 6) * SPB + s) * 128;
                        float f[8];
                        {
                            unpack8(wd[u], f);
                            if (lat) rope8<2>(f, (li8 & 2) == 0, (li8 < 4 ? trow : tcol) + 8 * (li8 & 1));
                            *(u32x4v*)(ka + (size_t)(lane >> 4) * SPB * 128 + 8 * (lane & 15)) = pack8(f); }
                        {
                            unpack8(wg[u], f);
                            float ss = 0.f;
#pragma unroll
                            for (int e = 0; e < 8; ++e) ss += f[e] * f[e];
                            ss += __shfl_xor(ss, 1); ss += __shfl_xor(ss, 2); ss += __shfl_xor(ss, 4); ss += __shfl_xor(ss, 8);
                            const float rstd = 1.f / sqrtf(ss * (1.f / 128.f) + EPS);
#pragma unroll
                            for (int e = 0; e < 8; ++e) f[e] = f[e] * rstd * kg[8 * li16 + e];
                            if (lat) rope8<4>(f, (li16 & 4) == 0, (li16 < 8 ? trow : tcol) + 16 + 8 * (li16 & 3));
                            if (lane < 32) *(u32x4v*)(ka + (size_t)(4 + (lk >> 4)) * SPB * 128 + 8 * (lk & 15)) = pack8(f); }
                    }
                }
            }
            PH_END;
            if (PH_ON) for (int rep = 0; rep < PROBE_REPS(ph); ++rep) { PH_IDS (void)rep;
                unsigned char* const ws = WSP();
                {
                    static_assert(NCH / 17 == 8, "the two-level scan is laid out for 8 segments of 17 chunks");
                    const f32x2v* const APOW = (const f32x2v*)(ws + WS_APOW); const float* const SST = WS_F32(WS_SST); bf16_t* const UG = WS_BF(WS_UG);
                    for (int item = gw; item < NB * S5G * 2 * 8; item += NGW) {
                        const int oct = item & 7, d = (item >> 3) & 1, g = (item >> 4) & 31, b = item >> 9, seg = lane >> 3, p = oct * 8 + (lane & 7);
                        const f32x2v aT = APOW[((size_t)((layer * 2 + d) * S5G + g) * S5P + p) * 65 + TCH];
                        f32x2v sv[17];
#pragma unroll
                        for (int q = 0; q < 17; ++q) { const int idx = seg * 17 + q, c = d == 0 ? idx : (idx < NCC ? NCC - 1 - idx : NCH + NCC - 1 - idx);
                            sv[q] = *(const f32x2v*)(SST + (size_t)(g * RCP + b * NCH + c) * 256 + d * 128 + p * 2); }
                        float lr[17], li[17]; float rr = 0.f, ri_ = 0.f;
#pragma unroll
                        for (int q = 0; q < 17; ++q) { lr[q] = rr; li[q] = ri_; const float nr = aT.x * rr - aT.y * ri_ + sv[q].x, ni = aT.x * ri_ + aT.y * rr + sv[q].y; rr = nr; ri_ = ni; }
                        float ar = 1.f, ai = 0.f;
#pragma unroll
                        for (int q = 0; q < 17; ++q) { const float nr = ar * aT.x - ai * aT.y, ni = ar * aT.y + ai * aT.x; ar = nr; ai = ni; }
                        float cr = 0.f, ci = 0.f;
#pragma unroll
                        for (int sgi = 0; sgi < 7; ++sgi) { const float tr = __shfl(rr, sgi * 8 + (lane & 7)), ti = __shfl(ri_, sgi * 8 + (lane & 7));
                            if (sgi < seg) { const float nr = ar * cr - ai * ci + tr, ni = ar * ci + ai * cr + ti; cr = nr; ci = ni; } }
                        float pr = 1.f, pi = 0.f;
#pragma unroll
                        for (int q = 0; q < 17; ++q) { const int idx = seg * 17 + q, c = d == 0 ? idx : (idx < NCC ? NCC - 1 - idx : NCH + NCC - 1 - idx);
                            const float hr = lr[q] + pr * cr - pi * ci, hi_ = li[q] + pr * ci + pi * cr;
                            *(unsigned*)(UG + (size_t)(g * RCP + b * NCH + c) * KS5 + KU + d * 128 + p * 2) = cvtpk2(hr, hi_);
                            const float nr = pr * aT.x - pi * aT.y, ni = pr * aT.y + pi * aT.x; pr = nr; pi = ni; }
                    }
                }
                const bf16_t* const KA = WS_BF(WS_KA); const bf16_t* const PB = WS_BF(WS_P); const float* const qgf = INP(24) + layer * 128; const float* const ropef = (const float*)(ws + WS_ROPE); const bf16_t* const VA = WS_BF(WS_VA); bf16_t* const OD = WS_BF(WS_OD); bf16_t* const MIX = WS_BF(WS_MIX);
                const int nunits = 1024 + (layer == 0 ? 64 : 0);
                for (int i = 0;; ++i) {
                    const int U = i * G + vcu; if (U >= nunits) break;
                    int b, slot, qrow0, seq;
                    if (U < 1024) { b = U >> 8; slot = ((U >> 4) + 8 * (b & 1)) & 15; qrow0 = b * SPB + CTXL + (U & 15) * 256; seq = SPB; }
                    else { const int U2 = U - 1024; b = U2 >> 4; slot = U2 & 15; qrow0 = b * SPB; seq = CTXL; }
                    const size_t kvoff = ((size_t)(b * 6 + (slot < 8 ? (slot >> 1) : 4 + ((slot - 8) >> 2))) * SPB) * 128;

                    __syncthreads();
                    const int tpos0 = U < 1024 ? (U & 15) * 256 : -1;
                    if (slot < 8)
                        at128::attn_dma_body<4, INC, 128, 128, 1024, 1024>((const at128::bf16*)(PB + (size_t)qrow0 * INC + 512 + slot * 64), (const at128::bf16*)(KA + kvoff),
                            (const at128::bf16*)(VA + kvoff), nullptr, (at128::bf16*)(OD + (size_t)qrow0 * 1024 + slot * 128), seq, (char*)lds, (slot & 1) * 128, nullptr, ropef, tpos0);
                    else
                        at128::attn_dma_body<8, INC, 128, 128, 1024, DM>((const at128::bf16*)(PB + (size_t)qrow0 * INC + 2048 + (slot - 8) * 128), (const at128::bf16*)(KA + kvoff),
                            (const at128::bf16*)(VA + kvoff), nullptr, (at128::bf16*)(MIX + (size_t)qrow0 * DM + 1024 + (slot - 8) * 128), seq, (char*)lds, 0, qgf, ropef, tpos0);
                }
                __syncthreads();
            }
            PH_END;
            if (PH_ON) for (int rep = 0; rep < PROBE_REPS(ph); ++rep) { PH_IDS (void)rep;
                unsigned char* const ws = WSP();
                {   pg8::Gemm g{WS_BF(WS_UG), WS_BF(WS_TZE) + (size_t)layer * S5G * KU * KS5, S5G * RCP, S5G * KU, KS5, KS5, KS5}; pg8::S5OutOrder S{G, bx};
                    pg8::EpiS5Out E{WS_BF(WS_UG), INP(19) + layer * 512, WS_BF(WS_YG)};
                    pg8::gemm_phase<pg8::EpiS5Out, pg8::S5OutOrder, true, true>(ldsl, g, S, E); }
                const float* lv = INP(22) + layer * 256; const bf16_t* const OD = WS_BF(WS_OD); bf16_t* const MIX = WS_BF(WS_MIX); const float lam_init = layer == 0 ? 0.2f : 0.35550906759f;
                const float lam = expf(wave_sum(lv[lane] * lv[64 + lane])) - expf(wave_sum(lv[128 + lane] * lv[192 + lane])) + lam_init;
                const float* sg = INP(23) + layer * 128; const int li16 = lane & 15, hh = lane >> 4;
                const bool deal = (G == 256); const bool busy = bx < 192;
                const int w1 = deal ? (busy ? bx * NWAVES + wave : (bx - 192) * NWAVES + wave) : gw;
                const int rbase = deal ? (busy ? 0 : 192 * NWAVES * 2) : 0, rstep = deal ? (busy ? 192 * NWAVES : 64 * NWAVES) : NGW, rend = deal ? (busy ? 192 * NWAVES * 2 : R) : R;
                for (int r0 = rbase + w1; r0 < rend; r0 += 4 * rstep) {
                    u32x4v q1[4], q2[4]; int rr[4];
#pragma unroll
                    for (int u = 0; u < 4; ++u) { const int r = r0 + u * rstep; rr[u] = r < rend ? r : r0;
                        const bf16_t* o1 = OD + (size_t)rr[u] * 1024 + (2 * hh) * 128 + 8 * li16; q1[u] = *(const u32x4v*)o1; q2[u] = *(const u32x4v*)(o1 + 128); }
#pragma unroll
                    for (int u = 0; u < 4; ++u) { const int r = rr[u];
                        if (layer == 1 && (r % SPB) < CTXL) continue;
                        float f[8], f2[8]; unpack8(q1[u], f); unpack8(q2[u], f2);
#pragma unroll
                        for (int e = 0; e < 8; ++e) f[e] -= lam * f2[e];
                        float ss = 0.f;
#pragma unroll
                        for (int e = 0; e < 8; ++e) ss += f[e] * f[e];
                        ss += __shfl_xor(ss, 1); ss += __shfl_xor(ss, 2); ss += __shfl_xor(ss, 4); ss += __shfl_xor(ss, 8);
                        const float rstd = (1.f - lam_init) / sqrtf(ss * (1.f / 128.f) + EPS);
#pragma unroll
                        for (int e = 0; e < 8; ++e) f[e] = f[e] * rstd * sg[8 * li16 + e];
                        *(u32x4v*)(MIX + (size_t)r * DM + 512 + hh * 128 + 8 * li16) = pack8(f);
                    }
                }
            }
            PH_END;
            if (PH_ON) for (int rep = 0; rep < PROBE_REPS(ph); ++rep) { PH_IDS (void)rep;
                unsigned char* const ws = WSP();
                pg8::Gemm g{WS_BF(WS_YG), WS_BF(WS_GLU) + (size_t)layer * 512 * 512, R, 512, 512, 512, 512}; pg8::StaticOrder S; S.init(R, 512, G, bx);
                pg8::EpiGLU E{WS_BF(WS_YG), INP(21) + layer * 512, WS_BF(WS_MIX)};
                pg8::gemm_phase<pg8::EpiGLU, pg8::StaticOrder, true, true>(ldsl, g, S, E);
            }
            PH_END;
            if (PH_ON) for (int rep = 0; rep < PROBE_REPS(ph); ++rep) { PH_IDS (void)rep;
                unsigned char* const ws = WSP(); const float* const modl = WS_F32(WS_MODV) + (size_t)layer * 5 * MODW;
                if (layer == 0) {
                    pg8::Gemm g{WS_BF(WS_MIX), WS_BF(WS_WOUT), R, DM, DM / 4, DM, DM}; pg8::CtxSplitOrder S{G, bx, (DM / 4) * 2};
                    pg8::EpiPart E{WS_F32(WS_PART)};
                    pg8::gemm_phase<pg8::EpiPart, pg8::CtxSplitOrder, true, true>(ldsl, g, S, E); }
                pg8::Gemm g{WS_BF(WS_MIX), WS_BF(WS_WOUT) + (size_t)layer * DM * DM, R, DM, DM, DM, DM}; pg8::FlexOrder S; S.init(true, DM, G, bx);
                pg8::EpiResid E{WS_F32(WS_XS), modl + (size_t)5 * DM, rep ? 0.f : 1.0f};
                pg8::gemm_phase<pg8::EpiResid, pg8::FlexOrder, true, true>(ldsl, g, S, E);
            }
            PH_END;
        }
    }
    if (PH_ON) for (int rep = 0; rep < PROBE_REPS(ph); ++rep) { PH_IDS (void)rep;
        unsigned char* const ws = WSP(); const float* fg = INP(26); const float* const XS = WS_F32(WS_XS); float* const outp = (float*)ldptr(ldsl, 27);
        for (int q0 = gw; q0 < NB * SEQL; q0 += 2 * NGW) {
            f32x4 v[2][8]; int qq[2];
#pragma unroll
            for (int u = 0; u < 2; ++u) { const int q = q0 + u * NGW < NB * SEQL ? q0 + u * NGW : q0; qq[u] = q; const int b = q / SEQL, t = q % SEQL; const f32x4* xr = (const f32x4*)(XS + (size_t)(b * SPB + CTXL + t) * DM) + lane;
#pragma unroll
                for (int j = 0; j < 8; ++j) v[u][j] = xr[64 * j]; }
#pragma unroll
            for (int u = 0; u < 2; ++u) { if (u == 1 && qq[1] == q0) continue;
                float ss = 0.f;
#pragma unroll
                for (int j = 0; j < 8; ++j) ss += (v[u][j].x * v[u][j].x + v[u][j].y * v[u][j].y) + (v[u][j].z * v[u][j].z + v[u][j].w * v[u][j].w);
                const float rstd = 1.f / sqrtf(wave_sum(ss) * (1.f / DM) + EPS);
                f32x4* orow = (f32x4*)(outp + (size_t)qq[u] * DM) + lane;
#pragma unroll
                for (int j = 0; j < 8; ++j) orow[64 * j] = v[u][j] * rstd * *(const f32x4*)(fg + 4 * (lane + 64 * j)); }
        }
    }
#undef PH_ON
#undef PH_END
}

extern "C" void kernel_launch(void* const* d_in, const int* in_sizes, int n_in, void* d_out, int out_size, void* d_ws, size_t ws_size, hipStream_t stream) {
    static int grid = 0;
    if (grid == 0) {
        if (n_in != 27 || in_sizes[0] != NB * SEQL * DM || out_size != NB * SEQL * DM || ws_size < WS_END) {
            fprintf(stderr, "kernel_launch: shape mismatch: n_in %d in0 %d out %d ws %zu (need %zu)\n", n_in, n_in > 0 ? in_sizes[0] : -1, out_size, ws_size, (size_t)WS_END); grid = -1; return; }
        int dev = 0, cus = 0, per_cu = 0;
        if (hipGetDevice(&dev) != hipSuccess || hipDeviceGetAttribute(&cus, hipDeviceAttributeMultiprocessorCount, dev) != hipSuccess) { fprintf(stderr, "kernel_launch: device query failed\n"); grid = -1; return; }
        if (hipFuncSetAttribute((const void*)mega_fwd, hipFuncAttributeMaxDynamicSharedMemorySize, LDS_BYTES) != hipSuccess) { fprintf(stderr, "kernel_launch: hipFuncSetAttribute failed\n"); grid = -1; return; }
        if (hipOccupancyMaxActiveBlocksPerMultiprocessor(&per_cu, (const void*)mega_fwd, NWAVES * 64, LDS_BYTES) != hipSuccess || per_cu < 1)
            fprintf(stderr, "kernel_launch: note: occupancy query reports %d workgroups per CU\n", per_cu);
        (void)hipGetLastError();
        grid = cus;
    }
    if (grid < 0) return;
    if (hipMemsetAsync((char*)d_ws + WS_CTL, 0, CTL_ZERO_BYTES, stream) != hipSuccess) { fprintf(stderr, "kernel_launch: memset failed\n"); return; }
    Args a{};
    for (int i = 0; i < 27; ++i) a.in[i] = (const float*)d_in[i];
    a.out = (float*)d_out; a.ws = (unsigned char*)d_ws;
#if MK_N_LAUNCHES == 1
    a.ph_lo = 0; a.ph_hi = NPH;
    hipLaunchKernelGGL(mega_fwd, dim3(grid), dim3(NWAVES * 64), LDS_BYTES, stream, a);
#else
    for (int k = 0; k < NPH; ++k) { a.ph_lo = k; a.ph_hi = k + 1; hipLaunchKernelGGL(mega_fwd, dim3(grid), dim3(NWAVES * 64), LDS_BYTES, stream, a); }
#endif
    const hipError_t le = hipPeekAtLastError();
    if (le != hipSuccess) fprintf(stderr, "kernel_launch: launch failed: %s\n", hipGetErrorName(le));
}
```
